# Optimizing an MI355X kernel written in HIP

```python
import jax, jax.numpy as jnp
from jax import lax
import numpy as np

D_MODEL = 1024
BATCH = 4
SEQ = 4096
DEPTH = 2

GRID_W = 64
CTX_LEN = 256
HEAD_DIM = 64
ATTN_SCALE = HEAD_DIM ** -0.5
ROPE_THETA = 10000.0
A_HEADS = 4
A_KV = 2
WINDOW = 128
BAND_BLOCK = 128
B_HEADS = 4
B_KV = 2
Q_BLOCK = 128
C_HEADS = 4
C_KDIM = 128
C_VDIM = 128
C_CHUNK = 64
A_WIDTH = A_HEADS * HEAD_DIM
B_WIDTH = B_HEADS * HEAD_DIM
C_WIDTH = C_HEADS * C_VDIM
MIX_WIDTH = A_WIDTH + B_WIDTH + C_WIDTH
IN_SIZES = (A_HEADS * HEAD_DIM, A_KV * HEAD_DIM, A_KV * HEAD_DIM,
            B_HEADS * HEAD_DIM, B_KV * HEAD_DIM, B_KV * HEAD_DIM,
            C_HEADS * C_KDIM, C_HEADS * C_KDIM, C_HEADS * C_KDIM, C_HEADS * C_VDIM, C_HEADS * C_VDIM)
IN_WIDTH = sum(IN_SIZES)
SPLIT_IDX = tuple(int(s) for s in np.cumsum(IN_SIZES)[:-1])
N_EXPERTS = 32
TOP_K = 4
D_FF = 1024
SWIGLU_ALPHA = 1.702
SWIGLU_LIMIT = 7.0
MOE_BLOCK = 256
EPS = 1e-6
NEG_INF = -1e30
TINY = 1e-30

kernel_name = 'hybrid_flow_trunk_block'


def rms_norm(x, w):
    xf = x.astype(jnp.float32)
    y = xf * lax.rsqrt(jnp.mean(xf * xf, axis=-1, keepdims=True) + EPS)
    return (y * w.astype(jnp.float32)).astype(x.dtype)


def heads(a, n):
    return a.reshape(a.shape[0], a.shape[1], n, -1)


def group(a, kv):
    return a.reshape(a.shape[0], a.shape[1], kv, -1, a.shape[-1])


def flip_seq(a):
    return jnp.flip(a, axis=1)


def axial_rope_tables(n):
    rows = n // GRID_W
    row = jnp.repeat(jnp.arange(rows), GRID_W).astype(jnp.float32)
    col = jnp.tile(jnp.arange(GRID_W), rows).astype(jnp.float32)
    half = HEAD_DIM // 2
    inv = 1.0 / (ROPE_THETA ** (jnp.arange(0, half, 2, dtype=jnp.float32) / half))
    ang_r = row[:, None] * inv
    ang_c = col[:, None] * inv
    ang = jnp.concatenate([ang_r, ang_r, ang_c, ang_c], axis=-1)
    return jnp.cos(ang), jnp.sin(ang)


def apply_rope(x, cos, sin):
    x1, x2, x3, x4 = jnp.split(x, 4, axis=-1)
    rot = jnp.concatenate([-x2, x1, -x4, x3], axis=-1)
    return x * cos[:, None].astype(x.dtype) + rot * sin[:, None].astype(x.dtype)


def dense_attend(q, k, v, sink=None):
    s = jnp.einsum('bqkgd,bskd->bkgqs', q, k).astype(jnp.float32) * ATTN_SCALE
    if sink is not None:
        kv, g = q.shape[2], q.shape[3]
        sc = jnp.broadcast_to(sink.reshape(kv, g)[None, :, :, None, None].astype(jnp.float32), s.shape[:-1] + (1,))
        s = jnp.concatenate([s, sc], axis=-1)
    p = jax.nn.softmax(s, axis=-1)
    if sink is not None:
        p = p[..., :-1]
    return jnp.einsum('bkgqs,bskd->bqkgd', p.astype(v.dtype), v)


def window_attention(q, k, v, kc, vc, sink):
    B, N, H, Dh = q.shape
    KV = k.shape[2]
    G = H // KV
    W = BAND_BLOCK
    nb = N // W
    qb = q.reshape(B, nb, W, KV, G, Dh)

    def band(a):
        pad = jnp.zeros((B, W, KV, Dh), a.dtype)
        ab = jnp.concatenate([pad, a, pad], axis=1).reshape(B, nb + 2, W, KV, Dh)
        return jnp.concatenate([ab[:, :-2], ab[:, 1:-1], ab[:, 2:]], axis=2)

    kb, vb = band(k), band(v)
    s_loc = jnp.einsum('bnqkgd,bnskd->bnkgqs', qb, kb).astype(jnp.float32) * ATTN_SCALE
    qi = jnp.arange(W)[:, None]
    kj = jnp.arange(3 * W)[None, :]
    kpos = jnp.arange(nb)[:, None, None] * W - W + kj[None]
    mask = (jnp.abs(qi + W - kj) <= WINDOW)[None] & (kpos >= 0) & (kpos < N)
    s_loc = jnp.where(mask[None, :, None, None], s_loc, NEG_INF)
    s_ctx = jnp.einsum('bnqkgd,bmkd->bnkgqm', qb, kc).astype(jnp.float32) * ATTN_SCALE
    s_sink = jnp.broadcast_to(sink.reshape(KV, G)[None, None, :, :, None, None].astype(jnp.float32), s_loc.shape[:-1] + (1,))
    p = jax.nn.softmax(jnp.concatenate([s_loc, s_ctx, s_sink], axis=-1), axis=-1).astype(v.dtype)
    L = 3 * W
    o = (jnp.einsum('bnkgqs,bnskd->bnqkgd', p[..., :L], vb)
         + jnp.einsum('bnkgqm,bmkd->bnqkgd', p[..., L:-1], vc))
    return o.reshape(B, N, H * Dh)


def blocked_attention(q, k, v):
    B, N, H, Dh = q.shape
    KV = k.shape[2]
    nb = N // Q_BLOCK
    qb = q.reshape(B, nb, Q_BLOCK, KV, H // KV, Dh).transpose(1, 0, 2, 3, 4, 5)
    o = lax.map(lambda qq: dense_attend(qq, k, v), qb)
    return o.transpose(1, 0, 2, 3, 4, 5).reshape(B, N, H * Dh)


def hgrn_forget(z, lb):
    z = z.astype(jnp.float32)
    lb = lb.astype(jnp.float32)
    f = lb + (1.0 - lb) * jax.nn.sigmoid(z)
    logf = jnp.log(jnp.maximum(f, TINY))
    k = (1.0 - lb) * jax.nn.sigmoid(-z)
    return logf, k


def chunk_scan(q, k, v, logf, s0):
    B, L, H, K = q.shape
    V = v.shape[-1]
    nc = L // C_CHUNK

    def chunks(a):
        return a.astype(jnp.float32).reshape(B, nc, C_CHUNK, H, a.shape[-1]).transpose(1, 0, 3, 2, 4)

    tri = jnp.tril(jnp.ones((C_CHUNK, C_CHUNK), bool))[:, :, None]

    def step(S, inp):
        qc, kc, vc, gc = inp
        b = jnp.cumsum(gc, axis=2)
        inter = jnp.einsum('bhtk,bhkv->bhtv', qc * jnp.exp(b), S)
        diff = jnp.where(tri, b[:, :, :, None, :] - b[:, :, None, :, :], 0.0)
        decay = jnp.where(tri, jnp.exp(diff), 0.0)
        attn = jnp.einsum('bhtk,bhtsk,bhsk->bhts', qc, decay, kc)
        out = inter + jnp.einsum('bhts,bhsv->bhtv', attn, vc)
        b_end = b[:, :, -1:, :]
        S = jnp.exp(b_end[:, :, 0, :, None]) * S + jnp.einsum('bhsk,bhsv->bhkv', kc * jnp.exp(b_end - b), vc)
        return S, out

    S, o = lax.scan(step, s0, (chunks(q), chunks(k), chunks(v), chunks(logf)))
    return o.transpose(1, 0, 3, 2, 4).reshape(B, L, H, V), S


def final_state(k, v, logf):
    b = jnp.cumsum(logf, axis=1)
    w = k * jnp.exp(b[:, -1:] - b)
    return jnp.einsum('blhk,blhv->bhkv', w, v.astype(jnp.float32))


def hgrn_readout(o, g_pre, w, dtype):
    y = rms_norm(o, w) * jax.nn.silu(heads(g_pre, C_HEADS).astype(jnp.float32))
    return y.reshape(o.shape[0], o.shape[1], -1).astype(dtype)


def mix_layer(h, hc, w_in, w_out, sink, q_norm_w, k_norm_w, lb, gate_norm_w, cos, sin, ctx_out):
    B, N, _ = h.shape
    M = hc.shape[1]
    wa_q, wa_k, wa_v, wb_q, wb_k, wb_v, wc_q, wc_ff, wc_fb, wc_i, wc_g = jnp.split(w_in, SPLIT_IDX, axis=1)
    aq, ak, av, bq, bk, bv, cq, cff, cfb, ci, cg = jnp.split(h @ w_in, SPLIT_IDX, axis=-1)
    a_kc = heads(hc @ wa_k, A_KV)
    a_vc = heads(hc @ wa_v, A_KV)
    ya = window_attention(apply_rope(heads(aq, A_HEADS), cos, sin), apply_rope(heads(ak, A_KV), cos, sin),
                          heads(av, A_KV), a_kc, a_vc, sink)
    b_kc = rms_norm(heads(hc @ wb_k, B_KV), k_norm_w)
    b_vc = heads(hc @ wb_v, B_KV)
    b_q = apply_rope(rms_norm(heads(bq, B_HEADS), q_norm_w), cos, sin)
    b_k = apply_rope(rms_norm(heads(bk, B_KV), k_norm_w), cos, sin)
    yb = blocked_attention(b_q, jnp.concatenate([b_k, b_kc], axis=1),
                           jnp.concatenate([heads(bv, B_KV), b_vc], axis=1))
    lb_f = lb[0].reshape(C_HEADS, C_KDIM)
    lb_b = lb[1].reshape(C_HEADS, C_KDIM)
    c_vc = heads(hc @ wc_i, C_HEADS)
    g_cf, k_cf = hgrn_forget(heads(hc @ wc_ff, C_HEADS), lb_f)
    g_cb, k_cb = hgrn_forget(heads(hc @ wc_fb, C_HEADS), lb_b)
    if ctx_out:
        s0 = jnp.zeros((B, C_HEADS, C_KDIM, C_VDIM), jnp.float32)
        c_qc = jax.nn.silu(heads(hc @ wc_q, C_HEADS))
        oc_f, s_f = chunk_scan(c_qc, k_cf, c_vc, g_cf, s0)
        oc_b, s_b = chunk_scan(flip_seq(c_qc), flip_seq(k_cb), flip_seq(c_vc), flip_seq(g_cb), s0)
    else:
        s_f = final_state(k_cf, c_vc, g_cf)
        s_b = final_state(flip_seq(k_cb), flip_seq(c_vc), flip_seq(g_cb))
    c_q = jax.nn.silu(heads(cq, C_HEADS))
    c_v = heads(ci, C_HEADS)
    g_f, k_f = hgrn_forget(heads(cff, C_HEADS), lb_f)
    g_b, k_b = hgrn_forget(heads(cfb, C_HEADS), lb_b)
    o_f, _ = chunk_scan(c_q, k_f, c_v, g_f, s_f)
    o_b, _ = chunk_scan(flip_seq(c_q), flip_seq(k_b), flip_seq(c_v), flip_seq(g_b), s_b)
    yc = hgrn_readout(o_f + flip_seq(o_b), cg, gate_norm_w, h.dtype)
    y = jnp.concatenate([ya, yb, yc], axis=-1) @ w_out
    if not ctx_out:
        return y, None
    yac = dense_attend(group(heads(hc @ wa_q, A_HEADS), A_KV), a_kc, a_vc, sink).reshape(B, M, -1)
    ybc = dense_attend(group(rms_norm(heads(hc @ wb_q, B_HEADS), q_norm_w), B_KV), b_kc, b_vc).reshape(B, M, -1)
    ycc = hgrn_readout(oc_f + flip_seq(oc_b), hc @ wc_g, gate_norm_w, hc.dtype)
    return y, jnp.concatenate([yac, ybc, ycc], axis=-1) @ w_out


def clamped_swiglu(u):
    u_glu = jnp.minimum(u[..., ::2], SWIGLU_LIMIT)
    u_lin = jnp.clip(u[..., 1::2], -SWIGLU_LIMIT, SWIGLU_LIMIT)
    return u_glu * jax.nn.sigmoid(SWIGLU_ALPHA * u_glu) * (u_lin + 1.0)


def moe(h, router_w, router_b, w1, b1, w2, b2):
    T, D = h.shape
    logits = (h @ router_w + router_b).astype(jnp.float32)
    top_v, top_i = lax.top_k(logits, TOP_K)
    gates = jax.nn.softmax(top_v, axis=-1)
    TK = T * TOP_K
    flat_e = top_i.reshape(-1)
    flat_tok = jnp.repeat(jnp.arange(T), TOP_K)
    order = jnp.argsort(flat_e)
    se = flat_e[order]
    st = flat_tok[order]
    sg = gates.reshape(-1)[order]
    counts = jnp.bincount(flat_e, length=N_EXPERTS)
    padded = (counts + MOE_BLOCK - 1) // MOE_BLOCK * MOE_BLOCK
    start = jnp.cumsum(counts) - counts
    pend = jnp.cumsum(padded)
    pstart = pend - padded
    dest = pstart[se] + jnp.arange(TK) - start[se]
    n_blocks = -(-(TK + N_EXPERTS * (MOE_BLOCK - 1)) // MOE_BLOCK)
    P = n_blocks * MOE_BLOCK
    buf_tok = jnp.zeros((P,), jnp.int32).at[dest].set(st.astype(jnp.int32))
    buf_gate = jnp.zeros((P,), h.dtype).at[dest].set(sg.astype(h.dtype))
    blk_e = jnp.minimum(jnp.searchsorted(pend, jnp.arange(n_blocks) * MOE_BLOCK, side='right'), N_EXPERTS - 1)

    def step(acc, inp):
        tok, g, e = inp
        u = h[tok] @ w1[e] + b1[e]
        y = clamped_swiglu(u) @ w2[e] + b2[e]
        return acc.at[tok].add(y * g[:, None]), None

    out, _ = lax.scan(step, jnp.zeros_like(h),
                      (buf_tok.reshape(n_blocks, MOE_BLOCK), buf_gate.reshape(n_blocks, MOE_BLOCK), blk_e))
    return out


def setup_inputs(seed: int = 0) -> dict:
    key = jax.random.key(seed)
    ks = jax.random.split(key, 22)
    d = D_MODEL

    def normal(k, shape, scale):
        return scale * jax.random.normal(k, shape, jnp.float32)

    return {
        'x': normal(ks[0], (BATCH, SEQ, d), 1.0),
        'c': normal(ks[1], (BATCH, d), 1.0),
        'ctx': normal(ks[2], (BATCH, CTX_LEN, d), 1.0),
        'c_ctx': normal(ks[3], (d,), 1.0),
        'w_mod': normal(ks[4], (DEPTH, d, 6 * d), 0.5 * d ** -0.5),
        'b_mod': normal(ks[5], (DEPTH, 6 * d), 0.01),
        'norm1_w': 1.0 + normal(ks[6], (DEPTH, d), 0.05),
        'norm2_w': 1.0 + normal(ks[7], (DEPTH, d), 0.05),
        'w_in': normal(ks[8], (DEPTH, d, IN_WIDTH), d ** -0.5),
        'w_out': normal(ks[9], (DEPTH, MIX_WIDTH, d), MIX_WIDTH ** -0.5),
        'attn_sink': normal(ks[10], (DEPTH, A_HEADS), 1.0),
        'q_norm_w': 1.0 + normal(ks[11], (DEPTH, HEAD_DIM), 0.05),
        'k_norm_w': 1.0 + normal(ks[12], (DEPTH, HEAD_DIM), 0.05),
        'hgrn_lb': normal(ks[13], (DEPTH, 2, C_HEADS * C_KDIM), 0.5),
        'gate_norm_w': 1.0 + normal(ks[14], (DEPTH, C_VDIM), 0.05),
        'router_w': normal(ks[15], (DEPTH, d, N_EXPERTS), d ** -0.5),
        'router_b': normal(ks[16], (DEPTH, N_EXPERTS), 0.01),
        'w1': normal(ks[17], (DEPTH, N_EXPERTS, d, 2 * D_FF), d ** -0.5),
        'b1': normal(ks[18], (DEPTH, N_EXPERTS, 2 * D_FF), 0.01),
        'w2': normal(ks[19], (DEPTH, N_EXPERTS, D_FF, d), D_FF ** -0.5),
        'b2': normal(ks[20], (DEPTH, N_EXPERTS, d), 0.01),
        'final_norm_w': 1.0 + normal(ks[21], (d,), 0.05),
    }


def reference(x, c, ctx, c_ctx, w_mod, b_mod, norm1_w, norm2_w, w_in, w_out, attn_sink, q_norm_w,
              k_norm_w, hgrn_lb, gate_norm_w, router_w, router_b, w1, b1, w2, b2, final_norm_w):
    B, N, D = x.shape
    cos, sin = axial_rope_tables(N)
    lbs = jax.nn.softmax(hgrn_lb.astype(jnp.float32), axis=0)
    lbs = jnp.cumsum(lbs, axis=0) - lbs[0]
    xc = ctx
    for l in range(DEPTH):
        ctx_out = l < DEPTH - 1
        mod = jax.nn.silu(c) @ w_mod[l] + b_mod[l]
        mod_c = jax.nn.silu(c_ctx) @ w_mod[l] + b_mod[l]
        sh1, sc1, g1, sh2, sc2, g2 = jnp.split(mod[:, None, :], 6, axis=-1)
        csh1, csc1, cg1, csh2, csc2, cg2 = jnp.split(mod_c, 6, axis=-1)
        h = rms_norm(x, norm1_w[l]) * (1.0 + sc1) + sh1
        hc = rms_norm(xc, norm1_w[l]) * (1.0 + csc1) + csh1
        y, yc = mix_layer(h, hc, w_in[l], w_out[l], attn_sink[l], q_norm_w[l], k_norm_w[l], lbs[l],
                          gate_norm_w[l], cos, sin, ctx_out)
        x = x + g1 * y
        h2 = rms_norm(x, norm2_w[l]) * (1.0 + sc2) + sh2
        if ctx_out:
            xc = xc + cg1 * yc
            hc2 = rms_norm(xc, norm2_w[l]) * (1.0 + csc2) + csh2
            tokens = jnp.concatenate([h2.reshape(-1, D), hc2.reshape(-1, D)], axis=0)
            f = moe(tokens, router_w[l], router_b[l], w1[l], b1[l], w2[l], b2[l])
            x = x + g2 * f[:B * N].reshape(B, N, D)
            xc = xc + cg2 * f[B * N:].reshape(B, -1, D)
        else:
            f = moe(h2.reshape(-1, D), router_w[l], router_b[l], w1[l], b1[l], w2[l], b2[l])
            x = x + g2 * f.reshape(B, N, D)
    return rms_norm(x, final_norm_w)
```

```cpp
#include <hip/hip_runtime.h>
#include <hip/hip_cooperative_groups.h>
#include <stdint.h>
#include <stdio.h>
namespace cg = cooperative_groups;

#ifndef MEGA
#define MEGA 0
#endif

typedef unsigned short bf16_t;
typedef short bf16x8 __attribute__((ext_vector_type(8)));
typedef float f32x4 __attribute__((ext_vector_type(4)));
typedef unsigned u32x4 __attribute__((ext_vector_type(4)));
typedef unsigned u32x2 __attribute__((ext_vector_type(2)));

#define NT 512
constexpr int D_ = 1024, NB_ = 4, SEQ_ = 4096, CTX_ = 256, TPB = 4352, R_ = NB_ * TPB, INW = 3584, NE = 32, DFF = 1024;
constexpr float EPS_ = 1e-6f;
constexpr int PMAX = 77824;
constexpr int LDS_BYTES = 135168;

constexpr size_t OFF_CTL = 0;
constexpr size_t OFF_ROPE = 65536;
constexpr size_t OFF_MOD = 131072;
constexpr size_t OFF_WIN = 1u << 20;
constexpr size_t OFF_WOUT = OFF_WIN + (size_t)2 * INW * D_ * 2;
constexpr size_t OFF_W1 = OFF_WOUT + (size_t)2 * D_ * D_ * 2;
constexpr size_t OFF_W2 = OFF_W1 + (size_t)2 * NE * 2048 * D_ * 2;
constexpr size_t OFF_XS = OFF_W2 + (size_t)2 * NE * D_ * DFF * 2;
constexpr size_t OFF_HB = OFF_XS + (size_t)R_ * D_ * 4;
constexpr size_t OFF_PROJ = OFF_HB + (size_t)R_ * D_ * 2;
constexpr size_t OFF_MIX = OFF_PROJ + (size_t)R_ * INW * 2;
constexpr size_t OFF_OF = OFF_MIX + (size_t)R_ * D_ * 2;
constexpr size_t OFF_OB = OFF_OF + (size_t)R_ * 512 * 4;
constexpr size_t OFF_EID = OFF_OB + (size_t)R_ * 512 * 4;
constexpr size_t OFF_GATE = OFF_EID + (size_t)R_ * 16;
constexpr size_t OFF_POS = OFF_GATE + (size_t)R_ * 16;
constexpr size_t OFF_ROWL = OFF_POS + (size_t)R_ * 16;
constexpr size_t OFF_ACT = OFF_ROWL + (size_t)PMAX * 4;
constexpr size_t OFF_YBUF = OFF_ACT + (size_t)PMAX * DFF * 2;
constexpr size_t WS_END = OFF_YBUF + (size_t)R_ * 4 * D_ * 2;

struct Params {
    const float *x, *c, *ctx, *c_ctx, *w_mod, *b_mod, *norm1_w, *norm2_w, *w_in, *w_out, *attn_sink, *q_norm_w, *k_norm_w, *hgrn_lb,
        *gate_norm_w, *router_w, *router_b, *w1, *b1, *w2, *b2, *final_norm_w;
    float* out;
    unsigned char* ws;
};

__device__ __forceinline__ unsigned f2bf(float f) { unsigned u = __float_as_uint(f); u += 0x7fffu + ((u >> 16) & 1u); return u >> 16; }
__device__ __forceinline__ unsigned pack2(float lo, float hi) { return f2bf(lo) | (f2bf(hi) << 16); }
__device__ __forceinline__ float bflo(unsigned w) { return __uint_as_float(w << 16); }
__device__ __forceinline__ float bfhi(unsigned w) { return __uint_as_float(w & 0xffff0000u); }
__device__ __forceinline__ float wave_sum(float v) {
#pragma unroll
    for (int o = 1; o < 64; o <<= 1) v += __shfl_xor(v, o);
    return v;
}
__device__ __forceinline__ int get_tid() { int t = threadIdx.x; asm volatile("" : "+v"(t)); return t; }
__device__ __forceinline__ float sigmoidf_(float z) { return 1.f / (1.f + __expf(-z)); }

__device__ __forceinline__ void prep_transpose_item(const float* __restrict__ src, int K, int N, bf16_t* __restrict__ dst, int item, float* tile) {
    const int nb = N >> 6, kb = item / nb, nbk = item - kb * nb, k0 = kb * 64, n0 = nbk * 64, tid = get_tid();
#pragma unroll
    for (int i = 0; i < 8; ++i) { const int k = i * 8 + (tid >> 6), n = tid & 63; tile[k * 65 + n] = src[(size_t)(k0 + k) * N + n0 + n]; }
    __syncthreads();
    const int n = tid >> 3, kc = tid & 7;
    u32x4 w;
    w.x = pack2(tile[(kc * 8 + 0) * 65 + n], tile[(kc * 8 + 1) * 65 + n]);
    w.y = pack2(tile[(kc * 8 + 2) * 65 + n], tile[(kc * 8 + 3) * 65 + n]);
    w.z = pack2(tile[(kc * 8 + 4) * 65 + n], tile[(kc * 8 + 5) * 65 + n]);
    w.w = pack2(tile[(kc * 8 + 6) * 65 + n], tile[(kc * 8 + 7) * 65 + n]);
    *(u32x4*)(dst + (size_t)(n0 + n) * K + k0 + kc * 8) = w;
    __syncthreads();
}

__device__ __forceinline__ void prep_mod_item(const Params& p, int item, float* lds) {
    const int l = item / 96, col0 = (item - l * 96) * 64, tid = get_tid();
    float* s = lds;
    float* red = lds + 5 * 1024;
    for (int i = tid; i < 5 * 1024; i += NT) { const int row = i >> 10, k = i & 1023; const float cv = row < 4 ? p.c[row * 1024 + k] : p.c_ctx[k]; s[i] = cv / (1.f + __expf(-cv)); }
    __syncthreads();
    const int col = tid & 63, kq = tid >> 6;
    const float* w = p.w_mod + (size_t)l * 1024 * 6144 + col0 + col;
    float a0 = 0.f, a1 = 0.f, a2 = 0.f, a3 = 0.f, a4 = 0.f;
#pragma unroll 8
    for (int k = kq * 128; k < kq * 128 + 128; ++k) {
        const float wv = w[(size_t)k * 6144];
        a0 += s[k] * wv; a1 += s[1024 + k] * wv; a2 += s[2048 + k] * wv; a3 += s[3072 + k] * wv; a4 += s[4096 + k] * wv;
    }
    red[(kq * 5 + 0) * 64 + col] = a0; red[(kq * 5 + 1) * 64 + col] = a1; red[(kq * 5 + 2) * 64 + col] = a2; red[(kq * 5 + 3) * 64 + col] = a3; red[(kq * 5 + 4) * 64 + col] = a4;
    __syncthreads();
    if (tid < 320) {
        const int r = tid >> 6, c = tid & 63; float sum = 0.f;
#pragma unroll
        for (int q = 0; q < 8; ++q) sum += red[(q * 5 + r) * 64 + c];
        float* modv = (float*)(p.ws + OFF_MOD);
        modv[(size_t)(l * 5 + r) * 6144 + col0 + c] = sum + p.b_mod[l * 6144 + col0 + c];
    }
    __syncthreads();
}

__device__ __forceinline__ void phase_prep(const Params& p, unsigned char* ldsraw) {
    float* lds = (float*)ldsraw;
    const int tid = get_tid();
    constexpr int N_MOD = 192, N_MISC = 1, N_WIN = 2 * 16 * 56, N_WOUT = 2 * 16 * 16, N_W1 = 64 * 16 * 32, N_W2 = 64 * 16 * 16;
    constexpr int NITEMS = N_MOD + N_MISC + N_WIN + N_WOUT + N_W1 + N_W2;
    for (int it = blockIdx.x; it < NITEMS; it += gridDim.x) {
        int r = it;
        if (r < N_MOD) { prep_mod_item(p, r, lds); continue; } r -= N_MOD;
        if (r < N_MISC) {
            float* tab = (float*)(p.ws + OFF_ROPE);
            for (int i = tid; i < 1024; i += NT) { const int pos = i >> 4, fi = i & 15; const float inv = 1.0f / powf(10000.0f, (float)(2 * fi) / 32.0f); const float ang = (float)pos * inv; tab[2 * i] = cosf(ang); tab[2 * i + 1] = sinf(ang); }
            int* cnt = (int*)(p.ws + OFF_CTL);
            if (tid < 64) cnt[tid] = 0;
            continue;
        } r -= N_MISC;
        if (r < N_WIN) { const int l = r / (16 * 56), ii = r - l * 16 * 56; prep_transpose_item(p.w_in + (size_t)l * D_ * INW, D_, INW, (bf16_t*)(p.ws + OFF_WIN) + (size_t)l * INW * D_, ii, lds); continue; } r -= N_WIN;
        if (r < N_WOUT) { const int l = r / 256, ii = r - l * 256; prep_transpose_item(p.w_out + (size_t)l * D_ * D_, D_, D_, (bf16_t*)(p.ws + OFF_WOUT) + (size_t)l * D_ * D_, ii, lds); continue; } r -= N_WOUT;
        if (r < N_W1) { const int m = r / 512, ii = r - m * 512; prep_transpose_item(p.w1 + (size_t)m * D_ * 2048, D_, 2048, (bf16_t*)(p.ws + OFF_W1) + (size_t)m * 2048 * D_, ii, lds); continue; } r -= N_W1;
        { const int m = r / 256, ii = r - m * 256; prep_transpose_item(p.w2 + (size_t)m * DFF * D_, DFF, D_, (bf16_t*)(p.ws + OFF_W2) + (size_t)m * D_ * DFF, ii, lds); }
    }
}

__device__ __forceinline__ float row_rstd(const f32x4 (&v)[4]) {
    float ss = 0.f;
#pragma unroll
    for (int j = 0; j < 4; ++j) ss += (v[j].x * v[j].x + v[j].y * v[j].y) + (v[j].z * v[j].z + v[j].w * v[j].w);
    return rsqrtf(wave_sum(ss) * (1.0f / D_) + EPS_);
}
__device__ __forceinline__ void norm_mod_store(const f32x4 (&v)[4], float rstd, const float* w, const float* sc, const float* sh, bf16_t* dst, int lane, f32x4 (&hv)[4]) {
#pragma unroll
    for (int j = 0; j < 4; ++j) {
        const int c = 4 * lane + 256 * j;
        const f32x4 wv = *(const f32x4*)(w + c), scv = *(const f32x4*)(sc + c), shv = *(const f32x4*)(sh + c);
        f32x4 h;
        h.x = (v[j].x * rstd * wv.x) * (1.f + scv.x) + shv.x; h.y = (v[j].y * rstd * wv.y) * (1.f + scv.y) + shv.y;
        h.z = (v[j].z * rstd * wv.z) * (1.f + scv.z) + shv.z; h.w = (v[j].w * rstd * wv.w) * (1.f + scv.w) + shv.w;
        hv[j] = h;
        u32x2 o; o.x = pack2(h.x, h.y); o.y = pack2(h.z, h.w);
        *(u32x2*)(dst + c) = o;
    }
}

__device__ __forceinline__ void phase_norm_in(const Params& p) {
    const int tid = get_tid(), wave = tid >> 6, lane = tid & 63;
    float* xs = (float*)(p.ws + OFF_XS); bf16_t* hb = (bf16_t*)(p.ws + OFF_HB); const float* modv = (const float*)(p.ws + OFF_MOD);
    for (int r = blockIdx.x * 8 + wave; r < R_; r += gridDim.x * 8) {
        const int b = r / TPB, pp = r - b * TPB;
        const float* src = pp < CTX_ ? p.ctx + ((size_t)b * CTX_ + pp) * D_ : p.x + ((size_t)b * SEQ_ + (pp - CTX_)) * D_;
        f32x4 v[4], hv[4];
#pragma unroll
        for (int j = 0; j < 4; ++j) { v[j] = *(const f32x4*)(src + 4 * lane + 256 * j); *(f32x4*)(xs + (size_t)r * D_ + 4 * lane + 256 * j) = v[j]; }
        const float rstd = row_rstd(v);
        const float* mv = modv + (size_t)(pp < CTX_ ? 4 : b) * 6144;
        norm_mod_store(v, rstd, p.norm1_w, mv + 1024, mv, hb + (size_t)r * D_, lane, hv);
    }
}

constexpr int G_LDT = 72, G_ABYTES = 256 * G_LDT * 2, G_BBYTES = 128 * G_LDT * 2, G_STAGE = G_ABYTES + G_BBYTES, G_LDS = 2 * G_STAGE;
__device__ __forceinline__ void gemm_core(const bf16_t* ap0, const bf16_t* ap1, const bf16_t* ap2, const bf16_t* ap3, const bf16_t* bp0, const bf16_t* bp1,
                                          int K, unsigned char* lds, f32x4 (&acc)[4][4]) {
    const int tid = get_tid(), lane = tid & 63, wave = tid >> 6, wm = wave >> 1, wn = wave & 1, fr = lane & 15, fq = lane >> 4;
    const int soff = ((tid >> 3) * G_LDT + (tid & 7) * 8) * 2;
    const int nk = K >> 6;
#pragma unroll
    for (int m = 0; m < 4; ++m)
#pragma unroll
        for (int n = 0; n < 4; ++n) acc[m][n] = (f32x4){0.f, 0.f, 0.f, 0.f};
    u32x4 ra0, ra1, ra2, ra3, rb0, rb1;
#define G_LOADG(kt) do { ra0 = *(const u32x4*)(ap0 + (kt) * 64); ra1 = *(const u32x4*)(ap1 + (kt) * 64); ra2 = *(const u32x4*)(ap2 + (kt) * 64); ra3 = *(const u32x4*)(ap3 + (kt) * 64); \
                         rb0 = *(const u32x4*)(bp0 + (kt) * 64); rb1 = *(const u32x4*)(bp1 + (kt) * 64); } while (0)
#define G_STOREL(buf) do { unsigned char* As_ = lds + (buf) * G_STAGE; unsigned char* Bs_ = As_ + G_ABYTES; \
        *(u32x4*)(As_ + soff) = ra0; *(u32x4*)(As_ + soff + 64 * G_LDT * 2) = ra1; *(u32x4*)(As_ + soff + 128 * G_LDT * 2) = ra2; *(u32x4*)(As_ + soff + 192 * G_LDT * 2) = ra3; \
        *(u32x4*)(Bs_ + soff) = rb0; *(u32x4*)(Bs_ + soff + 64 * G_LDT * 2) = rb1; } while (0)
    G_LOADG(0); G_STOREL(0); __syncthreads();
    for (int kt = 0; kt < nk; ++kt) {
        if (kt + 1 < nk) G_LOADG(kt + 1);
        const unsigned char* As = lds + (kt & 1) * G_STAGE; const unsigned char* Bs = As + G_ABYTES;
#pragma unroll
        for (int kk = 0; kk < 2; ++kk) {
            bf16x8 af[4], bfr[4];
#pragma unroll
            for (int m = 0; m < 4; ++m) af[m] = *(const bf16x8*)(As + ((wm * 64 + m * 16 + fr) * G_LDT + kk * 32 + fq * 8) * 2);
#pragma unroll
            for (int n = 0; n < 4; ++n) bfr[n] = *(const bf16x8*)(Bs + ((wn * 64 + n * 16 + fr) * G_LDT + kk * 32 + fq * 8) * 2);
#pragma unroll
            for (int m = 0; m < 4; ++m)
#pragma unroll
                for (int n = 0; n < 4; ++n) acc[m][n] = __builtin_amdgcn_mfma_f32_16x16x32_bf16(bfr[n], af[m], acc[m][n], 0, 0, 0);
        }
        if (kt + 1 < nk) G_STOREL((kt + 1) & 1);
        __syncthreads();
    }
#undef G_LOADG
#undef G_STOREL
}

__device__ __forceinline__ void phase_inproj(const Params& p, int layer, unsigned char* lds) {
    const int tid = get_tid(), lane = tid & 63, wave = tid >> 6, wm = wave >> 1, wn = wave & 1, fr = lane & 15, fq = lane >> 4;
    const bf16_t* hb = (const bf16_t*)(p.ws + OFF_HB);
    const bf16_t* wt = (const bf16_t*)(p.ws + OFF_WIN) + (size_t)layer * INW * D_;
    bf16_t* proj = (bf16_t*)(p.ws + OFF_PROJ);
    const float* rope = (const float*)(p.ws + OFF_ROPE);
    constexpr int NTM = R_ / 256, NTN = INW / 128;
    for (int t = blockIdx.x; t < NTM * NTN; t += gridDim.x) {
        const int tm = t / NTN, tn = t - tm * NTN;
        const bf16_t* ab = hb + (size_t)(tm * 256 + (tid >> 3)) * D_ + (tid & 7) * 8;
        const bf16_t* bb = wt + (size_t)(tn * 128 + (tid >> 3)) * D_ + (tid & 7) * 8;
        f32x4 acc[4][4];
        gemm_core(ab, ab + 64 * D_, ab + 128 * D_, ab + 192 * D_, bb, bb + 64 * D_, D_, lds, acc);
        const int col0 = tn * 128 + wn * 64;
        const bool is_rope = (tn <= 2) || (tn >= 4 && tn <= 6);
        const bool is_norm = (tn >= 4 && tn <= 6);
        const bool is_q = (tn <= 1) || (tn == 4) || (tn == 5);
        const bool is_silu = (tn >= 8 && tn <= 11);
        const float* nw = (tn == 6 ? p.k_norm_w : p.q_norm_w) + layer * 64;
#pragma unroll
        for (int m = 0; m < 4; ++m) {
            const int r = tm * 256 + wm * 64 + m * 16 + fr;
            const int b = r / TPB, pp = r - b * TPB;
            const bool latent = pp >= CTX_;
            const int nn = pp - CTX_, prow = nn >> 6, pcol = nn & 63;
            f32x4 v[4];
#pragma unroll
            for (int n = 0; n < 4; ++n) v[n] = acc[m][n];
            if (is_norm) {
                float ss = 0.f;
#pragma unroll
                for (int n = 0; n < 4; ++n) ss += (v[n].x * v[n].x + v[n].y * v[n].y) + (v[n].z * v[n].z + v[n].w * v[n].w);
                ss += __shfl_xor(ss, 16); ss += __shfl_xor(ss, 32);
                const float rs = rsqrtf(ss * (1.0f / 64.0f) + EPS_);
#pragma unroll
                for (int n = 0; n < 4; ++n) { const f32x4 wv = *(const f32x4*)(nw + n * 16 + 4 * fq); v[n].x *= rs * wv.x; v[n].y *= rs * wv.y; v[n].z *= rs * wv.z; v[n].w *= rs * wv.w; }
            }
            if (is_rope && latent) {
                const f32x4 cr0 = *(const f32x4*)(rope + (prow * 16 + 4 * fq) * 2), cr1 = *(const f32x4*)(rope + (prow * 16 + 4 * fq) * 2 + 4);
                const f32x4 cc0 = *(const f32x4*)(rope + (pcol * 16 + 4 * fq) * 2), cc1 = *(const f32x4*)(rope + (pcol * 16 + 4 * fq) * 2 + 4);
                f32x4 a = v[0], bq = v[1], o0, o1;
                o0.x = a.x * cr0.x - bq.x * cr0.y; o1.x = bq.x * cr0.x + a.x * cr0.y;
                o0.y = a.y * cr0.z - bq.y * cr0.w; o1.y = bq.y * cr0.z + a.y * cr0.w;
                o0.z = a.z * cr1.x - bq.z * cr1.y; o1.z = bq.z * cr1.x + a.z * cr1.y;
                o0.w = a.w * cr1.z - bq.w * cr1.w; o1.w = bq.w * cr1.z + a.w * cr1.w;
                v[0] = o0; v[1] = o1;
                a = v[2]; bq = v[3];
                o0.x = a.x * cc0.x - bq.x * cc0.y; o1.x = bq.x * cc0.x + a.x * cc0.y;
                o0.y = a.y * cc0.z - bq.y * cc0.w; o1.y = bq.y * cc0.z + a.y * cc0.w;
                o0.z = a.z * cc1.x - bq.z * cc1.y; o1.z = bq.z * cc1.x + a.z * cc1.y;
                o0.w = a.w * cc1.z - bq.w * cc1.w; o1.w = bq.w * cc1.z + a.w * cc1.w;
                v[2] = o0; v[3] = o1;
            }
            if (is_q) {
#pragma unroll
                for (int n = 0; n < 4; ++n) v[n] = v[n] * 0.125f;
            }
            if (is_silu) {
#pragma unroll
                for (int n = 0; n < 4; ++n) { v[n].x = v[n].x * sigmoidf_(v[n].x); v[n].y = v[n].y * sigmoidf_(v[n].y); v[n].z = v[n].z * sigmoidf_(v[n].z); v[n].w = v[n].w * sigmoidf_(v[n].w); }
            }
            bf16_t* dst = proj + (size_t)r * INW + col0 + 4 * fq;
#pragma unroll
            for (int n = 0; n < 4; ++n) { u32x2 o; o.x = pack2(v[n].x, v[n].y); o.y = pack2(v[n].z, v[n].w); *(u32x2*)(dst + n * 16) = o; }
        }
    }
}

__device__ __forceinline__ void cvt8(const u32x4 w, float* d) {
    d[0] = bflo(w.x); d[1] = bfhi(w.x); d[2] = bflo(w.y); d[3] = bfhi(w.y); d[4] = bflo(w.z); d[5] = bfhi(w.z); d[6] = bflo(w.w); d[7] = bfhi(w.w);
}

__device__ __forceinline__ void attn_naive_item(const Params& p, int layer, int item, unsigned char* ldsraw) {
    float* Ks = (float*)ldsraw; float* Vs = Ks + 64 * 128;
    const int mixer = item / 136, rem = item - mixer * 136, b = rem / 34, qb = rem - b * 34;
    const int tid = get_tid(), qi = tid & 127, h = tid >> 7, kv = h >> 1;
    const int p0 = qb * 128; const bool ctxblk = p0 < CTX_;
    const int r = b * TPB + p0 + qi;
    const bf16_t* proj = (const bf16_t*)(p.ws + OFF_PROJ);
    bf16_t* mix = (bf16_t*)(p.ws + OFF_MIX);
    const int qcol = (mixer == 0 ? 0 : 512) + h * 64, kcol = (mixer == 0 ? 256 : 768), vcol = (mixer == 0 ? 384 : 896);
    float q[64], o[64];
    {
        const u32x4* qp = (const u32x4*)(proj + (size_t)r * INW + qcol);
#pragma unroll
        for (int i = 0; i < 8; ++i) { const u32x4 w = qp[i]; cvt8(w, q + 8 * i); }
    }
#pragma unroll
    for (int d = 0; d < 64; ++d) o[d] = 0.f;
    float m, l;
    if (mixer == 0) { m = p.attn_sink[layer * 4 + h]; l = 1.f; } else { m = -1e30f; l = 0.f; }
    int tlo, thi;
    if (ctxblk) { tlo = 4; thi = 3; } else if (mixer == 1) { tlo = 4; thi = 67; } else { tlo = (p0 - 128) >> 6; if (tlo < 4) tlo = 4; thi = (p0 + 255) >> 6; if (thi > 67) thi = 67; }
    const int nq = p0 + qi - CTX_;
    const int ntile = 4 + (thi - tlo + 1);
    for (int ti = 0; ti < ntile; ++ti) {
        const int t = ti < 4 ? ti : tlo + ti - 4;
        __syncthreads();
#pragma unroll
        for (int i = 0; i < 2; ++i) {
            const int piece = tid + NT * i, j = piece >> 4, c8 = piece & 15;
            const bf16_t* row = proj + (size_t)(b * TPB + t * 64 + j) * INW;
            const u32x4 kw = *(const u32x4*)(row + kcol + c8 * 8), vw = *(const u32x4*)(row + vcol + c8 * 8);
            float tk[8], tv[8]; cvt8(kw, tk); cvt8(vw, tv);
            *(f32x4*)(Ks + j * 128 + c8 * 8) = (f32x4){tk[0], tk[1], tk[2], tk[3]}; *(f32x4*)(Ks + j * 128 + c8 * 8 + 4) = (f32x4){tk[4], tk[5], tk[6], tk[7]};
            *(f32x4*)(Vs + j * 128 + c8 * 8) = (f32x4){tv[0], tv[1], tv[2], tv[3]}; *(f32x4*)(Vs + j * 128 + c8 * 8 + 4) = (f32x4){tv[4], tv[5], tv[6], tv[7]};
        }
        __syncthreads();
        const bool masked = (mixer == 0) && (t >= 4);
        for (int jc = 0; jc < 64; jc += 8) {
            float s[8];
#pragma unroll
            for (int jj = 0; jj < 8; ++jj) {
                const float* kr = Ks + (jc + jj) * 128 + kv * 64;
                float a = 0.f;
#pragma unroll
                for (int d = 0; d < 64; ++d) a += q[d] * kr[d];
                if (masked) { const int nk = t * 64 + jc + jj - CTX_; const int df = nq - nk; if (df > 128 || df < -128) a = -1e30f; }
                s[jj] = a;
            }
            float mx = s[0];
#pragma unroll
            for (int jj = 1; jj < 8; ++jj) mx = fmaxf(mx, s[jj]);
            const float mn = fmaxf(m, mx), corr = __expf(m - mn);
            m = mn; l *= corr;
#pragma unroll
            for (int d = 0; d < 64; ++d) o[d] *= corr;
#pragma unroll
            for (int jj = 0; jj < 8; ++jj) {
                const float pj = __expf(s[jj] - m); l += pj;
                const float* vr = Vs + (jc + jj) * 128 + kv * 64;
#pragma unroll
                for (int d = 0; d < 64; ++d) o[d] += pj * vr[d];
            }
        }
    }
    const float inv = 1.f / l;
    u32x4* dst = (u32x4*)(mix + (size_t)r * D_ + (mixer == 0 ? 0 : 256) + h * 64);
#pragma unroll
    for (int i = 0; i < 8; ++i) { u32x4 w; w.x = pack2(o[8 * i] * inv, o[8 * i + 1] * inv); w.y = pack2(o[8 * i + 2] * inv, o[8 * i + 3] * inv); w.z = pack2(o[8 * i + 4] * inv, o[8 * i + 5] * inv); w.w = pack2(o[8 * i + 6] * inv, o[8 * i + 7] * inv); dst[i] = w; }
}

__device__ __forceinline__ int chain_pos(int dir, int cc, int j) { return dir == 0 ? cc * 64 + j : (cc < 4 ? (3 - cc) * 64 + 63 - j : TPB - 1 - ((cc - 4) * 64 + j)); }

__device__ __forceinline__ void hgrn_naive_item(const Params& p, int layer, int item, unsigned char* ldsraw) {
    float* Fs = (float*)ldsraw; float* Qs = Fs + 64 * 128; float* Vs = Qs + 64 * 128;
    const int dir = item & 1, h = (item >> 1) & 3, b = item >> 3;
    const int tid = get_tid(), wave = tid >> 6, lane = tid & 63, vv = wave * 16 + (lane & 15), kq = lane >> 4;
    const bf16_t* proj = (const bf16_t*)(p.ws + OFF_PROJ);
    float* obuf = (float*)(p.ws + (dir == 0 ? OFF_OF : OFF_OB));
    float S[32];
#pragma unroll
    for (int k = 0; k < 32; ++k) S[k] = 0.f;
    for (int cc = 0; cc < 68; ++cc) {
        __syncthreads();
#pragma unroll
        for (int i = 0; i < 2; ++i) {
            const int piece = tid + NT * i, j = piece >> 4, c8 = piece & 15;
            const int pp = chain_pos(dir, cc, j);
            const bf16_t* row = proj + (size_t)(b * TPB + pp) * INW;
            const u32x4 zw = *(const u32x4*)(row + (dir == 0 ? 1536 : 2048) + h * 128 + c8 * 8);
            const u32x4 qw = *(const u32x4*)(row + 1024 + h * 128 + c8 * 8);
            const u32x4 vw = *(const u32x4*)(row + 2560 + h * 128 + c8 * 8);
            float tz[8], tq[8], tv[8]; cvt8(zw, tz); cvt8(qw, tq); cvt8(vw, tv);
#pragma unroll
            for (int e = 0; e < 8; ++e) {
                float lb = 0.f;
                if (layer == 1) { const int ix = dir * 512 + h * 128 + c8 * 8 + e; lb = sigmoidf_(p.hgrn_lb[1024 + ix] - p.hgrn_lb[ix]); }
                tz[e] = lb + (1.f - lb) * sigmoidf_(tz[e]);
            }
            *(f32x4*)(Fs + j * 128 + c8 * 8) = (f32x4){tz[0], tz[1], tz[2], tz[3]}; *(f32x4*)(Fs + j * 128 + c8 * 8 + 4) = (f32x4){tz[4], tz[5], tz[6], tz[7]};
            *(f32x4*)(Qs + j * 128 + c8 * 8) = (f32x4){tq[0], tq[1], tq[2], tq[3]}; *(f32x4*)(Qs + j * 128 + c8 * 8 + 4) = (f32x4){tq[4], tq[5], tq[6], tq[7]};
            *(f32x4*)(Vs + j * 128 + c8 * 8) = (f32x4){tv[0], tv[1], tv[2], tv[3]}; *(f32x4*)(Vs + j * 128 + c8 * 8 + 4) = (f32x4){tv[4], tv[5], tv[6], tv[7]};
        }
        __syncthreads();
        for (int j = 0; j < 64; ++j) {
            const float vj = Vs[j * 128 + vv];
            const float* fr = Fs + j * 128 + kq * 32; const float* qr = Qs + j * 128 + kq * 32;
            float oacc = 0.f;
#pragma unroll
            for (int kk = 0; kk < 32; ++kk) { const float f = fr[kk]; S[kk] = vj + f * (S[kk] - vj); oacc += qr[kk] * S[kk]; }
            oacc += __shfl_xor(oacc, 16); oacc += __shfl_xor(oacc, 32);
            if (kq == 0) obuf[(size_t)(b * TPB + chain_pos(dir, cc, j)) * 512 + h * 128 + vv] = oacc;
        }
    }
}

__device__ __forceinline__ void phase_mixers(const Params& p, int layer, unsigned char* lds) {
    constexpr int N_H = 32, N_A = 272;
    for (int it = blockIdx.x; it < N_H + N_A; it += gridDim.x) {
        if (it < N_H) hgrn_naive_item(p, layer, it, lds);
        else {
            int a = it - N_H;
            a = a < 136 ? a + 136 : a - 136;
            attn_naive_item(p, layer, a, lds);
        }
        __syncthreads();
    }
}

__device__ __forceinline__ void phase_readout(const Params& p, int layer) {
    const int tid = get_tid(), wave = tid >> 6, lane = tid & 63;
    const float* of = (const float*)(p.ws + OFF_OF); const float* ob = (const float*)(p.ws + OFF_OB);
    const bf16_t* proj = (const bf16_t*)(p.ws + OFF_PROJ); bf16_t* mix = (bf16_t*)(p.ws + OFF_MIX);
    const float* gw = p.gate_norm_w + layer * 128;
    for (int r = blockIdx.x * 8 + wave; r < R_; r += gridDim.x * 8) {
        const int c = lane * 8;
        const f32x4 a0 = *(const f32x4*)(of + (size_t)r * 512 + c), a1 = *(const f32x4*)(of + (size_t)r * 512 + c + 4);
        const f32x4 b0 = *(const f32x4*)(ob + (size_t)r * 512 + c), b1 = *(const f32x4*)(ob + (size_t)r * 512 + c + 4);
        float o[8] = {a0.x + b0.x, a0.y + b0.y, a0.z + b0.z, a0.w + b0.w, a1.x + b1.x, a1.y + b1.y, a1.z + b1.z, a1.w + b1.w};
        float ss = 0.f;
#pragma unroll
        for (int e = 0; e < 8; ++e) ss += o[e] * o[e];
        ss += __shfl_xor(ss, 1); ss += __shfl_xor(ss, 2); ss += __shfl_xor(ss, 4); ss += __shfl_xor(ss, 8);
        const float rs = rsqrtf(ss * (1.0f / 128.0f) + EPS_);
        const u32x4 gwd = *(const u32x4*)(proj + (size_t)r * INW + 3072 + c);
        float g[8]; cvt8(gwd, g);
        const int vb = (lane & 15) * 8;
        float y[8];
#pragma unroll
        for (int e = 0; e < 8; ++e) y[e] = o[e] * rs * gw[vb + e] * (g[e] * sigmoidf_(g[e]));
        u32x4 w; w.x = pack2(y[0], y[1]); w.y = pack2(y[2], y[3]); w.z = pack2(y[4], y[5]); w.w = pack2(y[6], y[7]);
        *(u32x4*)(mix + (size_t)r * D_ + 512 + c) = w;
    }
}

__device__ __forceinline__ void phase_outproj(const Params& p, int layer, unsigned char* lds) {
    const int tid = get_tid(), lane = tid & 63, wave = tid >> 6, wm = wave >> 1, wn = wave & 1, fr = lane & 15, fq = lane >> 4;
    const bf16_t* mix = (const bf16_t*)(p.ws + OFF_MIX);
    const bf16_t* wt = (const bf16_t*)(p.ws + OFF_WOUT) + (size_t)layer * D_ * D_;
    float* xs = (float*)(p.ws + OFF_XS);
    const float* modv = (const float*)(p.ws + OFF_MOD) + (size_t)layer * 5 * 6144;
    constexpr int NTM = R_ / 256, NTN = D_ / 128;
    for (int t = blockIdx.x; t < NTM * NTN; t += gridDim.x) {
        const int tm = t / NTN, tn = t - tm * NTN;
        const bf16_t* ab = mix + (size_t)(tm * 256 + (tid >> 3)) * D_ + (tid & 7) * 8;
        const bf16_t* bb = wt + (size_t)(tn * 128 + (tid >> 3)) * D_ + (tid & 7) * 8;
        f32x4 acc[4][4];
        gemm_core(ab, ab + 64 * D_, ab + 128 * D_, ab + 192 * D_, bb, bb + 64 * D_, D_, lds, acc);
        const int col0 = tn * 128 + wn * 64 + 4 * fq;
#pragma unroll
        for (int m = 0; m < 4; ++m) {
            const int r = tm * 256 + wm * 64 + m * 16 + fr;
            const int b = r / TPB, pp = r - b * TPB;
            const float* g1 = modv + (size_t)(pp < CTX_ ? 4 : b) * 6144 + 2048;
#pragma unroll
            for (int n = 0; n < 4; ++n) {
                float* xp = xs + (size_t)r * D_ + col0 + n * 16;
                const f32x4 gv = *(const f32x4*)(g1 + col0 + n * 16); f32x4 xv = *(const f32x4*)xp;
                xv = xv + gv * acc[m][n];
                *(f32x4*)xp = xv;
            }
        }
    }
}

constexpr int RW_LD = 1028;
__device__ __forceinline__ void phase_router(const Params& p, int layer, unsigned char* ldsraw) {
    float* RW = (float*)ldsraw;
    const int tid = get_tid(), wave = tid >> 6, lane = tid & 63;
    for (int i = tid; i < 32768; i += NT) { const int c = i >> 5, e = i & 31; RW[e * RW_LD + c] = p.router_w[(size_t)layer * 32768 + i]; }
    __syncthreads();
    float* xs = (float*)(p.ws + OFF_XS); bf16_t* hb = (bf16_t*)(p.ws + OFF_HB);
    const float* modv = (const float*)(p.ws + OFF_MOD) + (size_t)layer * 5 * 6144;
    int* cnt = (int*)(p.ws + OFF_CTL) + layer * 32;
    int* eid = (int*)(p.ws + OFF_EID); float* gate = (float*)(p.ws + OFF_GATE); int* posn = (int*)(p.ws + OFF_POS);
    for (int r = blockIdx.x * 8 + wave; r < R_; r += gridDim.x * 8) {
        const int b = r / TPB, pp = r - b * TPB;
        f32x4 v[4], hv[4];
#pragma unroll
        for (int j = 0; j < 4; ++j) v[j] = *(const f32x4*)(xs + (size_t)r * D_ + 4 * lane + 256 * j);
        const float rstd = row_rstd(v);
        const float* mv = modv + (size_t)(pp < CTX_ ? 4 : b) * 6144;
        norm_mod_store(v, rstd, p.norm2_w + layer * D_, mv + 4096, mv + 3072, hb + (size_t)r * D_, lane, hv);
        float myv = -3.0e38f;
        const float rbias = p.router_b[layer * 32 + (lane & 31)];
#pragma unroll 2
        for (int e = 0; e < 32; ++e) {
            float a = 0.f;
#pragma unroll
            for (int j = 0; j < 4; ++j) { const f32x4 w = *(const f32x4*)(RW + e * RW_LD + 4 * lane + 256 * j); a += (hv[j].x * w.x + hv[j].y * w.y) + (hv[j].z * w.z + hv[j].w * w.w); }
            const float s = wave_sum(a);
            if (lane == e) myv = s + rbias;
        }
        int sel[4]; float sv[4];
#pragma unroll
        for (int t = 0; t < 4; ++t) {
            float bv = myv; int bi = lane;
#pragma unroll
            for (int o = 1; o < 64; o <<= 1) { const float ov = __shfl_xor(bv, o); const int oi = __shfl_xor(bi, o); const bool take = (ov > bv) || (ov == bv && oi < bi); bv = take ? ov : bv; bi = take ? oi : bi; }
            sel[t] = bi; sv[t] = bv; if (lane == bi) myv = -3.0e38f;
        }
        const float e0 = 1.f, e1 = __expf(sv[1] - sv[0]), e2 = __expf(sv[2] - sv[0]), e3 = __expf(sv[3] - sv[0]);
        const float isum = 1.f / (e0 + e1 + e2 + e3);
        if (lane == 0) {
            const float gs[4] = {e0 * isum, e1 * isum, e2 * isum, e3 * isum};
#pragma unroll
            for (int t = 0; t < 4; ++t) { const int pos = atomicAdd(cnt + sel[t], 1); eid[r * 4 + t] = sel[t]; gate[r * 4 + t] = gs[t]; posn[r * 4 + t] = pos; }
        }
    }
}

__device__ __forceinline__ void moe_offsets(const Params& p, int layer, int* off) {
    if (get_tid() == 0) { const int* cnt = (const int*)(p.ws + OFF_CTL) + layer * 32; int a = 0; for (int e = 0; e < 32; ++e) { off[e] = a; a += (cnt[e] + 255) & ~255; } off[32] = a; }
    __syncthreads();
}

__device__ __forceinline__ void phase_scatter(const Params& p, int layer, unsigned char* ldsraw) {
    int* off = (int*)ldsraw;
    moe_offsets(p, layer, off);
    const int* cnt = (const int*)(p.ws + OFF_CTL) + layer * 32;
    const int* eid = (const int*)(p.ws + OFF_EID); const int* posn = (const int*)(p.ws + OFF_POS); int* rowl = (int*)(p.ws + OFF_ROWL);
    const int gt = blockIdx.x * NT + get_tid(), ngt = gridDim.x * NT;
    for (int i = gt; i < R_ * 4; i += ngt) rowl[off[eid[i]] + posn[i]] = i;
    for (int e = 0; e < 32; ++e) { const int c = cnt[e], pe = off[e + 1] - off[e]; for (int i = c + gt; i < pe; i += ngt) rowl[off[e] + i] = -1; }
}

__device__ __forceinline__ void phase_moe1(const Params& p, int layer, unsigned char* lds) {
    int* off = (int*)(lds + G_LDS);
    moe_offsets(p, layer, off);
    const int tid = get_tid(), lane = tid & 63, wave = tid >> 6, wm = wave >> 1, wn = wave & 1, fr = lane & 15, fq = lane >> 4;
    const bf16_t* hb = (const bf16_t*)(p.ws + OFF_HB);
    const bf16_t* w1t = (const bf16_t*)(p.ws + OFF_W1) + (size_t)layer * NE * 2048 * D_;
    const int* rowl = (const int*)(p.ws + OFF_ROWL);
    bf16_t* act = (bf16_t*)(p.ws + OFF_ACT);
    const int ntm = off[32] >> 8;
    for (int t = blockIdx.x; t < ntm * 16; t += gridDim.x) {
        const int tm = t >> 4, tn = t & 15;
        int e = 0;
#pragma unroll
        for (int q = 1; q < 32; ++q) e += (off[q] <= tm * 256) ? 1 : 0;
        const bf16_t* ap[4];
#pragma unroll
        for (int i = 0; i < 4; ++i) { const int idx = rowl[tm * 256 + (tid >> 3) + 64 * i]; const int tok = idx < 0 ? 0 : (idx >> 2); ap[i] = hb + (size_t)tok * D_ + (tid & 7) * 8; }
        const bf16_t* bb = w1t + ((size_t)e * 2048 + tn * 128 + (tid >> 3)) * D_ + (tid & 7) * 8;
        f32x4 acc[4][4];
        gemm_core(ap[0], ap[1], ap[2], ap[3], bb, bb + 64 * D_, D_, lds, acc);
        const int ucol0 = tn * 128 + wn * 64 + 4 * fq;
        const float* b1 = p.b1 + ((size_t)layer * NE + e) * 2048;
#pragma unroll
        for (int m = 0; m < 4; ++m) {
            const int prow = tm * 256 + wm * 64 + m * 16 + fr;
#pragma unroll
            for (int n = 0; n < 4; ++n) {
                const f32x4 bv = *(const f32x4*)(b1 + ucol0 + n * 16);
                const f32x4 u = acc[m][n] + bv;
                const float g0 = fminf(u.x, 7.f), l0 = fminf(fmaxf(u.y, -7.f), 7.f), g1 = fminf(u.z, 7.f), l1 = fminf(fmaxf(u.w, -7.f), 7.f);
                const float y0 = g0 * sigmoidf_(1.702f * g0) * (l0 + 1.f), y1 = g1 * sigmoidf_(1.702f * g1) * (l1 + 1.f);
                *(unsigned*)(act + (size_t)prow * DFF + ((ucol0 + n * 16) >> 1)) = pack2(y0, y1);
            }
        }
    }
}

__device__ __forceinline__ void phase_moe2(const Params& p, int layer, unsigned char* lds) {
    int* off = (int*)(lds + G_LDS);
    moe_offsets(p, layer, off);
    const int tid = get_tid(), lane = tid & 63, wave = tid >> 6, wm = wave >> 1, wn = wave & 1, fr = lane & 15, fq = lane >> 4;
    const bf16_t* act = (const bf16_t*)(p.ws + OFF_ACT);
    const bf16_t* w2t = (const bf16_t*)(p.ws + OFF_W2) + (size_t)layer * NE * D_ * DFF;
    const int* rowl = (const int*)(p.ws + OFF_ROWL); const float* gate = (const float*)(p.ws + OFF_GATE);
    bf16_t* ybuf = (bf16_t*)(p.ws + OFF_YBUF);
    const int ntm = off[32] >> 8;
    for (int t = blockIdx.x; t < ntm * 8; t += gridDim.x) {
        const int tm = t >> 3, tn = t & 7;
        int e = 0;
#pragma unroll
        for (int q = 1; q < 32; ++q) e += (off[q] <= tm * 256) ? 1 : 0;
        const bf16_t* ab = act + (size_t)(tm * 256 + (tid >> 3)) * DFF + (tid & 7) * 8;
        const bf16_t* bb = w2t + ((size_t)e * D_ + tn * 128 + (tid >> 3)) * DFF + (tid & 7) * 8;
        f32x4 acc[4][4];
        gemm_core(ab, ab + 64 * DFF, ab + 128 * DFF, ab + 192 * DFF, bb, bb + 64 * DFF, DFF, lds, acc);
        const int col0 = tn * 128 + wn * 64 + 4 * fq;
        const float* b2 = p.b2 + ((size_t)layer * NE + e) * D_;
#pragma unroll
        for (int m = 0; m < 4; ++m) {
            const int prow = tm * 256 + wm * 64 + m * 16 + fr;
            const int idx = rowl[prow];
            if (idx >= 0) {
                const float g = gate[idx];
#pragma unroll
                for (int n = 0; n < 4; ++n) {
                    const f32x4 bv = *(const f32x4*)(b2 + col0 + n * 16);
                    const f32x4 y = (acc[m][n] + bv) * g;
                    u32x2 o; o.x = pack2(y.x, y.y); o.y = pack2(y.z, y.w);
                    *(u32x2*)(ybuf + (size_t)idx * D_ + col0 + n * 16) = o;
                }
            }
        }
    }
}

__device__ __forceinline__ void phase_combine(const Params& p, int layer) {
    const int tid = get_tid(), wave = tid >> 6, lane = tid & 63;
    float* xs = (float*)(p.ws + OFF_XS); bf16_t* hb = (bf16_t*)(p.ws + OFF_HB); const bf16_t* ybuf = (const bf16_t*)(p.ws + OFF_YBUF);
    const float* modv = (const float*)(p.ws + OFF_MOD);
    for (int r = blockIdx.x * 8 + wave; r < R_; r += gridDim.x * 8) {
        const int b = r / TPB, pp = r - b * TPB;
        const int mi = pp < CTX_ ? 4 : b;
        const float* g2 = modv + (size_t)(layer * 5 + mi) * 6144 + 5120;
        f32x4 v[4], hv[4];
#pragma unroll
        for (int j = 0; j < 4; ++j) {
            const int c = 4 * lane + 256 * j;
            f32x4 f = (f32x4){0.f, 0.f, 0.f, 0.f};
#pragma unroll
            for (int s = 0; s < 4; ++s) { const u32x2 w = *(const u32x2*)(ybuf + ((size_t)r * 4 + s) * D_ + c); f.x += bflo(w.x); f.y += bfhi(w.x); f.z += bflo(w.y); f.w += bfhi(w.y); }
            const f32x4 gv = *(const f32x4*)(g2 + c);
            v[j] = *(const f32x4*)(xs + (size_t)r * D_ + c) + gv * f;
        }
        const float rstd = row_rstd(v);
        if (layer == 0) {
#pragma unroll
            for (int j = 0; j < 4; ++j) *(f32x4*)(xs + (size_t)r * D_ + 4 * lane + 256 * j) = v[j];
            const float* mv = modv + (size_t)(5 + mi) * 6144;
            norm_mod_store(v, rstd, p.norm1_w + D_, mv + 1024, mv, hb + (size_t)r * D_, lane, hv);
        } else if (pp >= CTX_) {
            float* dst = p.out + ((size_t)b * SEQ_ + (pp - CTX_)) * D_;
#pragma unroll
            for (int j = 0; j < 4; ++j) { const int c = 4 * lane + 256 * j; const f32x4 wv = *(const f32x4*)(p.final_norm_w + c); f32x4 o; o.x = v[j].x * rstd * wv.x; o.y = v[j].y * rstd * wv.y; o.z = v[j].z * rstd * wv.z; o.w = v[j].w * rstd * wv.w; *(f32x4*)(dst + c) = o; }
        }
    }
}

constexpr int NPHASE = 20;
template <bool COOP>
__global__ void __launch_bounds__(NT) fwd_kernel(Params p, int lo, int hi) {
    extern __shared__ __attribute__((aligned(16))) unsigned char lds[];
#define PH(id, call) do { const int id_ = (id); if (lo <= id_ && id_ < hi) { call; if (COOP) { if (id_ + 1 < hi) cg::this_grid().sync(); } __syncthreads(); } } while (0)
    PH(0, phase_prep(p, lds));
    PH(1, phase_norm_in(p));
#pragma nounroll
    for (int L = 0; L < 2; ++L) {
        const int base = 2 + 9 * L;
        PH(base + 0, phase_inproj(p, L, lds));
        PH(base + 1, phase_mixers(p, L, lds));
        PH(base + 2, phase_readout(p, L));
        PH(base + 3, phase_outproj(p, L, lds));
        PH(base + 4, phase_router(p, L, lds));
        PH(base + 5, phase_scatter(p, L, lds));
        PH(base + 6, phase_moe1(p, L, lds));
        PH(base + 7, phase_moe2(p, L, lds));
        PH(base + 8, phase_combine(p, L));
    }
#undef PH
}

extern "C" void kernel_launch(void* const* d_in, const int* in_sizes, int n_in, void* d_out, int out_size, void* d_ws, size_t ws_size, hipStream_t stream) {
    static int grid = 0;
    if (grid == 0) {
        if (ws_size < WS_END) { fprintf(stderr, "kernel_launch: workspace too small (%zu < %zu)\n", ws_size, (size_t)WS_END); grid = -1; return; }
        int dev = 0, cus = 0, per_cu = 0;
        hipGetDevice(&dev);
        hipDeviceGetAttribute(&cus, hipDeviceAttributeMultiprocessorCount, dev);
        hipFuncSetAttribute((const void*)fwd_kernel<true>, hipFuncAttributeMaxDynamicSharedMemorySize, LDS_BYTES);
        hipFuncSetAttribute((const void*)fwd_kernel<false>, hipFuncAttributeMaxDynamicSharedMemorySize, LDS_BYTES);
        hipOccupancyMaxActiveBlocksPerMultiprocessor(&per_cu, (const void*)fwd_kernel<true>, NT, LDS_BYTES);
        if (per_cu < 1) per_cu = 1;
        if (per_cu > 1) per_cu = 1;
        grid = cus * per_cu;
        (void)hipGetLastError();
    }
    if (grid < 0) return;
    Params p{};
    const float** pin = (const float**)&p;
    for (int i = 0; i < 22; ++i) pin[i] = (const float*)d_in[i];
    p.out = (float*)d_out; p.ws = (unsigned char*)d_ws;
#if MEGA
    int lo = 0, hi = NPHASE;
    void* args[] = {&p, &lo, &hi};
    hipError_t e = hipLaunchCooperativeKernel((const void*)fwd_kernel<true>, dim3(grid), dim3(NT), args, LDS_BYTES, stream);
    if (e != hipSuccess) fprintf(stderr, "cooperative launch failed: %s (grid %d)\n", hipGetErrorString(e), grid);
#else
    for (int ph = 0; ph < NPHASE; ++ph) hipLaunchKernelGGL(fwd_kernel<false>, dim3(grid), dim3(NT), LDS_BYTES, stream, p, ph, ph + 1);
#endif
}
```

```cpp
#include <hip/hip_runtime.h>
#include <hip/hip_cooperative_groups.h>
#include <stdint.h>
#include <stdio.h>
namespace cg = cooperative_groups;

#ifndef MEGA
#define MEGA 1
#endif
#ifndef PROBE
#define PROBE 0
#endif
#define PROBE_MASK1 0x0
#define PROBE_MASK2 0x0

typedef unsigned short bf16_t;
typedef short bf16x8 __attribute__((ext_vector_type(8)));
typedef float f32x4 __attribute__((ext_vector_type(4)));
typedef unsigned u32x4 __attribute__((ext_vector_type(4)));
typedef unsigned u32x2 __attribute__((ext_vector_type(2)));

#define NT 512
constexpr int D_ = 1024, NB_ = 4, SEQ_ = 4096, CTX_ = 256, TPB = 4352, R_ = NB_ * TPB, INW = 3584, NE = 32, DFF = 1024;
constexpr float EPS_ = 1e-6f;
constexpr int PMAX = 77824;
constexpr int LDS_BYTES = 147456;
constexpr int ROWE_CAP = R_;

constexpr size_t OFF_CTL = 0;
constexpr size_t OFF_ROPE = 65536;
constexpr size_t OFF_MOD = 131072;
constexpr size_t OFF_WIN = 1u << 20;
constexpr size_t OFF_WOUT = OFF_WIN + (size_t)2 * INW * D_ * 2;
constexpr size_t OFF_W1 = OFF_WOUT + (size_t)2 * D_ * D_ * 2;
constexpr size_t OFF_W2 = OFF_W1 + (size_t)2 * NE * 2048 * D_ * 2;
constexpr size_t OFF_XS = OFF_W2 + (size_t)2 * NE * D_ * DFF * 2;
constexpr size_t OFF_HB = OFF_XS + (size_t)R_ * D_ * 4;
constexpr size_t OFF_PROJ = OFF_HB + (size_t)R_ * D_ * 2;
constexpr size_t OFF_MIX = OFF_PROJ + (size_t)R_ * INW * 2;
constexpr size_t OFF_OF = OFF_MIX + (size_t)R_ * D_ * 2;
constexpr size_t OFF_OB = OFF_OF + (size_t)R_ * 512 * 4;
constexpr size_t OFF_EID = OFF_OB + (size_t)R_ * 512 * 4;
constexpr size_t OFF_GATE = OFF_EID + (size_t)R_ * 16;
constexpr size_t OFF_POS = OFF_GATE + (size_t)R_ * 16;
constexpr size_t OFF_ROWL = OFF_POS + (size_t)R_ * 16;
constexpr size_t OFF_ACT = OFF_ROWL + (size_t)PMAX * 4;
constexpr size_t OFF_YBUF = OFF_ACT + (size_t)PMAX * DFF * 2;
constexpr size_t OFF_LT = OFF_YBUF + (size_t)R_ * 4 * D_ * 2;
constexpr size_t OFF_SB = OFF_LT + (size_t)2176 * 16384 * 2;
constexpr size_t OFF_DEC = OFF_SB + (size_t)2176 * 16384 * 2;
constexpr size_t OFF_QH = OFF_DEC + (size_t)2176 * 128 * 4;
constexpr size_t OFF_ROWE = OFF_QH + (size_t)2176 * 8192 * 2;
constexpr size_t WS_END = OFF_ROWE + (size_t)NE * ROWE_CAP * 4;
constexpr size_t OFF_LB = 4096;
constexpr int LDS_ROPE = 135168;
constexpr size_t OFF_BAR = 16384;
constexpr size_t OFF_TS = 32768;
constexpr size_t OFF_HS = OFF_PROJ;
static_assert((size_t)PMAX * D_ * 2 <= (size_t)R_ * INW * 2 + (size_t)R_ * D_ * 2, "hs overlay");

struct Params {
    const float *x, *c, *ctx, *c_ctx, *w_mod, *b_mod, *norm1_w, *norm2_w, *w_in, *w_out, *attn_sink, *q_norm_w, *k_norm_w, *hgrn_lb,
        *gate_norm_w, *router_w, *router_b, *w1, *b1, *w2, *b2, *final_norm_w;
    float* out;
    unsigned char* ws;
};

typedef const __attribute__((address_space(4))) Params& PRef;
typedef __bf16 bf2_t __attribute__((ext_vector_type(2)));
__device__ __forceinline__ unsigned pack2(float lo, float hi) { bf2_t v; v.x = (__bf16)lo; v.y = (__bf16)hi; return __builtin_bit_cast(unsigned, v); }
__device__ __forceinline__ unsigned f2bf(float f) { return pack2(f, 0.f) & 0xffffu; }
__device__ __forceinline__ float bflo(unsigned w) { return __uint_as_float(w << 16); }
__device__ __forceinline__ float bfhi(unsigned w) { return __uint_as_float(w & 0xffff0000u); }
__device__ __forceinline__ float wave_sum(float v) {
#pragma unroll
    for (int o = 1; o < 64; o <<= 1) v += __shfl_xor(v, o);
    return v;
}
__device__ __forceinline__ int get_tid() { int t = threadIdx.x; asm volatile("" : "+v"(t)); return t; }
__device__ __forceinline__ int get_bid() { int t = blockIdx.x; asm volatile("" : "+s"(t)); return t; }
__device__ __forceinline__ int get_nblk() { int t = gridDim.x; asm volatile("" : "+s"(t)); return t; }
__device__ __forceinline__ float sigmoidf_(float z) { return 1.f / (1.f + __expf(-z)); }

__device__ __forceinline__ int perm_row(int c, int perm) {
    const int lc = c & 255;
    if (perm == 1) { const int wcc = lc >> 6, dim = lc & 63; return (c & ~255) + 128 * (dim >> 5) + 32 * wcc + (dim & 31); }
    if (perm == 2) { const int wcc = lc >> 6, fq = (lc >> 4) & 3, bj = (lc >> 3) & 1, n = (lc >> 2) & 1, i = lc & 3; return (c & ~255) + 128 * bj + 32 * wcc + 16 * n + 4 * fq + i; }
    return c;
}
__device__ __forceinline__ void prep_transpose_item(const float* __restrict__ src, int K, int N, bf16_t* __restrict__ dst, int item, int perm, unsigned char* lds) {
    constexpr int LDO = 72;
    const int nb = N >> 8, kb = item / nb, nbk = item - kb * nb, k0 = kb * 64, n0 = nbk * 256, tid = get_tid(), kc = tid >> 6, lane = tid & 63;
    const float* s = src + (size_t)(k0 + kc * 8) * N + n0 + 4 * lane;
    f32x4 v[8];
#pragma unroll
    for (int j = 0; j < 8; ++j) v[j] = *(const f32x4*)(s + (size_t)j * N);
    bf16_t* img = (bf16_t*)lds;
#pragma unroll
    for (int ni = 0; ni < 4; ++ni) {
        u32x4 w;
        w.x = pack2(v[0][ni], v[1][ni]); w.y = pack2(v[2][ni], v[3][ni]); w.z = pack2(v[4][ni], v[5][ni]); w.w = pack2(v[6][ni], v[7][ni]);
        *(u32x4*)(img + (4 * lane + ni) * LDO + kc * 8) = w;
    }
    __syncthreads();
#pragma unroll
    for (int i = 0; i < 4; ++i) {
        const int n = (tid >> 3) + 64 * i, pc = tid & 7;
        const u32x4 w = *(const u32x4*)(img + n * LDO + pc * 8);
        *(u32x4*)(dst + (size_t)perm_row(n0 + n, perm) * K + k0 + pc * 8) = w;
    }
    __syncthreads();
}

constexpr int N_MOECONV = 32 * 128 + 32 * 64;
constexpr int CV_OUTTAIL = 240 * 8, CV_INTAIL = 72 * 8;
__device__ __forceinline__ void moe_conv_item(PRef p, int layer, int idx, unsigned char* lds) {
    if (idx < 4096) { const int m = layer * 32 + (idx >> 7), ii = idx & 127; prep_transpose_item(p.w1 + (size_t)m * D_ * 2048, D_, 2048, (bf16_t*)(p.ws + OFF_W1) + (size_t)m * 2048 * D_, ii, 2, lds); }
    else { const int j = idx - 4096, m = layer * 32 + (j >> 6), ii = j & 63; prep_transpose_item(p.w2 + (size_t)m * DFF * D_, DFF, D_, (bf16_t*)(p.ws + OFF_W2) + (size_t)m * D_ * DFF, ii, 2, lds); }
}

__device__ __forceinline__ void prep_mod_item(PRef p, int item, float* lds) {
    const int l = item / 96, col0 = (item - l * 96) * 64, tid = get_tid();
    float* s = lds;
    float* red = lds + 5 * 1024;
    for (int i = tid; i < 5 * 1024; i += NT) { const int row = i >> 10, k = i & 1023; const float cv = row < 4 ? p.c[row * 1024 + k] : p.c_ctx[k]; s[i] = cv / (1.f + __expf(-cv)); }
    __syncthreads();
    const int col = tid & 63, kq = tid >> 6;
    const float* w = p.w_mod + (size_t)l * 1024 * 6144 + col0 + col;
    float a0 = 0.f, a1 = 0.f, a2 = 0.f, a3 = 0.f, a4 = 0.f;
#pragma unroll 8
    for (int k = kq * 128; k < kq * 128 + 128; ++k) {
        const float wv = w[(size_t)k * 6144];
        a0 += s[k] * wv; a1 += s[1024 + k] * wv; a2 += s[2048 + k] * wv; a3 += s[3072 + k] * wv; a4 += s[4096 + k] * wv;
    }
    red[(kq * 5 + 0) * 64 + col] = a0; red[(kq * 5 + 1) * 64 + col] = a1; red[(kq * 5 + 2) * 64 + col] = a2; red[(kq * 5 + 3) * 64 + col] = a3; red[(kq * 5 + 4) * 64 + col] = a4;
    __syncthreads();
    if (tid < 320) {
        const int r = tid >> 6, c = tid & 63; float sum = 0.f;
#pragma unroll
        for (int q = 0; q < 8; ++q) sum += red[(q * 5 + r) * 64 + c];
        float* modv = (float*)(p.ws + OFF_MOD);
        modv[(size_t)(l * 5 + r) * 6144 + col0 + c] = sum + p.b_mod[l * 6144 + col0 + c];
    }
    __syncthreads();
}

__device__ __forceinline__ void phase_prep(PRef p, unsigned char* ldsraw) {
    float* lds = (float*)ldsraw;
    const int tid = get_tid();
    constexpr int N_MOD = 192, N_MISC = 1, N_WIN = 2 * 16 * 14, N_WOUT = 2 * 16 * 4;
    constexpr int NITEMS = N_MOD + N_MISC + N_WIN + N_WOUT;
    for (int it = get_bid(); it < NITEMS; it += get_nblk()) {
        int r = it;
        if (r < N_MOD) { prep_mod_item(p, r, lds); continue; } r -= N_MOD;
        if (r < N_MISC) {
            float* tab = (float*)(p.ws + OFF_ROPE);
            for (int i = tid; i < 1024; i += NT) { const int pos = i >> 4, fi = i & 15; const float inv = 1.0f / powf(10000.0f, (float)(2 * fi) / 32.0f); const float ang = (float)pos * inv; tab[2 * i] = cosf(ang); tab[2 * i + 1] = sinf(ang); }
            int* cnt = (int*)(p.ws + OFF_CTL);
            if (tid < 64) cnt[tid] = 0;
            float* lbt = (float*)(p.ws + OFF_LB);
            for (int i = tid; i < 1024; i += NT) lbt[i] = sigmoidf_(p.hgrn_lb[1024 + i] - p.hgrn_lb[i]);
            continue;
        } r -= N_MISC;
        if (r < N_WIN) { const int l = r / (16 * 14), ii = r - l * 16 * 14; prep_transpose_item(p.w_in + (size_t)l * D_ * INW, D_, INW, (bf16_t*)(p.ws + OFF_WIN) + (size_t)l * INW * D_, ii, 1, ldsraw); continue; } r -= N_WIN;
        { const int l = r / 64, ii = r - l * 64; prep_transpose_item(p.w_out + (size_t)l * D_ * D_, D_, D_, (bf16_t*)(p.ws + OFF_WOUT) + (size_t)l * D_ * D_, ii, 2, ldsraw); }
    }
}

__device__ __forceinline__ float row_rstd(const f32x4 (&v)[4]) {
    float ss = 0.f;
#pragma unroll
    for (int j = 0; j < 4; ++j) ss += (v[j].x * v[j].x + v[j].y * v[j].y) + (v[j].z * v[j].z + v[j].w * v[j].w);
    return rsqrtf(wave_sum(ss) * (1.0f / D_) + EPS_);
}
#define SCHED_FENCE() __builtin_amdgcn_sched_barrier(0)
__device__ __forceinline__ void load_row4(const float* src, int lane, f32x4 (&v)[4]) {
#pragma unroll
    for (int j = 0; j < 4; ++j) v[j] = *(const f32x4*)(src + 4 * lane + 256 * j);
}
__device__ __forceinline__ void norm_apply_store(const f32x4 (&v)[4], float rstd, const f32x4 (&wv)[4], const f32x4 (&scv)[4], const f32x4 (&shv)[4], bf16_t* dst, int lane, f32x4 (&hv)[4]) {
#pragma unroll
    for (int j = 0; j < 4; ++j) {
        f32x4 h;
        h.x = (v[j].x * rstd * wv[j].x) * (1.f + scv[j].x) + shv[j].x; h.y = (v[j].y * rstd * wv[j].y) * (1.f + scv[j].y) + shv[j].y;
        h.z = (v[j].z * rstd * wv[j].z) * (1.f + scv[j].z) + shv[j].z; h.w = (v[j].w * rstd * wv[j].w) * (1.f + scv[j].w) + shv[j].w;
        hv[j] = h;
        u32x2 o; o.x = pack2(h.x, h.y); o.y = pack2(h.z, h.w);
        *(u32x2*)(dst + 4 * lane + 256 * j) = o;
    }
}

__device__ __forceinline__ void phase_norm_in(PRef p) {
    const int tid = get_tid(), wave = tid >> 6, lane = tid & 63;
    float* xs = (float*)(p.ws + OFF_XS); bf16_t* hb = (bf16_t*)(p.ws + OFF_HB); const float* modv = (const float*)(p.ws + OFF_MOD);
    f32x4 wv[4]; load_row4(p.norm1_w, lane, wv);
    const int stride = get_nblk() * 8;
    int r = get_bid() * 8 + wave;
    f32x4 v[4], vn[4], scv[4], shv[4], hv[4];
#define NI_SRC(r_) (((r_) % TPB) < CTX_ ? p.ctx + ((size_t)((r_) / TPB) * CTX_ + ((r_) % TPB)) * D_ : p.x + ((size_t)((r_) / TPB) * SEQ_ + (((r_) % TPB) - CTX_)) * D_)
    if (r < R_) load_row4(NI_SRC(r), lane, v);
    for (; r < R_; r += stride) {
        const int b = r / TPB, pp = r - b * TPB;
        const float* mv = modv + (size_t)(pp < CTX_ ? 4 : b) * 6144;
        const int rn = (r + stride < R_) ? r + stride : r;
        load_row4(NI_SRC(rn), lane, vn); load_row4(mv + 1024, lane, scv); load_row4(mv, lane, shv);
        SCHED_FENCE();
#pragma unroll
        for (int j = 0; j < 4; ++j) *(f32x4*)(xs + (size_t)r * D_ + 4 * lane + 256 * j) = v[j];
        const float rstd = row_rstd(v);
        norm_apply_store(v, rstd, wv, scv, shv, hb + (size_t)r * D_, lane, hv);
#pragma unroll
        for (int j = 0; j < 4; ++j) v[j] = vn[j];
    }
#undef NI_SRC
}

namespace pg8 {
#define PG8_LAS __attribute__((address_space(3)))
constexpr int BM = 256, BK = 64, HALF = 128, HTB = HALF * BK * 2, STAGE_BYTES = 8 * HTB, NXCD = 8, WGM = 8;
__host__ __device__ __forceinline__ int lds_byte(int r, int c) { const int st = (r >> 4) * 2 + (c >> 5), rr = r & 15, cc = c & 31, ob = rr * 64 + cc * 2; return st * 1024 + (ob ^ (((ob >> 9) & 1) << 5)); }
__host__ __device__ __forceinline__ void stage_rc(int b, int& R, int& C) { const int st = b / 1024, sb = b % 1024, swz = sb ^ (((sb >> 9) & 1) << 5); R = (st >> 1) * 16 + swz / 64; C = (st & 1) * 32 + (swz % 64) / 2; }
__host__ __device__ __forceinline__ int perm32(int rho) { const int n = rho >> 4, i = rho & 15; return 8 * (i >> 2) + 4 * n + (i & 3); }
struct Unit { int pm, pn, aux; };
struct Gemm { const bf16_t* A; const bf16_t* Bt; int K; };
struct TileOrder {
    int nM, nN, nwg, G, c;
    __device__ __forceinline__ void init(int nM_, int nN_, int G_, int c_) { nM = nM_; nN = nN_; nwg = nM * nN; G = G_; c = c_; }
    __device__ __forceinline__ bool map(int i, int& pm, int& pn) const {
        const long L = (long)i * G + c; if (L >= nwg) return false;
        int wgid = (int)L; { const int q = nwg / NXCD, r = nwg % NXCD, xcd = wgid % NXCD, off = wgid / NXCD; wgid = (xcd < r ? xcd * (q + 1) : r * (q + 1) + (xcd - r) * q) + off; }
        const int nig = WGM * nN, gid = wgid / nig, fm = gid * WGM, gsz = (nM - fm) < WGM ? (nM - fm) : WGM;
        pm = fm + ((wgid % nig) % gsz); pn = (wgid % nig) / gsz; return true;
    }
};
struct DenseSched : TileOrder {
    static constexpr bool GATHER = false;
    __device__ __forceinline__ bool next(int i, Unit& u) const { u.aux = 0; return map(i, u.pm, u.pn); }
    __device__ __forceinline__ void a_ready(const Unit&) const {}
    __device__ __forceinline__ void done(const Unit&) const {}
};
template <bool GATHER_>
struct MoeSched : TileOrder {
    static constexpr bool GATHER = GATHER_;
    const int* tab; const int* rowe; int K2;
    __device__ __forceinline__ bool next(int i, Unit& u) const {
        int pm, ln; if (!map(i, pm, ln)) return false;
        const int e = tab[96 + pm];
        u.pm = pm; u.pn = e * nN + ln; u.aux = (e << 8) | ln; return true;
    }
    __device__ __forceinline__ void gather(const Unit& u, int tid, unsigned (&go)[2][2]) const {
        const int e = u.aux >> 8, pos0 = u.pm * 256 - tab[e], c = tab[40 + e];
        int idx[2][2], C[2];
#pragma unroll
        for (int i = 0; i < 2; ++i) {
            int R; stage_rc(tid * 16 + i * 8192, R, C[i]);
#pragma unroll
            for (int h = 0; h < 2; ++h) { const int pos = pos0 + h * 128 + R; idx[h][i] = pos < c ? rowe[(size_t)e * ROWE_CAP + pos] : -1; }
        }
#pragma unroll
        for (int h = 0; h < 2; ++h)
#pragma unroll
            for (int i = 0; i < 2; ++i) go[h][i] = (unsigned)((idx[h][i] < 0 ? 0 : (idx[h][i] >> 2)) * K2 + C[i] * 2);
    }
    __device__ __forceinline__ void a_ready(const Unit&) const {}
    __device__ __forceinline__ void done(const Unit&) const {}
};
template <class Epi, class Sched, bool ALIGN_EPI = false, bool SP2 = false>
__device__ __forceinline__ void gemm_phase(PG8_LAS unsigned char* lds, const Gemm g, const Sched& S, const Epi& E) {
    const int tid = get_tid(), wid = __builtin_amdgcn_readfirstlane(tid >> 6), lane = tid & 63, wr = wid >> 2, wc = wid & 3, fr = lane & 15, fq = lane >> 4;
    const int K = g.K, nt = K / BK;
    unsigned voffA[2], voffB[2];
#pragma unroll
    for (int i = 0; i < 2; ++i) { int R, C; stage_rc(tid * 16 + i * 8192, R, C); const int Rb = Epi::PERM ? ((R & ~31) + perm32(R & 31)) : R;
        voffA[i] = (unsigned)(R * K + C) * 2u; voffB[i] = (unsigned)(Rb * K + C) * 2u; }
    const size_t kstep = (size_t)(BK * 2);
    const size_t hstep = (size_t)HALF * K * 2;
    const size_t tstep = 2 * hstep;
    const unsigned ldsw = (unsigned)wid * 1024u;
    const int aoff = lds_byte(wr * 64 + fr, fq * 8), boff = lds_byte(wc * 32 + fr, fq * 8);
#define PG8_SA(b, h) (((b) * 2 + (h)) * HTB)
#define PG8_SB(b, h) ((4 + (b) * 2 + (h)) * HTB)
#define PG8_STAGE(bufoff, gbase, voff) do { _Pragma("unroll") for (int _i = 0; _i < 2; ++_i) \
        __builtin_amdgcn_global_load_lds((const unsigned*)((const char*)(gbase) + (voff)[_i]), (PG8_LAS unsigned*)(lds + (bufoff) + ldsw + _i * 8192), 16, 0, 0); } while (0)
#define PG8_STAGE_A(bufoff, kbytes, h, usenext) do { if constexpr (Sched::GATHER) { _Pragma("unroll") for (int _i = 0; _i < 2; ++_i) { const unsigned o_ = (usenext) ? ngo[h][_i] : cgo[h][_i]; \
        __builtin_amdgcn_global_load_lds((const unsigned*)((const char*)g.A + (kbytes) + o_), (PG8_LAS unsigned*)(lds + (bufoff) + ldsw + _i * 8192), 16, 0, 0); } } \
    else { PG8_STAGE(bufoff, ((usenext) ? nA : cA) + (kbytes) + (h) * hstep, voffA); } } while (0)
#define PG8_LDA(dst, b, h) do { _Pragma("unroll") for (int m = 0; m < 4; ++m) _Pragma("unroll") for (int k = 0; k < 2; ++k) dst[m][k] = *(const PG8_LAS bf16x8*)(lds + PG8_SA(b, h) + aoff + m * 2048 + k * 1024); } while (0)
#define PG8_LDB(dst, b, h) do { _Pragma("unroll") for (int n = 0; n < 2; ++n) _Pragma("unroll") for (int k = 0; k < 2; ++k) dst[n][k] = *(const PG8_LAS bf16x8*)(lds + PG8_SB(b, h) + boff + n * 2048 + k * 1024); } while (0)
#define PG8_MMA(ai, bj, At, Bt) do { __builtin_amdgcn_s_setprio(1); _Pragma("unroll") for (int m = 0; m < 4; ++m) _Pragma("unroll") for (int n = 0; n < 2; ++n) _Pragma("unroll") for (int k = 0; k < 2; ++k) \
        acc[ai][bj][m][n] = __builtin_amdgcn_mfma_f32_16x16x32_bf16(Bt[n][k], At[m][k], acc[ai][bj][m][n], 0, 0, 0); __builtin_amdgcn_s_setprio(0); } while (0)
#define PG8_WAIT_V(n) asm volatile("s_waitcnt vmcnt(" #n ")" ::: "memory")
#define PG8_WAIT_L(n) asm volatile("s_waitcnt lgkmcnt(" #n ")" ::: "memory")
#define PG8_BAR __builtin_amdgcn_s_barrier()
#define PG8_SCHED __builtin_amdgcn_sched_barrier(0)
    Unit cur, nxt; int ui = 0;
    if (!S.next(0, cur)) return;
    unsigned cgo[2][2] = {{0u, 0u}, {0u, 0u}}, ngo[2][2] = {{0u, 0u}, {0u, 0u}};
    if constexpr (Sched::GATHER) S.gather(cur, tid, cgo);
    f32x4 acc[2][2][4][2];
#pragma unroll
    for (int a = 0; a < 2; ++a)
#pragma unroll
        for (int b = 0; b < 2; ++b)
#pragma unroll
            for (int m = 0; m < 4; ++m)
#pragma unroll
                for (int n = 0; n < 2; ++n) acc[a][b][m][n] = (f32x4){0.f, 0.f, 0.f, 0.f};
    bf16x8 At[4][2], B0[2][2], B1[2][2];
    const char* cA = (const char*)g.A + (size_t)cur.pm * tstep; const char* cB = (const char*)g.Bt + (size_t)cur.pn * tstep;
    const char* nA = cA;
    S.a_ready(cur);
    if constexpr (SP2) {
        PG8_STAGE(PG8_SB(0, 0), cB, voffB); PG8_STAGE(PG8_SB(0, 1), cB + hstep, voffB); PG8_STAGE_A(PG8_SA(0, 0), 0, 0, false); PG8_STAGE_A(PG8_SA(0, 1), 0, 1, false);
        if (wr == 1) PG8_BAR;
        PG8_WAIT_V(2); PG8_BAR;
        PG8_STAGE(PG8_SB(1, 0), cB + kstep, voffB); PG8_STAGE_A(PG8_SA(1, 0), kstep, 0, false); PG8_STAGE(PG8_SB(1, 1), cB + hstep + kstep, voffB);
        PG8_WAIT_V(6); PG8_BAR;
    } else {
        PG8_STAGE(PG8_SB(0, 0), cB, voffB); PG8_STAGE_A(PG8_SA(0, 0), 0, 0, false); PG8_STAGE(PG8_SB(0, 1), cB + hstep, voffB); PG8_STAGE_A(PG8_SA(0, 1), 0, 1, false);
        if (wr == 1) PG8_BAR;
        PG8_WAIT_V(4); PG8_BAR;
        PG8_STAGE(PG8_SB(1, 0), cB + kstep, voffB); PG8_STAGE_A(PG8_SA(1, 0), kstep, 0, false); PG8_STAGE(PG8_SB(1, 1), cB + hstep + kstep, voffB);
        PG8_WAIT_V(6); PG8_BAR;
    }
    for (;;) {
        const bool has_next = S.next(ui + 1, nxt);
        nA = has_next ? (const char*)g.A + (size_t)nxt.pm * tstep : cA; const char* nB = has_next ? (const char*)g.Bt + (size_t)nxt.pn * tstep : cB;
        if constexpr (Sched::GATHER) { if (has_next) S.gather(nxt, tid, ngo); else { ngo[0][0] = cgo[0][0]; ngo[0][1] = cgo[0][1]; ngo[1][0] = cgo[1][0]; ngo[1][1] = cgo[1][1]; } }
        for (int t = 0; t < nt; t += 2) {
            const bool last = (t == nt - 2);
            const size_t k1 = (size_t)(t + 1) * kstep, k2 = last ? 0 : (size_t)(t + 2) * kstep, k3 = k2 + kstep;
            const char* b2 = last ? nB : cB + (size_t)(t + 2) * kstep; const char* b3 = b2 + kstep;
            if (last && has_next) S.a_ready(nxt);
            if constexpr (SP2) {
            PG8_LDB(B0, 0, 0); PG8_LDB(B1, 0, 1); PG8_SCHED; PG8_LDA(At, 0, 0); PG8_STAGE_A(PG8_SA(1, 1), k1, 1, false);
            PG8_WAIT_V(8); PG8_WAIT_L(0); PG8_BAR; PG8_MMA(0, 0, At, B0); PG8_MMA(0, 1, At, B1); PG8_BAR; PG8_SCHED;
            PG8_LDA(At, 0, 1); PG8_STAGE(PG8_SB(0, 0), b2, voffB); PG8_STAGE(PG8_SB(0, 1), b2 + hstep, voffB); PG8_STAGE_A(PG8_SA(0, 0), k2, 0, last);
            PG8_WAIT_V(8); PG8_WAIT_L(0); PG8_BAR; PG8_MMA(1, 0, At, B0); PG8_MMA(1, 1, At, B1); PG8_BAR; PG8_SCHED;
            PG8_LDB(B0, 1, 0); PG8_LDB(B1, 1, 1); PG8_SCHED; PG8_LDA(At, 1, 0); PG8_STAGE_A(PG8_SA(0, 1), k2, 1, last);
            PG8_WAIT_V(8); PG8_WAIT_L(0); PG8_BAR; PG8_MMA(0, 0, At, B0); PG8_MMA(0, 1, At, B1); PG8_BAR; PG8_SCHED;
            PG8_LDA(At, 1, 1); PG8_STAGE(PG8_SB(1, 0), b3, voffB); PG8_STAGE(PG8_SB(1, 1), b3 + hstep, voffB); PG8_STAGE_A(PG8_SA(1, 0), k3, 0, last);
            PG8_WAIT_V(8); PG8_WAIT_L(0); PG8_BAR; PG8_MMA(1, 0, At, B0); PG8_MMA(1, 1, At, B1); PG8_BAR; PG8_SCHED;
            } else {
            PG8_LDB(B0, 0, 0); PG8_SCHED; PG8_LDA(At, 0, 0); PG8_STAGE_A(PG8_SA(1, 1), k1, 1, false);
            PG8_WAIT_L(8); PG8_BAR; PG8_WAIT_L(0); PG8_MMA(0, 0, At, B0); PG8_BAR; PG8_SCHED;
            PG8_LDB(B1, 0, 1); PG8_STAGE(PG8_SB(0, 0), b2, voffB);
            PG8_BAR; PG8_WAIT_L(0); PG8_MMA(0, 1, At, B1); PG8_BAR;
            PG8_LDA(At, 0, 1); PG8_STAGE_A(PG8_SA(0, 0), k2, 0, last);
            PG8_BAR; PG8_WAIT_L(0); PG8_MMA(1, 0, At, B0); PG8_BAR; PG8_SCHED;
            PG8_STAGE(PG8_SB(0, 1), b2 + hstep, voffB);
            PG8_WAIT_V(6); PG8_BAR; PG8_MMA(1, 1, At, B1); PG8_BAR;
            PG8_LDB(B0, 1, 0); PG8_SCHED; PG8_LDA(At, 1, 0); PG8_STAGE_A(PG8_SA(0, 1), k2, 1, last);
            PG8_WAIT_L(8); PG8_BAR; PG8_WAIT_L(0); PG8_MMA(0, 0, At, B0); PG8_BAR; PG8_SCHED;
            PG8_LDB(B1, 1, 1); PG8_STAGE(PG8_SB(1, 0), b3, voffB);
            PG8_BAR; PG8_WAIT_L(0); PG8_MMA(0, 1, At, B1); PG8_BAR;
            PG8_LDA(At, 1, 1); PG8_STAGE_A(PG8_SA(1, 0), k3, 0, last);
            PG8_BAR; PG8_WAIT_L(0); PG8_MMA(1, 0, At, B0); PG8_BAR; PG8_SCHED;
            PG8_STAGE(PG8_SB(1, 1), b3 + hstep, voffB);
            PG8_WAIT_V(6); PG8_BAR; PG8_MMA(1, 1, At, B1); PG8_BAR;
            }
        }
        if constexpr (ALIGN_EPI) { if (wr == 0) PG8_BAR; }
        if constexpr (!Epi::AFTER_DRAIN) { E(acc, cur, wr, wc, fr, fq); S.done(cur); }
        if (!has_next) break;
#pragma unroll
        for (int a = 0; a < 2; ++a)
#pragma unroll
            for (int b = 0; b < 2; ++b)
#pragma unroll
                for (int m = 0; m < 4; ++m)
#pragma unroll
                    for (int n = 0; n < 2; ++n) acc[a][b][m][n] = (f32x4){0.f, 0.f, 0.f, 0.f};
        cur = nxt; cA = nA; cB = nB; ++ui;
        if constexpr (Sched::GATHER) { cgo[0][0] = ngo[0][0]; cgo[0][1] = ngo[0][1]; cgo[1][0] = ngo[1][0]; cgo[1][1] = ngo[1][1]; }
        if constexpr (ALIGN_EPI) { if (wr == 1) PG8_BAR; }
    }
    PG8_WAIT_V(0);
    if constexpr (!ALIGN_EPI) { if (wr == 0) PG8_BAR; }
    PG8_BAR;
    if constexpr (Epi::AFTER_DRAIN) { E.fused(acc, cur, wr, wc, fr, fq, lds, wid, lane); S.done(cur); }
#undef PG8_SA
#undef PG8_SB
#undef PG8_STAGE
#undef PG8_STAGE_A
#undef PG8_LDA
#undef PG8_LDB
#undef PG8_MMA
#undef PG8_WAIT_V
#undef PG8_WAIT_L
#undef PG8_BAR
#undef PG8_SCHED
}
}

struct EpiInProj {
    static constexpr bool PERM = false, AFTER_DRAIN = false;
    bf16_t* proj; const float* rope; const float* qn; const float* kn;
    __device__ __forceinline__ void operator()(const f32x4 (&acc)[2][2][4][2], const pg8::Unit& u, int wr, int wc, int fr, int fq) const {
        const int tile = u.pn;
        const bool attn_half = (tile == 0) || (tile == 2) || ((tile == 1 || tile == 3) && wc < 2);
        const bool is_rope = attn_half, is_norm = attn_half && tile >= 2, is_q = (tile == 0) || (tile == 2), is_silu = (tile == 4) || (tile == 5);
        const float* nw = (tile == 3) ? kn : qn;
        f32x4 nwv[2][2];
#pragma unroll
        for (int bj = 0; bj < 2; ++bj)
#pragma unroll
            for (int n = 0; n < 2; ++n) nwv[bj][n] = *(const f32x4*)(nw + 32 * bj + 16 * n + 4 * fq);
        SCHED_FENCE();
#pragma unroll
        for (int ai = 0; ai < 2; ++ai)
#pragma unroll
            for (int m = 0; m < 4; ++m) {
                const int r = u.pm * 256 + ai * 128 + wr * 64 + m * 16 + fr;
                const int b = r / TPB, pp = r - b * TPB;
                const bool latent = pp >= CTX_;
                const int nn = pp - CTX_, prow = nn >> 6, pcol = nn & 63;
                f32x4 v[2][2];
#pragma unroll
                for (int bj = 0; bj < 2; ++bj)
#pragma unroll
                    for (int n = 0; n < 2; ++n) v[bj][n] = acc[ai][bj][m][n];
                if (is_norm) {
                    float ss = 0.f;
#pragma unroll
                    for (int bj = 0; bj < 2; ++bj)
#pragma unroll
                        for (int n = 0; n < 2; ++n) ss += (v[bj][n].x * v[bj][n].x + v[bj][n].y * v[bj][n].y) + (v[bj][n].z * v[bj][n].z + v[bj][n].w * v[bj][n].w);
                    ss += __shfl_xor(ss, 16); ss += __shfl_xor(ss, 32);
                    const float rs = rsqrtf(ss * (1.0f / 64.0f) + EPS_);
#pragma unroll
                    for (int bj = 0; bj < 2; ++bj)
#pragma unroll
                        for (int n = 0; n < 2; ++n) { const f32x4 wv = nwv[bj][n]; v[bj][n].x *= rs * wv.x; v[bj][n].y *= rs * wv.y; v[bj][n].z *= rs * wv.z; v[bj][n].w *= rs * wv.w; }
                }
                if (is_rope && latent) {
#pragma unroll
                    for (int bj = 0; bj < 2; ++bj) {
                        const int pos = bj == 0 ? prow : pcol;
                        const f32x4 c0 = *(const f32x4*)(rope + (pos * 16 + 4 * fq) * 2), c1 = *(const f32x4*)(rope + (pos * 16 + 4 * fq) * 2 + 4);
                        const f32x4 a = v[bj][0], bq = v[bj][1]; f32x4 o0, o1;
                        o0.x = a.x * c0.x - bq.x * c0.y; o1.x = bq.x * c0.x + a.x * c0.y;
                        o0.y = a.y * c0.z - bq.y * c0.w; o1.y = bq.y * c0.z + a.y * c0.w;
                        o0.z = a.z * c1.x - bq.z * c1.y; o1.z = bq.z * c1.x + a.z * c1.y;
                        o0.w = a.w * c1.z - bq.w * c1.w; o1.w = bq.w * c1.z + a.w * c1.w;
                        v[bj][0] = o0; v[bj][1] = o1;
                    }
                }
                if (is_q) {
#pragma unroll
                    for (int bj = 0; bj < 2; ++bj)
#pragma unroll
                        for (int n = 0; n < 2; ++n) v[bj][n] = v[bj][n] * (0.125f * 1.4426950408889634f);
                }
                if (is_silu) {
#pragma unroll
                    for (int bj = 0; bj < 2; ++bj)
#pragma unroll
                        for (int n = 0; n < 2; ++n) { v[bj][n].x = v[bj][n].x * sigmoidf_(v[bj][n].x); v[bj][n].y = v[bj][n].y * sigmoidf_(v[bj][n].y); v[bj][n].z = v[bj][n].z * sigmoidf_(v[bj][n].z); v[bj][n].w = v[bj][n].w * sigmoidf_(v[bj][n].w); }
                }
                bf16_t* dst = proj + (size_t)r * INW + tile * 256 + wc * 64 + 4 * fq;
#pragma unroll
                for (int bj = 0; bj < 2; ++bj)
#pragma unroll
                    for (int n = 0; n < 2; ++n) { u32x2 o; o.x = pack2(v[bj][n].x, v[bj][n].y); o.y = pack2(v[bj][n].z, v[bj][n].w); *(u32x2*)(dst + 32 * bj + 16 * n) = o; }
            }
    }
};
__device__ __forceinline__ void phase_inproj(PRef p, int layer, unsigned char* lds) {
    pg8::Gemm g{(const bf16_t*)(p.ws + OFF_HB), (const bf16_t*)(p.ws + OFF_WIN) + (size_t)layer * INW * D_, D_};
    pg8::DenseSched S; S.init(R_ / 256, INW / 256, get_nblk(), get_bid());
    {
        const int tid = get_tid();
        *(u32x4*)(lds + LDS_ROPE + tid * 16) = *(const u32x4*)(p.ws + OFF_ROPE + tid * 16);
        __syncthreads();
    }
    EpiInProj E{(bf16_t*)(p.ws + OFF_PROJ), (const float*)(lds + LDS_ROPE), p.q_norm_w + layer * 64, p.k_norm_w + layer * 64};
    pg8::gemm_phase<EpiInProj, pg8::DenseSched, true, true>((PG8_LAS unsigned char*)lds, g, S, E);
    if (get_nblk() == 256 && get_bid() >= 184) {
        const int base = (layer == 1 ? CV_OUTTAIL : 0) + (get_bid() - 184);
        for (int k = 0; k < 8; ++k) moe_conv_item(p, layer, base + k * 72, lds);
    }
}

__device__ __forceinline__ void cvt8(const u32x4 w, float* d) {
    d[0] = bflo(w.x); d[1] = bfhi(w.x); d[2] = bflo(w.y); d[3] = bfhi(w.y); d[4] = bflo(w.z); d[5] = bfhi(w.z); d[6] = bflo(w.w); d[7] = bfhi(w.w);
}

__device__ __forceinline__ int chain_pos(int dir, int cc, int j) { return dir == 0 ? cc * 64 + j : (cc < 4 ? (3 - cc) * 64 + 63 - j : TPB - 1 - ((cc - 4) * 64 + j)); }

constexpr int HB_LD = 132, HQ_LD = 136, HV_LD = 72;
constexpr int H_OFF_B = 0, H_OFF_Q = 64 * HB_LD * 4, H_OFF_KK = H_OFF_Q + 64 * HQ_LD * 2, H_OFF_VT = H_OFF_KK + 64 * HQ_LD * 2, H_OFF_KHT = H_OFF_VT + 128 * HV_LD * 2,
              H_OFF_TOT = H_OFF_KHT + 128 * HV_LD * 2, H_LDS = H_OFF_TOT + 4 * 128 * 4;
static_assert(H_LDS <= LDS_BYTES, "hgrn lds");
__device__ __forceinline__ void cvt8f(const f32x4 a, const f32x4 b, float* d) { d[0] = a.x; d[1] = a.y; d[2] = a.z; d[3] = a.w; d[4] = b.x; d[5] = b.y; d[6] = b.z; d[7] = b.w; }
__device__ __forceinline__ bf16x8 pack8(const float* v) { u32x4 w; w.x = pack2(v[0], v[1]); w.y = pack2(v[2], v[3]); w.z = pack2(v[4], v[5]); w.w = pack2(v[6], v[7]); return __builtin_bit_cast(bf16x8, w); }

struct HgLoads { u32x4 z0, z1, q0, q1, v0, v1; f32x4 lb4[4]; };
__device__ __forceinline__ void hgrn_issue_loads(PRef p, int layer, int item, HgLoads& L) {
    const int cc = item % 68, chain = item / 68, dir = chain & 1, h = (chain >> 1) & 3, b = chain >> 3;
    const int tid = get_tid(), lane = tid & 63, wave = tid >> 6;
    const bf16_t* proj = (const bf16_t*)(p.ws + OFF_PROJ);
    const float* lbt = (const float*)(p.ws + OFF_LB) + dir * 512 + h * 128;
    const int j = tid >> 3, kb = (tid & 7) * 16;
    const bf16_t* row = proj + (size_t)(b * TPB + chain_pos(dir, cc, j)) * INW;
    const bf16_t* vrow = proj + (size_t)(b * TPB + chain_pos(dir, cc, lane)) * INW + 2560 + h * 128 + wave * 16;
    L.z0 = *(const u32x4*)(row + (dir == 0 ? 1536 : 2048) + h * 128 + kb); L.z1 = *(const u32x4*)(row + (dir == 0 ? 1536 : 2048) + h * 128 + kb + 8);
    L.q0 = *(const u32x4*)(row + 1024 + h * 128 + kb); L.q1 = *(const u32x4*)(row + 1024 + h * 128 + kb + 8);
    L.v0 = *(const u32x4*)vrow; L.v1 = *(const u32x4*)(vrow + 8);
#pragma unroll
    for (int e = 0; e < 4; ++e) L.lb4[e] = layer == 1 ? *(const f32x4*)(lbt + kb + 4 * e) : (f32x4){0.f, 0.f, 0.f, 0.f};
}
__device__ __forceinline__ void hgrn_load_scan(const HgLoads& L, unsigned char* lds) {
    const int tid = get_tid(), lane = tid & 63, wave = tid >> 6;
    float* Bc = (float*)(lds + H_OFF_B); bf16_t* Qs = (bf16_t*)(lds + H_OFF_Q); bf16_t* KKs = (bf16_t*)(lds + H_OFF_KK); bf16_t* VT = (bf16_t*)(lds + H_OFF_VT); float* Tot = (float*)(lds + H_OFF_TOT);
    {
        const int j = tid >> 3, kb = (tid & 7) * 16;
        const u32x4 z0 = L.z0, z1 = L.z1, q0 = L.q0, q1 = L.q1, v0 = L.v0, v1 = L.v1;
        float z[16], g[16], kk[16]; cvt8(z0, z); cvt8(z1, z + 8);
#pragma unroll
        for (int e = 0; e < 16; ++e) {
            const float lb = L.lb4[e >> 2][e & 3];
            const float sg = sigmoidf_(z[e]); const float f = lb + (1.f - lb) * sg;
            g[e] = __logf(fmaxf(f, 1e-30f)); kk[e] = (1.f - lb) * (1.f - sg);
        }
#pragma unroll
        for (int e = 0; e < 16; e += 4) *(f32x4*)(Bc + j * HB_LD + kb + e) = (f32x4){g[e], g[e + 1], g[e + 2], g[e + 3]};
        *(bf16x8*)(KKs + j * HQ_LD + kb) = pack8(kk); *(bf16x8*)(KKs + j * HQ_LD + kb + 8) = pack8(kk + 8);
        *(u32x4*)(Qs + j * HQ_LD + kb) = q0; *(u32x4*)(Qs + j * HQ_LD + kb + 8) = q1;
        bf16_t* d = VT + (wave * 16) * HV_LD + lane;
        d[0 * HV_LD] = (bf16_t)(v0.x & 0xffffu); d[1 * HV_LD] = (bf16_t)(v0.x >> 16); d[2 * HV_LD] = (bf16_t)(v0.y & 0xffffu); d[3 * HV_LD] = (bf16_t)(v0.y >> 16);
        d[4 * HV_LD] = (bf16_t)(v0.z & 0xffffu); d[5 * HV_LD] = (bf16_t)(v0.z >> 16); d[6 * HV_LD] = (bf16_t)(v0.w & 0xffffu); d[7 * HV_LD] = (bf16_t)(v0.w >> 16);
        d[8 * HV_LD] = (bf16_t)(v1.x & 0xffffu); d[9 * HV_LD] = (bf16_t)(v1.x >> 16); d[10 * HV_LD] = (bf16_t)(v1.y & 0xffffu); d[11 * HV_LD] = (bf16_t)(v1.y >> 16);
        d[12 * HV_LD] = (bf16_t)(v1.z & 0xffffu); d[13 * HV_LD] = (bf16_t)(v1.z >> 16); d[14 * HV_LD] = (bf16_t)(v1.w & 0xffffu); d[15 * HV_LD] = (bf16_t)(v1.w >> 16);
    }
    __syncthreads();
    const int k = tid & 127, seg = tid >> 7;
    float sc[16];
#pragma unroll
    for (int jj = 0; jj < 16; ++jj) sc[jj] = Bc[(seg * 16 + jj) * HB_LD + k];
    SCHED_FENCE();
#pragma unroll
    for (int jj = 1; jj < 16; ++jj) sc[jj] += sc[jj - 1];
    Tot[seg * 128 + k] = sc[15];
    __syncthreads();
    {
        const float t0 = Tot[k], t1 = Tot[128 + k], t2 = Tot[256 + k];
        const float off = seg == 0 ? 0.f : (seg == 1 ? t0 : (seg == 2 ? t0 + t1 : t0 + t1 + t2));
#pragma unroll
        for (int jj = 0; jj < 16; ++jj) Bc[(seg * 16 + jj) * HB_LD + k] = sc[jj] + off;
    }
    __syncthreads();
}

constexpr int H_OFF_PM = H_LDS, HP_LD = 72, H_LDS2 = H_OFF_PM + 64 * HP_LD * 2;
static_assert(H_LDS2 <= LDS_BYTES - 16, "hgrn lds");
__device__ __forceinline__ void hgrn_local_item(PRef p, int layer, int item, unsigned char* lds, const HgLoads& L) {
    const int cc = item % 68, chain = item / 68, dir = chain & 1, h = (chain >> 1) & 3, b = chain >> 3;
    hgrn_load_scan(L, lds);
    const int tid = get_tid(), lane = tid & 63, wave = tid >> 6, fr = lane & 15, fq = lane >> 4;
    const float* Bc = (const float*)(lds + H_OFF_B); const bf16_t* Qs = (const bf16_t*)(lds + H_OFF_Q); const bf16_t* KKs = (const bf16_t*)(lds + H_OFF_KK); const bf16_t* VT = (const bf16_t*)(lds + H_OFF_VT);
    bf16_t* KHT = (bf16_t*)(lds + H_OFF_KHT); bf16_t* Pm = (bf16_t*)(lds + H_OFF_PM);
    {
        const int j = lane, kc = wave * 16;
        float bj[16], be[16], kk[16];
        cvt8f(*(const f32x4*)(Bc + j * HB_LD + kc), *(const f32x4*)(Bc + j * HB_LD + kc + 4), bj); cvt8f(*(const f32x4*)(Bc + j * HB_LD + kc + 8), *(const f32x4*)(Bc + j * HB_LD + kc + 12), bj + 8);
        cvt8f(*(const f32x4*)(Bc + 63 * HB_LD + kc), *(const f32x4*)(Bc + 63 * HB_LD + kc + 4), be); cvt8f(*(const f32x4*)(Bc + 63 * HB_LD + kc + 8), *(const f32x4*)(Bc + 63 * HB_LD + kc + 12), be + 8);
        cvt8(*(const u32x4*)(KKs + j * HQ_LD + kc), kk); cvt8(*(const u32x4*)(KKs + j * HQ_LD + kc + 8), kk + 8);
#pragma unroll
        for (int e = 0; e < 16; ++e) KHT[(kc + e) * HV_LD + j] = (bf16_t)f2bf(kk[e] * __expf(be[e] - bj[e]));
    }
    if (tid < 128) ((float*)(p.ws + OFF_DEC))[(size_t)item * 128 + tid] = __expf(Bc[63 * HB_LD + tid]);
    {
        const int j = tid >> 3, kb = (tid & 7) * 16;
        float bt[16], q8[16], x[16];
        cvt8f(*(const f32x4*)(Bc + j * HB_LD + kb), *(const f32x4*)(Bc + j * HB_LD + kb + 4), bt); cvt8f(*(const f32x4*)(Bc + j * HB_LD + kb + 8), *(const f32x4*)(Bc + j * HB_LD + kb + 12), bt + 8);
        cvt8(*(const u32x4*)(Qs + j * HQ_LD + kb), q8); cvt8(*(const u32x4*)(Qs + j * HQ_LD + kb + 8), q8 + 8);
#pragma unroll
        for (int e = 0; e < 16; ++e) x[e] = q8[e] * __expf(bt[e]);
        bf16_t* qh = (bf16_t*)(p.ws + OFF_QH) + ((size_t)item * 64 + j) * 128 + kb;
        *(bf16x8*)qh = pack8(x); *(bf16x8*)(qh + 8) = pack8(x + 8);
        for (int i = tid; i < 64 * HP_LD * 2 / 16; i += NT) *(u32x4*)((unsigned char*)Pm + i * 16) = (u32x4){0u, 0u, 0u, 0u};
    }
    __syncthreads();
    {
        bf16x8 bfr[2];
#pragma unroll
        for (int ks = 0; ks < 2; ++ks) bfr[ks] = *(const bf16x8*)(VT + (16 * wave + fr) * HV_LD + ks * 32 + fq * 8);
        bf16_t* lt = (bf16_t*)(p.ws + OFF_LT) + ((size_t)item * 128 + 16 * wave + fr) * 128 + 4 * fq;
        bf16x8 afr[8][2];
#pragma unroll
        for (int a = 0; a < 8; ++a)
#pragma unroll
            for (int ks = 0; ks < 2; ++ks) afr[a][ks] = *(const bf16x8*)(KHT + (16 * a + fr) * HV_LD + ks * 32 + fq * 8);
        SCHED_FENCE();
#pragma unroll
        for (int a = 0; a < 8; ++a) {
            f32x4 acc = __builtin_amdgcn_mfma_f32_16x16x32_bf16(afr[a][0], bfr[0], (f32x4){0.f, 0.f, 0.f, 0.f}, 0, 0, 0);
            acc = __builtin_amdgcn_mfma_f32_16x16x32_bf16(afr[a][1], bfr[1], acc, 0, 0, 0);
            u32x2 o; o.x = pack2(acc.x, acc.y); o.y = pack2(acc.z, acc.w);
            *(u32x2*)(lt + 16 * a) = o;
        }
    }
    for (int pi = wave; pi < 10; pi += 8) {
        const int I = pi >= 6 ? 3 : (pi >= 3 ? 2 : (pi >= 1 ? 1 : 0)), J = pi - (I * (I + 1)) / 2;
        const int rrow = (J < I) ? 16 * J + 15 : 16 * I + 7;
        const int s = 16 * J + fr, t = 16 * I + fr;
        f32x4 pacc = (f32x4){0.f, 0.f, 0.f, 0.f};
#pragma unroll
        for (int k2 = 0; k2 < 4; k2 += 2) {
            f32x4 rr[2][2], sb[2][2], tb[2][2]; u32x4 kw[2], qw[2];
#pragma unroll
            for (int d = 0; d < 2; ++d) {
                const int ko = (k2 + d) * 32 + 8 * fq;
                rr[d][0] = *(const f32x4*)(Bc + rrow * HB_LD + ko); rr[d][1] = *(const f32x4*)(Bc + rrow * HB_LD + ko + 4);
                sb[d][0] = *(const f32x4*)(Bc + s * HB_LD + ko); sb[d][1] = *(const f32x4*)(Bc + s * HB_LD + ko + 4);
                tb[d][0] = *(const f32x4*)(Bc + t * HB_LD + ko); tb[d][1] = *(const f32x4*)(Bc + t * HB_LD + ko + 4);
                kw[d] = *(const u32x4*)(KKs + s * HQ_LD + ko); qw[d] = *(const u32x4*)(Qs + t * HQ_LD + ko);
            }
            SCHED_FENCE();
#pragma unroll
            for (int d = 0; d < 2; ++d) {
                float r8[8], bs[8], bt[8], kk[8], q8[8], xk[8], xq[8];
                cvt8f(rr[d][0], rr[d][1], r8); cvt8f(sb[d][0], sb[d][1], bs); cvt8f(tb[d][0], tb[d][1], bt); cvt8(kw[d], kk); cvt8(qw[d], q8);
#pragma unroll
                for (int e = 0; e < 8; ++e) { xk[e] = kk[e] * __expf(fminf(r8[e] - bs[e], 80.f)); xq[e] = q8[e] * __expf(fminf(bt[e] - r8[e], 80.f)); }
                pacc = __builtin_amdgcn_mfma_f32_16x16x32_bf16(pack8(xk), pack8(xq), pacc, 0, 0, 0);
            }
        }
        if (J == I) {
            if (4 * fq + 0 > fr) pacc.x = 0.f;
            if (4 * fq + 1 > fr) pacc.y = 0.f;
            if (4 * fq + 2 > fr) pacc.z = 0.f;
            if (4 * fq + 3 > fr) pacc.w = 0.f;
        }
        u32x2 o; o.x = pack2(pacc.x, pacc.y); o.y = pack2(pacc.z, pacc.w);
        *(u32x2*)(Pm + t * HP_LD + 16 * J + 4 * fq) = o;
    }
    __syncthreads();
    {
        float* obuf = (float*)(p.ws + (dir == 0 ? OFF_OF : OFF_OB));
        bf16x8 vf[2], pfr[4][2];
#pragma unroll
        for (int ks = 0; ks < 2; ++ks) vf[ks] = *(const bf16x8*)(VT + (16 * wave + fr) * HV_LD + ks * 32 + fq * 8);
#pragma unroll
        for (int I = 0; I < 4; ++I)
#pragma unroll
            for (int ks = 0; ks < 2; ++ks) pfr[I][ks] = *(const bf16x8*)(Pm + (16 * I + fr) * HP_LD + ks * 32 + fq * 8);
        SCHED_FENCE();
#pragma unroll
        for (int I = 0; I < 4; ++I) {
            f32x4 acc = __builtin_amdgcn_mfma_f32_16x16x32_bf16(vf[0], pfr[I][0], (f32x4){0.f, 0.f, 0.f, 0.f}, 0, 0, 0);
            if (I >= 2) acc = __builtin_amdgcn_mfma_f32_16x16x32_bf16(vf[1], pfr[I][1], acc, 0, 0, 0);
            *(f32x4*)(obuf + (size_t)(b * TPB + chain_pos(dir, cc, 16 * I + fr)) * 512 + h * 128 + 16 * wave + 4 * fq) = acc;
        }
    }
    __syncthreads();
}

__device__ __forceinline__ void phase_hgrn_c2(PRef p) {
    const int tid = get_tid();
    const bf16_t* LT = (const bf16_t*)(p.ws + OFF_LT); bf16_t* SB = (bf16_t*)(p.ws + OFF_SB); const float* DEC = (const float*)(p.ws + OFF_DEC);
    for (int e = get_bid() * NT + tid; e < 32 * 128 * 32; e += get_nblk() * NT) {
        const int chain = e >> 12, rem = e & 4095, v = rem >> 5, k4 = (rem & 31) * 4;
        float s0 = 0.f, s1 = 0.f, s2 = 0.f, s3 = 0.f;
        const size_t base = (size_t)chain * 68 * 16384 + v * 128 + k4;
        const float* dbase = DEC + (size_t)chain * 68 * 128 + k4;
#define C2_GROUP(C0_, N_) do { u32x2 l[N_]; f32x4 d[N_]; \
            _Pragma("unroll") for (int q = 0; q < (N_); ++q) { l[q] = *(const u32x2*)(LT + base + (size_t)((C0_) + q) * 16384); d[q] = *(const f32x4*)(dbase + (size_t)((C0_) + q) * 128); } \
            SCHED_FENCE(); \
            _Pragma("unroll") for (int q = 0; q < (N_); ++q) { u32x2 o; o.x = pack2(s0, s1); o.y = pack2(s2, s3); *(u32x2*)(SB + base + (size_t)((C0_) + q) * 16384) = o; \
                s0 = d[q].x * s0 + bflo(l[q].x); s1 = d[q].y * s1 + bfhi(l[q].x); s2 = d[q].z * s2 + bflo(l[q].y); s3 = d[q].w * s3 + bfhi(l[q].y); } } while (0)
#pragma unroll 1
        for (int c0 = 0; c0 < 64; c0 += 8) C2_GROUP(c0, 8);
        C2_GROUP(64, 4);
#undef C2_GROUP
    }
}

__device__ __forceinline__ void phase_hgrn_inter(PRef p, int layer, unsigned char* lds) {
    const int tid = get_tid(), lane = tid & 63, wave = tid >> 6, fr = lane & 15, fq = lane >> 4;
    const float* of = (const float*)(p.ws + OFF_OF); const float* ob = (const float*)(p.ws + OFF_OB);
    const bf16_t* proj = (const bf16_t*)(p.ws + OFF_PROJ); bf16_t* mix = (bf16_t*)(p.ws + OFF_MIX);
    for (int wi = get_bid() * 8 + wave; wi < 1088 * 4; wi += get_nblk() * 8) {
        const int tt = wi & 3, item = wi >> 2, tc = item % 68, bh = item / 68, h = bh & 3, b = bh >> 2;
        if (layer == 1 && tc < 4) continue;
        const int tau = tt * 16 + fr; const size_t r = (size_t)b * TPB + tc * 64 + tau;
        const bf16_t* sbp[2]; const bf16_t* qhp[2];
#pragma unroll
        for (int dir = 0; dir < 2; ++dir) {
            const int chain = (b * 4 + h) * 2 + dir, cc = dir == 0 ? tc : (tc < 4 ? 3 - tc : 71 - tc);
            const size_t it = (size_t)chain * 68 + cc;
            sbp[dir] = (const bf16_t*)(p.ws + OFF_SB) + it * 16384 + fr * 128 + 8 * fq;
            qhp[dir] = (const bf16_t*)(p.ws + OFF_QH) + it * 8192 + (dir == 0 ? tau : 63 - tau) * 128 + 8 * fq;
        }
        bf16x8 bfX[2], afX[2][8], bfY[2], afY[2][8];
#define IN_LOAD(BF_, AF_, q_) do { _Pragma("unroll") for (int k2 = 0; k2 < 2; ++k2) { BF_[k2] = *(const bf16x8*)(qhp[(q_) >> 1] + (2 * ((q_) & 1) + k2) * 32); \
            _Pragma("unroll") for (int vt = 0; vt < 8; ++vt) AF_[k2][vt] = *(const bf16x8*)(sbp[(q_) >> 1] + vt * 16 * 128 + (2 * ((q_) & 1) + k2) * 32); } } while (0)
#define IN_MMA(BF_, AF_) do { _Pragma("unroll") for (int k2 = 0; k2 < 2; ++k2) _Pragma("unroll") for (int vt = 0; vt < 8; ++vt) acc[vt] = __builtin_amdgcn_mfma_f32_16x16x32_bf16(AF_[k2][vt], BF_[k2], acc[vt], 0, 0, 0); } while (0)
        f32x4 acc[8];
        u32x2 gwd[8];
        {
            f32x4 a0[8], a1[8];
#pragma unroll
            for (int vt = 0; vt < 8; ++vt) { a0[vt] = *(const f32x4*)(of + r * 512 + h * 128 + 16 * vt + 4 * fq); a1[vt] = *(const f32x4*)(ob + r * 512 + h * 128 + 16 * vt + 4 * fq); }
            IN_LOAD(bfX, afX, 0);
#pragma unroll
            for (int vt = 0; vt < 8; ++vt) gwd[vt] = *(const u32x2*)(proj + r * INW + 3072 + h * 128 + 16 * vt + 4 * fq);
            SCHED_FENCE();
#pragma unroll
            for (int vt = 0; vt < 8; ++vt) acc[vt] = a0[vt] + a1[vt];
        }
        IN_LOAD(bfY, afY, 1); SCHED_FENCE(); IN_MMA(bfX, afX); SCHED_FENCE();
        IN_LOAD(bfX, afX, 2); SCHED_FENCE(); IN_MMA(bfY, afY); SCHED_FENCE();
        IN_LOAD(bfY, afY, 3); SCHED_FENCE(); IN_MMA(bfX, afX); SCHED_FENCE();
        IN_MMA(bfY, afY);
#undef IN_LOAD
#undef IN_MMA
        float ss = 0.f;
#pragma unroll
        for (int vt = 0; vt < 8; ++vt) ss += (acc[vt].x * acc[vt].x + acc[vt].y * acc[vt].y) + (acc[vt].z * acc[vt].z + acc[vt].w * acc[vt].w);
        ss += __shfl_xor(ss, 16); ss += __shfl_xor(ss, 32);
        const float rs = rsqrtf(ss * (1.0f / 128.0f) + EPS_);
        f32x4 gwv[8];
#pragma unroll
        for (int vt = 0; vt < 8; ++vt) gwv[vt] = *(const f32x4*)(p.gate_norm_w + layer * 128 + 16 * vt + 4 * fq);
        SCHED_FENCE();
#pragma unroll
        for (int vt = 0; vt < 8; ++vt) {
            const int vcol = h * 128 + 16 * vt + 4 * fq;
            const f32x4 gw = gwv[vt];
            const float g0 = bflo(gwd[vt].x), g1 = bfhi(gwd[vt].x), g2 = bflo(gwd[vt].y), g3 = bfhi(gwd[vt].y);
            u32x2 o;
            o.x = pack2(acc[vt].x * rs * gw.x * (g0 * sigmoidf_(g0)), acc[vt].y * rs * gw.y * (g1 * sigmoidf_(g1)));
            o.y = pack2(acc[vt].z * rs * gw.z * (g2 * sigmoidf_(g2)), acc[vt].w * rs * gw.w * (g3 * sigmoidf_(g3)));
            *(u32x2*)(mix + r * D_ + 512 + vcol) = o;
        }
    }
}

constexpr int AT_LDK = 80, AT_LDV = 136;
constexpr int AT_KBYTES = 128 * AT_LDK * 2, AT_VBYTES = 64 * AT_LDV * 2, AT_STAGE = AT_KBYTES + AT_VBYTES;
static_assert(2 * AT_STAGE <= LDS_BYTES - 16, "attention lds");
constexpr float LOG2E_ = 1.4426950408889634f;
struct AtRegs { u32x4 k0, k1, v0, v1; };
__device__ __forceinline__ float max3f(float a, float b, float c) { float r; asm("v_max3_f32 %0, %1, %2, %3" : "=v"(r) : "v"(a), "v"(b), "v"(c)); return r; }
__device__ __forceinline__ void at_tile(const unsigned char* Ks, const unsigned char* VT, const bf16x8 (&qf)[2][2], f32x4 (&oacc)[2][4], float (&m)[2], float (&l)[2],
                                        int fr, int fq, bool masked, int nq0, int nk0, bool first) {
    f32x4 sacc[2][2][4];
    {
        bf16x8 kf[2][4][2];
        const unsigned char* kp = Ks + (fr * AT_LDK + fq * 8) * 2;
#pragma unroll
        for (int h = 0; h < 2; ++h)
#pragma unroll
            for (int n = 0; n < 4; ++n)
#pragma unroll
                for (int ks = 0; ks < 2; ++ks) kf[h][n][ks] = *(const bf16x8*)(kp + ((h * 64 + n * 16) * AT_LDK + ks * 32) * 2);
        SCHED_FENCE();
#pragma unroll
        for (int h = 0; h < 2; ++h)
#pragma unroll
            for (int qt = 0; qt < 2; ++qt)
#pragma unroll
                for (int n = 0; n < 4; ++n) {
                    sacc[h][qt][n] = __builtin_amdgcn_mfma_f32_16x16x32_bf16(kf[h][n][0], qf[qt][0], (f32x4){-m[qt], -m[qt], -m[qt], -m[qt]}, 0, 0, 0);
                    sacc[h][qt][n] = __builtin_amdgcn_mfma_f32_16x16x32_bf16(kf[h][n][1], qf[qt][1], sacc[h][qt][n], 0, 0, 0);
                }
    }
    if (masked) {
#pragma unroll
        for (int h = 0; h < 2; ++h)
#pragma unroll
            for (int qt = 0; qt < 2; ++qt) {
                const int nq = nq0 + qt * 16;
#pragma unroll
                for (int n = 0; n < 4; ++n)
#pragma unroll
                    for (int i = 0; i < 4; ++i) { const int df = nq - (nk0 + h * 64 + n * 16 + i); if (df > 128 || df < -128) sacc[h][qt][n][i] = -1e30f; }
            }
    }
    float mx[2];
#pragma unroll
    for (int qt = 0; qt < 2; ++qt) {
        float t = max3f(sacc[0][qt][0].x, sacc[0][qt][0].y, sacc[0][qt][0].z);
#pragma unroll
        for (int h = 0; h < 2; ++h)
#pragma unroll
            for (int n = 0; n < 4; ++n) { if (h | n) t = max3f(t, sacc[h][qt][n].x, sacc[h][qt][n].y); t = max3f(t, sacc[h][qt][n].z, sacc[h][qt][n].w); }
        mx[qt] = t;
    }
    { const float a0 = __shfl_xor(mx[0], 16), a1 = __shfl_xor(mx[1], 16); mx[0] = fmaxf(mx[0], a0); mx[1] = fmaxf(mx[1], a1); }
    { const float a0 = __shfl_xor(mx[0], 32), a1 = __shfl_xor(mx[1], 32); mx[0] = fmaxf(mx[0], a0); mx[1] = fmaxf(mx[1], a1); }
    if (first || __any(fmaxf(mx[0], mx[1]) > 8.f)) {
#pragma unroll
        for (int qt = 0; qt < 2; ++qt) {
            const float dl = first ? fmaxf(mx[qt], -1e30f) : fmaxf(mx[qt], 0.f);
            const float corr = __builtin_amdgcn_exp2f(-dl);
            m[qt] += dl; l[qt] *= corr;
#pragma unroll
            for (int dt = 0; dt < 4; ++dt) oacc[qt][dt] = oacc[qt][dt] * corr;
#pragma unroll
            for (int h = 0; h < 2; ++h)
#pragma unroll
                for (int n = 0; n < 4; ++n) sacc[h][qt][n] = sacc[h][qt][n] - dl;
        }
    }
#pragma unroll
    for (int h = 0; h < 2; ++h) {
        u32x2 vlo[4][2], vhi[4][2];
        const unsigned char* vp = VT + (fr * AT_LDV + h * 64 + 4 * fq) * 2;
#pragma unroll
        for (int dt = 0; dt < 4; ++dt)
#pragma unroll
            for (int s = 0; s < 2; ++s) {
                vlo[dt][s] = *(const u32x2*)(vp + (dt * 16 * AT_LDV + s * 32) * 2);
                vhi[dt][s] = *(const u32x2*)(vp + (dt * 16 * AT_LDV + s * 32 + 16) * 2);
            }
        bf16x8 pf[2][2];
#pragma unroll
        for (int qt = 0; qt < 2; ++qt) {
            float ls = l[qt];
            float pe[4][4];
#pragma unroll
            for (int n = 0; n < 4; ++n) { pe[n][0] = __builtin_amdgcn_exp2f(sacc[h][qt][n].x); pe[n][1] = __builtin_amdgcn_exp2f(sacc[h][qt][n].y); pe[n][2] = __builtin_amdgcn_exp2f(sacc[h][qt][n].z); pe[n][3] = __builtin_amdgcn_exp2f(sacc[h][qt][n].w);
                                          ls += (pe[n][0] + pe[n][1]) + (pe[n][2] + pe[n][3]); }
            l[qt] = ls;
#pragma unroll
            for (int s = 0; s < 2; ++s) {
                u32x4 w; w.x = pack2(pe[2 * s][0], pe[2 * s][1]); w.y = pack2(pe[2 * s][2], pe[2 * s][3]); w.z = pack2(pe[2 * s + 1][0], pe[2 * s + 1][1]); w.w = pack2(pe[2 * s + 1][2], pe[2 * s + 1][3]);
                pf[qt][s] = __builtin_bit_cast(bf16x8, w);
            }
        }
#pragma unroll
        for (int dt = 0; dt < 4; ++dt)
#pragma unroll
            for (int s = 0; s < 2; ++s) {
                u32x4 w; w.x = vlo[dt][s].x; w.y = vlo[dt][s].y; w.z = vhi[dt][s].x; w.w = vhi[dt][s].y;
                const bf16x8 vf = __builtin_bit_cast(bf16x8, w);
#pragma unroll
                for (int qt = 0; qt < 2; ++qt) oacc[qt][dt] = __builtin_amdgcn_mfma_f32_16x16x32_bf16(vf, pf[qt][s], oacc[qt][dt], 0, 0, 0);
            }
    }
}
__device__ __forceinline__ void attn_mfma_item(PRef p, int layer, int item, unsigned char* lds) {
    const int tid = get_tid(), lane = tid & 63, wave = tid >> 6, fr = lane & 15, fq = lane >> 4;
    const int mixer = item / 272; int rem = item - mixer * 272; const int b = rem / 68; rem -= b * 68; const int kvh = rem / 34, qb = rem - kvh * 34;
    const int p0 = qb * 128; const bool ctxblk = p0 < CTX_;
    const int head = kvh * 2 + (wave >> 2);
    const int qrow0 = p0 + (wave & 3) * 32;
    const bf16_t* proj = (const bf16_t*)(p.ws + OFF_PROJ);
    bf16_t* mix = (bf16_t*)(p.ws + OFF_MIX);
    const int qcol = (mixer == 0 ? 0 : 512) + head * 64, kcol = (mixer == 0 ? 256 : 768) + kvh * 64, vcol = (mixer == 0 ? 384 : 896) + kvh * 64;
    bf16x8 qf[2][2];
#pragma unroll
    for (int qt = 0; qt < 2; ++qt)
#pragma unroll
        for (int ks = 0; ks < 2; ++ks) qf[qt][ks] = *(const bf16x8*)(proj + (size_t)(b * TPB + qrow0 + qt * 16 + fr) * INW + qcol + ks * 32 + fq * 8);
    f32x4 oacc[2][4];
#pragma unroll
    for (int qt = 0; qt < 2; ++qt)
#pragma unroll
        for (int dt = 0; dt < 4; ++dt) oacc[qt][dt] = (f32x4){0.f, 0.f, 0.f, 0.f};
    float m[2], l[2];
    if (mixer == 0) { const float sk = p.attn_sink[layer * 4 + head] * LOG2E_; m[0] = sk; m[1] = sk; l[0] = fq == 0 ? 1.f : 0.f; l[1] = l[0]; }
    else { m[0] = 0.f; m[1] = 0.f; l[0] = 0.f; l[1] = 0.f; }
    int tlo, thi;
    if (ctxblk) { tlo = 2; thi = 1; } else if (mixer == 1) { tlo = 2; thi = 33; } else { tlo = qb - 1 < 2 ? 2 : qb - 1; thi = qb + 1 > 33 ? 33 : qb + 1; }
    const int ntile = 2 + (thi - tlo + 1);
    const int srow = tid >> 3, sc8 = tid & 7;
    const bf16_t* kbase = proj + (size_t)(b * TPB + srow) * INW + kcol + sc8 * 8;
    const bf16_t* vbase = proj + (size_t)(b * TPB + lane) * INW + vcol + wave * 8;
    const int nq0 = qrow0 + fr - CTX_;
    const bool mixA = (mixer == 0);
#define AT_TID(ti_) ((ti_) < 2 ? (ti_) : tlo + (ti_) - 2)
#define AT_CL(ti_) ((ti_) < ntile ? (ti_) : ntile - 1)
#define AT_LOAD(R_, ti_) do { const size_t ro_ = (size_t)AT_TID(AT_CL(ti_)) * 128 * INW; R_.k0 = *(const u32x4*)(kbase + ro_); R_.k1 = *(const u32x4*)(kbase + ro_ + (size_t)64 * INW); \
                              R_.v0 = *(const u32x4*)(vbase + ro_); R_.v1 = *(const u32x4*)(vbase + ro_ + (size_t)64 * INW); } while (0)
#define AT_ST8(VT_, key_, w_) do { VT_[(wave * 8 + 0) * AT_LDV + (key_)] = (bf16_t)((w_).x & 0xffffu); VT_[(wave * 8 + 1) * AT_LDV + (key_)] = (bf16_t)((w_).x >> 16); \
        VT_[(wave * 8 + 2) * AT_LDV + (key_)] = (bf16_t)((w_).y & 0xffffu); VT_[(wave * 8 + 3) * AT_LDV + (key_)] = (bf16_t)((w_).y >> 16); \
        VT_[(wave * 8 + 4) * AT_LDV + (key_)] = (bf16_t)((w_).z & 0xffffu); VT_[(wave * 8 + 5) * AT_LDV + (key_)] = (bf16_t)((w_).z >> 16); \
        VT_[(wave * 8 + 6) * AT_LDV + (key_)] = (bf16_t)((w_).w & 0xffffu); VT_[(wave * 8 + 7) * AT_LDV + (key_)] = (bf16_t)((w_).w >> 16); } while (0)
#define AT_STORE(buf_, R_) do { unsigned char* Ks_ = lds + (buf_) * AT_STAGE; bf16_t* VT_ = (bf16_t*)(Ks_ + AT_KBYTES); \
        *(u32x4*)(Ks_ + (srow * AT_LDK + sc8 * 8) * 2) = R_.k0; *(u32x4*)(Ks_ + ((srow + 64) * AT_LDK + sc8 * 8) * 2) = R_.k1; \
        AT_ST8(VT_, lane, R_.v0); AT_ST8(VT_, lane + 64, R_.v1); } while (0)
    AtRegs RA;
    asm volatile("" :: "v"(qf[0][0]), "v"(qf[0][1]), "v"(qf[1][0]), "v"(qf[1][1]));
    AT_LOAD(RA, 0); AT_STORE(0, RA);
    __syncthreads();
#pragma unroll 1
    for (int ti = 0; ti < ntile; ++ti) {
        const int t_ = AT_TID(ti); const bool mk_ = mixA && (t_ >= 2); const int nk_ = t_ * 128 + 4 * fq - CTX_;
        const int buf = ti & 1;
        AT_LOAD(RA, ti + 1); SCHED_FENCE();
        const unsigned char* Ks = lds + buf * AT_STAGE;
        at_tile(Ks, Ks + AT_KBYTES, qf, oacc, m, l, fr, fq, mk_, nq0, nk_, ti == 0);
        AT_STORE(buf ^ 1, RA);
        __syncthreads();
    }
#undef AT_TID
#undef AT_CL
#undef AT_LOAD
#undef AT_ST8
#undef AT_STORE
#pragma unroll
    for (int qt = 0; qt < 2; ++qt) {
        float lt = l[qt]; lt += __shfl_xor(lt, 16); lt += __shfl_xor(lt, 32);
        const float inv = 1.f / lt;
        bf16_t* dst = mix + (size_t)(b * TPB + qrow0 + qt * 16 + fr) * D_ + (mixer == 0 ? 0 : 256) + head * 64 + 4 * fq;
#pragma unroll
        for (int dt = 0; dt < 4; ++dt) { u32x2 o; o.x = pack2(oacc[qt][dt].x * inv, oacc[qt][dt].y * inv); o.y = pack2(oacc[qt][dt].z * inv, oacc[qt][dt].w * inv); *(u32x2*)(dst + dt * 16) = o; }
    }
}

__device__ __forceinline__ void phase_mixers(PRef p, int layer, unsigned char* lds) {
    constexpr int N_A = 544, N_C1 = 2176;
    const int nblk = get_nblk();
    int it = get_bid();
    int cidx = (nblk == 256 ? (layer == 1 ? CV_OUTTAIL + CV_INTAIL : CV_INTAIL) : 0) + get_bid();
    if (get_bid() & 1) { for (; cidx < N_MOECONV; cidx += nblk) moe_conv_item(p, layer, cidx, lds); }
    for (; it < N_A; it += nblk) {
        int a;
        if (it < 256) { const int g = it >> 5, qb = 2 + (it & 31); a = 272 + g * 34 + qb; }
        else if (it < 512) { const int j = it - 256, g = j >> 5, qb = 2 + (j & 31); a = g * 34 + qb; }
        else if (it < 528) { const int j = it - 512; a = 272 + (j >> 1) * 34 + (j & 1); }
        else { const int j = it - 528; a = (j >> 1) * 34 + (j & 1); }
        for (int rep = 0; rep < (((PROBE_MASK1 >> (it < 256 ? 13 : 15)) & 1) ? 2 : 1); ++rep) { attn_mfma_item(p, layer, a, lds); __syncthreads(); }
    }
    if (it < N_A + N_C1) {
        HgLoads cur; hgrn_issue_loads(p, layer, it - N_A, cur);
        for (; it < N_A + N_C1; it += nblk) {
            HgLoads nxt; const bool hn = it + nblk < N_A + N_C1;
            hgrn_issue_loads(p, layer, (hn ? it + nblk : it) - N_A, nxt);
            SCHED_FENCE();
            for (int rep = 0; rep < (((PROBE_MASK1 >> 14) & 1) ? 2 : 1); ++rep) hgrn_local_item(p, layer, it - N_A, lds, cur);
            cur = nxt;
            __syncthreads();
        }
    }
    for (; cidx < N_MOECONV; cidx += nblk) moe_conv_item(p, layer, cidx, lds);
}

struct EpiOutProj {
    static constexpr bool PERM = false, AFTER_DRAIN = false;
    float* xs; const float* modl;
    __device__ __forceinline__ void operator()(const f32x4 (&acc)[2][2][4][2], const pg8::Unit& u, int wr, int wc, int fr, int fq) const {
        const int col0 = u.pn * 256 + wc * 64 + 16 * fq;
        const int r00 = u.pm * 256, b0 = r00 / TPB, pp0 = r00 - b0 * TPB;
        const float* g1 = modl + (size_t)(pp0 < CTX_ ? 4 : b0) * 6144 + 2048 + col0;
        f32x4 gv[4];
#pragma unroll
        for (int q = 0; q < 4; ++q) gv[q] = *(const f32x4*)(g1 + 4 * q);
#pragma unroll
        for (int ai = 0; ai < 2; ++ai)
#pragma unroll
            for (int m = 0; m < 4; m += 2) {
                float* xp0 = xs + (size_t)(u.pm * 256 + ai * 128 + wr * 64 + m * 16 + fr) * D_ + col0;
                float* xp1 = xp0 + (size_t)16 * D_;
                f32x4 x0[4], x1[4];
#pragma unroll
                for (int q = 0; q < 4; ++q) { x0[q] = *(const f32x4*)(xp0 + 4 * q); x1[q] = *(const f32x4*)(xp1 + 4 * q); }
                SCHED_FENCE();
#pragma unroll
                for (int bj = 0; bj < 2; ++bj)
#pragma unroll
                    for (int n = 0; n < 2; ++n) {
                        const int q = 2 * bj + n;
                        *(f32x4*)(xp0 + 4 * q) = x0[q] + gv[q] * acc[ai][bj][m][n];
                        *(f32x4*)(xp1 + 4 * q) = x1[q] + gv[q] * acc[ai][bj][m + 1][n];
                    }
                SCHED_FENCE();
            }
    }
};
struct OutProjSched : pg8::TileOrder {
    static constexpr bool GATHER = false;
    bool skipctx;
    __device__ __forceinline__ bool next(int i, pg8::Unit& u) const { int pm, pn; if (!map(i, pm, pn)) return false; u.pm = skipctx ? pm + (pm >> 4) + 1 : pm; u.pn = pn; u.aux = 0; return true; }
    __device__ __forceinline__ void a_ready(const pg8::Unit&) const {}
    __device__ __forceinline__ void done(const pg8::Unit&) const {}
};
__device__ __forceinline__ void phase_outproj(PRef p, int layer, unsigned char* lds) {
    pg8::Gemm g{(const bf16_t*)(p.ws + OFF_MIX), (const bf16_t*)(p.ws + OFF_WOUT) + (size_t)layer * D_ * D_, D_};
    OutProjSched S; S.skipctx = (layer == 1); S.init(layer == 1 ? 64 : R_ / 256, D_ / 256, get_nblk(), get_bid());
    EpiOutProj E{(float*)(p.ws + OFF_XS), (const float*)(p.ws + OFF_MOD) + (size_t)layer * 5 * 6144};
    pg8::gemm_phase<EpiOutProj, OutProjSched, true, true>((PG8_LAS unsigned char*)lds, g, S, E);
    if (layer == 0 && get_nblk() == 256 && get_bid() >= 16) {
        for (int k = 0; k < 8; ++k) moe_conv_item(p, 1, (get_bid() - 16) + k * 240, lds);
    }
}

constexpr int RW_LD = 1028;
__device__ __forceinline__ float router_reduce(float (&part)[32], int lane) {
#pragma unroll
    for (int i = 0; i < 16; ++i) { const bool hi = (lane & 32) != 0; const float send = hi ? part[i] : part[i + 16], keep = hi ? part[i + 16] : part[i]; part[i] = keep + __shfl_xor(send, 32); }
#pragma unroll
    for (int i = 0; i < 8; ++i) { const bool hi = (lane & 16) != 0; const float send = hi ? part[i] : part[i + 8], keep = hi ? part[i + 8] : part[i]; part[i] = keep + __shfl_xor(send, 16); }
#pragma unroll
    for (int i = 0; i < 4; ++i) { const bool hi = (lane & 8) != 0; const float send = hi ? part[i] : part[i + 4], keep = hi ? part[i + 4] : part[i]; part[i] = keep + __shfl_xor(send, 8); }
#pragma unroll
    for (int i = 0; i < 2; ++i) { const bool hi = (lane & 4) != 0; const float send = hi ? part[i] : part[i + 2], keep = hi ? part[i + 2] : part[i]; part[i] = keep + __shfl_xor(send, 4); }
    { const bool hi = (lane & 2) != 0; const float send = hi ? part[0] : part[1], keep = hi ? part[1] : part[0]; part[0] = keep + __shfl_xor(send, 2); }
    return part[0] + __shfl_xor(part[0], 1);
}
__device__ __forceinline__ void router_commit(float myv, int lane, bool routed, int lr, int* lcnt, int* lsel, int* lpos, float* lgate) {
    const int e_me = lane >> 1;
    int rank = 0;
#pragma unroll
    for (int e = 0; e < 32; ++e) {
        const float le = __int_as_float(__builtin_amdgcn_readlane(__float_as_int(myv), 2 * e));
        rank += ((le > myv) || (le == myv && e < e_me)) ? 1 : 0;
    }
    if (lane & 1) rank = 99;
    int sel[4]; float sv[4];
#pragma unroll
    for (int t = 0; t < 4; ++t) {
        const unsigned long long mk = __builtin_amdgcn_ballot_w64(rank == t);
        const int src = __builtin_amdgcn_readfirstlane((int)__builtin_ctzll(mk));
        sel[t] = src >> 1; sv[t] = __int_as_float(__builtin_amdgcn_readlane(__float_as_int(myv), src));
    }
    const float e0 = 1.f, e1 = __expf(sv[1] - sv[0]), e2 = __expf(sv[2] - sv[0]), e3 = __expf(sv[3] - sv[0]);
    const float isum = 1.f / (e0 + e1 + e2 + e3);
    if (lane == 0) {
        const float gs[4] = {e0 * isum, e1 * isum, e2 * isum, e3 * isum};
#pragma unroll
        for (int t = 0; t < 4; ++t) {
            if (routed) { const int lp = atomicAdd(lcnt + sel[t], 1); lsel[lr * 4 + t] = sel[t]; lpos[lr * 4 + t] = lp; lgate[lr * 4 + t] = gs[t]; }
            else { lsel[lr * 4 + t] = -1; lpos[lr * 4 + t] = 0; lgate[lr * 4 + t] = 0.f; }
        }
    }
}
__device__ __forceinline__ void phase_router(PRef p, int layer, unsigned char* ldsraw) {
    float* RW = (float*)ldsraw;
    int* lcnt = (int*)(ldsraw + 32 * RW_LD * 4);
    int* lbase = lcnt + 32;
    int* lsel = lbase + 32; int* lpos = lsel + 288; float* lgate = (float*)(lpos + 288);
    const int tid = get_tid(), wave = tid >> 6, lane = tid & 63;
    {
        f32x4 rw[16];
#pragma unroll
        for (int q = 0; q < 16; ++q) rw[q] = *(const f32x4*)(p.router_w + (size_t)layer * 32768 + (size_t)(q * NT + tid) * 4);
        SCHED_FENCE();
#pragma unroll
        for (int q = 0; q < 16; ++q) { const int i = (q * NT + tid) * 4, c = i >> 5, e = i & 31; RW[e * RW_LD + c] = rw[q].x; RW[(e + 1) * RW_LD + c] = rw[q].y; RW[(e + 2) * RW_LD + c] = rw[q].z; RW[(e + 3) * RW_LD + c] = rw[q].w; }
    }
    if (tid < 32) lcnt[tid] = 0;
    __syncthreads();
    float* xs = (float*)(p.ws + OFF_XS); bf16_t* hb = (bf16_t*)(p.ws + OFF_HB);
    const float* modv = (const float*)(p.ws + OFF_MOD) + (size_t)layer * 5 * 6144;
    const int chunk = (R_ + get_nblk() - 1) / get_nblk();
    const int r0 = get_bid() * chunk, r1 = (r0 + chunk < R_) ? r0 + chunk : R_;
    const float rbias = p.router_b[layer * 32 + (lane >> 1)];
    f32x4 wv2[4]; load_row4(p.norm2_w + layer * D_, lane, wv2);
    for (int rA = r0 + wave; rA < r1; rA += 16) {
        const bool hasB = rA + 8 < r1; const int rB = hasB ? rA + 8 : rA;
        const int bA = rA / TPB, ppA = rA - bA * TPB, bB = rB / TPB, ppB = rB - bB * TPB;
        f32x4 hvA[4], hvB[4];
        {
            f32x4 vA[4], vB[4], scA[4], shA[4], scB[4], shB[4];
            const float* mvA = modv + (size_t)(ppA < CTX_ ? 4 : bA) * 6144; const float* mvB = modv + (size_t)(ppB < CTX_ ? 4 : bB) * 6144;
            load_row4(xs + (size_t)rA * D_, lane, vA); load_row4(xs + (size_t)rB * D_, lane, vB);
            load_row4(mvA + 4096, lane, scA); load_row4(mvA + 3072, lane, shA); load_row4(mvB + 4096, lane, scB); load_row4(mvB + 3072, lane, shB);
            SCHED_FENCE();
            const float rsA = row_rstd(vA), rsB = row_rstd(vB);
            norm_apply_store(vA, rsA, wv2, scA, shA, hb + (size_t)rA * D_, lane, hvA);
            norm_apply_store(vB, rsB, wv2, scB, shB, hb + (size_t)rB * D_, lane, hvB);
        }
        float pA[32], pB[32];
#pragma unroll
        for (int e0 = 0; e0 < 32; e0 += 4) {
            f32x4 w[4][4];
#pragma unroll
            for (int q = 0; q < 4; ++q)
#pragma unroll
                for (int j = 0; j < 4; ++j) w[q][j] = *(const f32x4*)(RW + (e0 + q) * RW_LD + 4 * lane + 256 * j);
            SCHED_FENCE();
#pragma unroll
            for (int q = 0; q < 4; ++q) {
                float a = 0.f, c = 0.f;
#pragma unroll
                for (int j = 0; j < 4; ++j) { a = fmaf(hvA[j].x, w[q][j].x, a); a = fmaf(hvA[j].y, w[q][j].y, a); a = fmaf(hvA[j].z, w[q][j].z, a); a = fmaf(hvA[j].w, w[q][j].w, a);
                                              c = fmaf(hvB[j].x, w[q][j].x, c); c = fmaf(hvB[j].y, w[q][j].y, c); c = fmaf(hvB[j].z, w[q][j].z, c); c = fmaf(hvB[j].w, w[q][j].w, c); }
                pA[e0 + q] = a; pB[e0 + q] = c;
            }
            SCHED_FENCE();
        }
        const float lgA = router_reduce(pA, lane) + rbias, lgB = router_reduce(pB, lane) + rbias;
        router_commit(lgA, lane, !(layer == 1 && ppA < CTX_), rA - r0, lcnt, lsel, lpos, lgate);
        if (hasB) router_commit(lgB, lane, !(layer == 1 && ppB < CTX_), rB - r0, lcnt, lsel, lpos, lgate);
    }
    __syncthreads();
    if (tid < 32) lbase[tid] = atomicAdd((int*)(p.ws + OFF_CTL) + layer * 32 + tid, lcnt[tid]);
    __syncthreads();
    float* gate = (float*)(p.ws + OFF_GATE); int* rowe = (int*)(p.ws + OFF_ROWE);
    for (int i = tid; i < (r1 - r0) * 4; i += NT) { const int e = lsel[i]; if (e >= 0) { rowe[(size_t)e * ROWE_CAP + lbase[e] + lpos[i]] = r0 * 4 + i; gate[r0 * 4 + i] = lgate[i]; } }
    __syncthreads();
}

__device__ __forceinline__ void moe_offsets(PRef p, int layer, int* off) {
    const int tid = get_tid();
    if (tid == 0) { const int* cnt = (const int*)(p.ws + OFF_CTL) + layer * 32; int a = 0; for (int e = 0; e < 32; ++e) { const int c = cnt[e]; off[e] = a; off[40 + e] = c; a += (c + 255) & ~255; } off[32] = a; }
    __syncthreads();
    if (tid < PMAX / 256) { int e = 0; for (int q = 1; q < 32; ++q) e += (off[q] <= tid * 256) ? 1 : 0; off[96 + tid] = e; }
    __syncthreads();
}

struct EpiMoe1 {
    static constexpr bool PERM = false, AFTER_DRAIN = false;
    bf16_t* act; const float* b1l;
    __device__ __forceinline__ void operator()(const f32x4 (&acc)[2][2][4][2], const pg8::Unit& u, int wr, int wc, int fr, int fq) const {
        const int e = u.aux >> 8, ln = u.aux & 255;
        const int ucol0 = ln * 256 + wc * 64 + 16 * fq;
        const float* b1 = b1l + (size_t)e * 2048 + ucol0;
        f32x4 bv[2][2];
#pragma unroll
        for (int bj = 0; bj < 2; ++bj)
#pragma unroll
            for (int n = 0; n < 2; ++n) bv[bj][n] = *(const f32x4*)(b1 + 8 * bj + 4 * n);
#pragma unroll
        for (int ai = 0; ai < 2; ++ai)
#pragma unroll
            for (int m = 0; m < 4; ++m) {
                const int prow = u.pm * 256 + ai * 128 + wr * 64 + m * 16 + fr;
                u32x4 o; unsigned ow[4];
#pragma unroll
                for (int bj = 0; bj < 2; ++bj)
#pragma unroll
                    for (int n = 0; n < 2; ++n) {
                        const f32x4 uu = acc[ai][bj][m][n] + bv[bj][n];
                        const float g0 = fminf(uu.x, 7.f), l0 = fminf(fmaxf(uu.y, -7.f), 7.f), g1 = fminf(uu.z, 7.f), l1 = fminf(fmaxf(uu.w, -7.f), 7.f);
                        const float y0 = g0 * sigmoidf_(1.702f * g0) * (l0 + 1.f), y1 = g1 * sigmoidf_(1.702f * g1) * (l1 + 1.f);
                        ow[2 * bj + n] = pack2(y0, y1);
                    }
                o.x = ow[0]; o.y = ow[1]; o.z = ow[2]; o.w = ow[3];
                *(u32x4*)(act + (size_t)prow * DFF + (ucol0 >> 1)) = o;
            }
    }
};
__device__ __forceinline__ void phase_moe1(PRef p, int layer, unsigned char* lds) {
    int* off = (int*)(lds + pg8::STAGE_BYTES);
    moe_offsets(p, layer, off);
    pg8::Gemm g{(const bf16_t*)(p.ws + OFF_HB), (const bf16_t*)(p.ws + OFF_W1) + (size_t)layer * NE * 2048 * D_, D_};
    pg8::MoeSched<true> S; S.init(off[32] >> 8, 8, get_nblk(), get_bid()); S.tab = off; S.rowe = (const int*)(p.ws + OFF_ROWE); S.K2 = D_ * 2;
    EpiMoe1 E{(bf16_t*)(p.ws + OFF_ACT), p.b1 + (size_t)layer * NE * 2048};
    pg8::gemm_phase<EpiMoe1, pg8::MoeSched<true>, true, true>((PG8_LAS unsigned char*)lds, g, S, E);
}

struct EpiMoe2 {
    static constexpr bool PERM = false, AFTER_DRAIN = false;
    bf16_t* ybuf; const float* b2l; const int* rowe; const int* tab; const float* gate;
    __device__ __forceinline__ void operator()(const f32x4 (&acc)[2][2][4][2], const pg8::Unit& u, int wr, int wc, int fr, int fq) const {
        const int e = u.aux >> 8, ln = u.aux & 255;
        const int col0 = ln * 256 + wc * 64 + 16 * fq;
        const float* b2 = b2l + (size_t)e * D_ + col0;
        f32x4 bv[2][2];
#pragma unroll
        for (int bj = 0; bj < 2; ++bj)
#pragma unroll
            for (int n = 0; n < 2; ++n) bv[bj][n] = *(const f32x4*)(b2 + 8 * bj + 4 * n);
#pragma unroll
        for (int ai = 0; ai < 2; ++ai)
#pragma unroll
            for (int m = 0; m < 4; ++m) {
                const int pos = u.pm * 256 - tab[e] + ai * 128 + wr * 64 + m * 16 + fr;
                const int idx = pos < tab[40 + e] ? rowe[(size_t)e * ROWE_CAP + pos] : -1;
                if (idx >= 0) {
                    const float gt = gate[idx];
                    unsigned ow[8];
#pragma unroll
                    for (int bj = 0; bj < 2; ++bj)
#pragma unroll
                        for (int n = 0; n < 2; ++n) { const f32x4 y = (acc[ai][bj][m][n] + bv[bj][n]) * gt; ow[4 * bj + 2 * n] = pack2(y.x, y.y); ow[4 * bj + 2 * n + 1] = pack2(y.z, y.w); }
                    u32x4 o0, o1; o0.x = ow[0]; o0.y = ow[1]; o0.z = ow[2]; o0.w = ow[3]; o1.x = ow[4]; o1.y = ow[5]; o1.z = ow[6]; o1.w = ow[7];
                    bf16_t* d = ybuf + (size_t)idx * D_ + col0;
                    *(u32x4*)d = o0; *(u32x4*)(d + 8) = o1;
                }
            }
    }
};
__device__ __forceinline__ void phase_moe2(PRef p, int layer, unsigned char* lds) {
    int* off = (int*)(lds + pg8::STAGE_BYTES);
    moe_offsets(p, layer, off);
    pg8::Gemm g{(const bf16_t*)(p.ws + OFF_ACT), (const bf16_t*)(p.ws + OFF_W2) + (size_t)layer * NE * D_ * DFF, DFF};
    pg8::MoeSched<false> S; S.init(off[32] >> 8, 4, get_nblk(), get_bid()); S.tab = off; S.rowe = nullptr; S.K2 = 0;
    EpiMoe2 E{(bf16_t*)(p.ws + OFF_YBUF), p.b2 + (size_t)layer * NE * D_, (const int*)(p.ws + OFF_ROWE), off, (const float*)(p.ws + OFF_GATE)};
    pg8::gemm_phase<EpiMoe2, pg8::MoeSched<false>, true, true>((PG8_LAS unsigned char*)lds, g, S, E);
}

__device__ __forceinline__ void phase_combine(PRef p, int layer) {
    const int tid = get_tid(), wave = tid >> 6, lane = tid & 63;
    float* xs = (float*)(p.ws + OFF_XS); bf16_t* hb = (bf16_t*)(p.ws + OFF_HB); const bf16_t* ybuf = (const bf16_t*)(p.ws + OFF_YBUF);
    const float* modv = (const float*)(p.ws + OFF_MOD);
    f32x4 wv[4]; load_row4(layer == 0 ? p.norm1_w + D_ : p.final_norm_w, lane, wv);
    for (int r = get_bid() * 8 + wave; r < R_; r += get_nblk() * 8) {
        const int b = r / TPB, pp = r - b * TPB;
        if (layer == 1 && pp < CTX_) continue;
        const int mi = pp < CTX_ ? 4 : b;
        u32x2 yw[4][4]; f32x4 gv[4], xv[4], scv[4], shv[4], v[4], hv[4];
#pragma unroll
        for (int j = 0; j < 4; ++j)
#pragma unroll
            for (int s = 0; s < 4; ++s) yw[j][s] = *(const u32x2*)(ybuf + ((size_t)r * 4 + s) * D_ + 4 * lane + 256 * j);
        load_row4(modv + (size_t)(layer * 5 + mi) * 6144 + 5120, lane, gv);
        load_row4(xs + (size_t)r * D_, lane, xv);
        if (layer == 0) { const float* mv = modv + (size_t)(5 + mi) * 6144; load_row4(mv + 1024, lane, scv); load_row4(mv, lane, shv); }
        SCHED_FENCE();
#pragma unroll
        for (int j = 0; j < 4; ++j) {
            f32x4 f = (f32x4){0.f, 0.f, 0.f, 0.f};
#pragma unroll
            for (int s = 0; s < 4; ++s) { f.x += bflo(yw[j][s].x); f.y += bfhi(yw[j][s].x); f.z += bflo(yw[j][s].y); f.w += bfhi(yw[j][s].y); }
            v[j] = xv[j] + gv[j] * f;
        }
        const float rstd = row_rstd(v);
        if (layer == 0) {
#pragma unroll
            for (int j = 0; j < 4; ++j) *(f32x4*)(xs + (size_t)r * D_ + 4 * lane + 256 * j) = v[j];
            norm_apply_store(v, rstd, wv, scv, shv, hb + (size_t)r * D_, lane, hv);
        } else {
            float* dst = p.out + ((size_t)b * SEQ_ + (pp - CTX_)) * D_;
#pragma unroll
            for (int j = 0; j < 4; ++j) { f32x4 o; o.x = v[j].x * rstd * wv[j].x; o.y = v[j].y * rstd * wv[j].y; o.z = v[j].z * rstd * wv[j].z; o.w = v[j].w * rstd * wv[j].w; *(f32x4*)(dst + 4 * lane + 256 * j) = o; }
        }
    }
}

#define LAS __attribute__((address_space(3)))
#define XB_TMO      128
#define XB_XCNT(j)  (256  + 64 * (j))
#define XB_XSUB(j)  (1280 + 64 * (j))
#define XB_XGEN(j)  (2304 + 64 * (j))
#define XB_TOP      3328
#define XB_TOPGEN   3392
#define XCD_BAR_WORDS 3456
#define XB_SPIN_CAP (1u << 18)

__device__ __forceinline__ unsigned xb_ld(unsigned* p)              { return __hip_atomic_load(p, __ATOMIC_RELAXED, __HIP_MEMORY_SCOPE_AGENT); }
__device__ __forceinline__ unsigned xb_add(unsigned* p, unsigned v) { return __hip_atomic_fetch_add(p, v, __ATOMIC_RELAXED, __HIP_MEMORY_SCOPE_AGENT); }
__device__ __forceinline__ unsigned xb_xcc_id() { return (unsigned)__builtin_amdgcn_s_getreg((3 << 11) | 20) & 0xFu; }
#define XB_SPIN(cond, bar) do { unsigned _sp = 0; while (cond) { __builtin_amdgcn_s_sleep(1); \
    if ((++_sp & 255u) == 0u) { if (xb_ld(&(bar)[XB_TMO])) break; if (_sp > XB_SPIN_CAP) { atomicAdd(&(bar)[XB_TMO], 1u); break; } } } } while (0)

struct XcdBarrier {
    unsigned* bar; unsigned x;
    volatile LAS unsigned* st;
};

__device__ __forceinline__ XcdBarrier xcd_barrier_post(unsigned* bar, volatile LAS unsigned* st) {
    XcdBarrier b; b.bar = bar; b.x = xb_xcc_id(); b.st = st;
    if (threadIdx.x == 0) (void)xb_add(&bar[XB_XCNT(b.x)], 1u);
    return b;
}
__device__ __forceinline__ void xcd_barrier_complete(unsigned* bar, unsigned x, unsigned& nloc, unsigned& nx) {
    const unsigned G = gridDim.x * gridDim.y * gridDim.z;
    unsigned sum, cnt, mine, sp = 0u;
    for (;;) {
        sum = 0u; cnt = 0u; mine = 0u;
#pragma unroll
        for (unsigned j = 0; j < 16; ++j) { const unsigned c = xb_ld(&bar[XB_XCNT(j)]); sum += c; cnt += (c > 0u) ? 1u : 0u; mine = (j == x) ? c : mine; }
        if (sum == G) break;
        __builtin_amdgcn_s_sleep(1);
        if ((++sp & 255u) == 0u) { if (xb_ld(&bar[XB_TMO])) break; if (sp > XB_SPIN_CAP) { atomicAdd(&bar[XB_TMO], 1u); break; } }
    }
    nloc = mine > 0u ? mine : 1u; nx = cnt > 0u ? cnt : 1u;
}

__device__ __forceinline__ void xcd_barrier(const XcdBarrier& b) {
    asm volatile("s_waitcnt vmcnt(0)" ::: "memory");
    __syncthreads();
    if (threadIdx.x == 0) {
        unsigned* bar = b.bar;
        __builtin_amdgcn_s_waitcnt(0);
        unsigned nloc = b.st[0], nx = b.st[1];
        if (nloc == 0u) { xcd_barrier_complete(bar, b.x, nloc, nx); b.st[0] = nloc; b.st[1] = nx; }
        const unsigned old = xb_add(&bar[XB_XSUB(b.x)], 1u);
        const unsigned gen = old / nloc;
        if (old + 1u == (gen + 1u) * nloc) {
            __builtin_amdgcn_fence(__ATOMIC_RELEASE, "agent");
            asm volatile("s_waitcnt vmcnt(0)" ::: "memory");
            const unsigned og = xb_add(&bar[XB_TOP], 1u);
            const unsigned tg = og / nx;
            if (og + 1u == (tg + 1u) * nx) xb_add(&bar[XB_TOPGEN], 1u);
            else XB_SPIN(xb_ld(&bar[XB_TOPGEN]) == tg, bar);
            __builtin_amdgcn_fence(__ATOMIC_ACQUIRE, "agent");
            xb_add(&bar[XB_XGEN(b.x)], 1u);
            asm volatile("s_waitcnt vmcnt(0)" ::: "memory");
        } else {
            XB_SPIN(xb_ld(&bar[XB_XGEN(b.x)]) == gen, bar);
            __builtin_amdgcn_fence(__ATOMIC_ACQUIRE, "agent");
            asm volatile("s_waitcnt vmcnt(0)" ::: "memory");
        }
    }
    __syncthreads();
}


constexpr int NPHASE = 24;
typedef const __attribute__((address_space(4))) Params* KArgs;
__device__ __forceinline__ KArgs kargs() { KArgs q = (KArgs)__builtin_amdgcn_kernarg_segment_ptr(); asm volatile("" : "+s"(q)); return q; }
__device__ __forceinline__ void grid_bar(unsigned char* lds) {
    XcdBarrier b; b.bar = (unsigned*)(kargs()->ws + OFF_BAR); b.x = xb_xcc_id(); b.st = (volatile LAS unsigned*)((LAS unsigned char*)lds + LDS_BYTES - 16);
    xcd_barrier(b);
}
__global__ void __launch_bounds__(NT) fwd_kernel(Params p_unused) {
    extern __shared__ __attribute__((aligned(16))) unsigned char lds[];
    {
        volatile LAS unsigned* bst = (volatile LAS unsigned*)((LAS unsigned char*)lds + LDS_BYTES - 16);
        if (threadIdx.x == 0) { bst[0] = 0u; bst[1] = 0u; }
        __syncthreads();
        (void)xcd_barrier_post((unsigned*)(kargs()->ws + OFF_BAR), bst);
    }
#define PH(ty, last, call) do { const int nrep_ = ((PROBE_MASK1 >> (ty)) & 1) ? 2 : 1; for (int rep_ = 0; rep_ < nrep_; ++rep_) { { PRef p = *kargs(); call; } if (!(last) || rep_ + 1 < nrep_) grid_bar(lds); } } while (0)
    { PRef p = *kargs(); phase_prep(p, lds); }
    cg::this_grid().sync();
    if ((PROBE_MASK1 >> 0) & 1) { { PRef p = *kargs(); phase_prep(p, lds); } grid_bar(lds); }
    PH(1, false, phase_norm_in(p));
#pragma nounroll
    for (int L = 0; L < 2; ++L) {
        PH(2, false, phase_inproj(p, L, lds));
        PH(3, false, phase_mixers(p, L, lds));
        PH(4, false, phase_hgrn_c2(p));
        PH(5, false, phase_hgrn_inter(p, L, lds));
        PH(7, false, phase_outproj(p, L, lds));
        PH(8, false, phase_router(p, L, lds));
        PH(10, false, phase_moe1(p, L, lds));
        PH(11, false, phase_moe2(p, L, lds));
        PH(12, L == 1, phase_combine(p, L));
    }
#undef PH
}

extern "C" void kernel_launch(void* const* d_in, const int* in_sizes, int n_in, void* d_out, int out_size, void* d_ws, size_t ws_size, hipStream_t stream) {
    static int grid = 0;
    if (grid == 0) {
        if (ws_size < WS_END) { fprintf(stderr, "kernel_launch: workspace too small (%zu < %zu)\n", ws_size, (size_t)WS_END); grid = -1; return; }
        int dev = 0, cus = 0, per_cu = 0;
        (void)hipGetDevice(&dev);
        (void)hipDeviceGetAttribute(&cus, hipDeviceAttributeMultiprocessorCount, dev);
        (void)hipFuncSetAttribute((const void*)fwd_kernel, hipFuncAttributeMaxDynamicSharedMemorySize, LDS_BYTES);
        (void)hipOccupancyMaxActiveBlocksPerMultiprocessor(&per_cu, (const void*)fwd_kernel, NT, LDS_BYTES);
        if (per_cu < 1) { fprintf(stderr, "kernel_launch: occupancy query reports %d blocks per CU\n", per_cu); }
        grid = cus;
        (void)hipGetLastError();
    }
    if (grid < 0) return;
    Params p{};
    const float** pin = (const float**)&p;
    for (int i = 0; i < 22; ++i) pin[i] = (const float*)d_in[i];
    p.out = (float*)d_out; p.ws = (unsigned char*)d_ws;
    (void)hipMemsetAsync((char*)d_ws + OFF_BAR, 0, XCD_BAR_WORDS * 4, stream);
    void* args[] = {&p};
    hipError_t e = hipLaunchCooperativeKernel((const void*)fwd_kernel, dim3(grid), dim3(NT), args, LDS_BYTES, stream);
    if (e != hipSuccess) fprintf(stderr, "cooperative launch failed: %s (grid %d)\n", hipGetErrorString(e), grid);
}
```

```cpp
#include <hip/hip_runtime.h>
#include <hip/hip_cooperative_groups.h>
#include <stdint.h>
#include <stdio.h>
namespace cg = cooperative_groups;

#ifndef MEGA
#define MEGA 1
#endif
#ifndef PROBE
#define PROBE 0
#endif
#define PROBE_MASK1 0x0
#define PROBE_MASK2 0x0

typedef unsigned short bf16_t;
typedef short bf16x8 __attribute__((ext_vector_type(8)));
typedef float f32x4 __attribute__((ext_vector_type(4)));
typedef unsigned u32x4 __attribute__((ext_vector_type(4)));
typedef unsigned u32x2 __attribute__((ext_vector_type(2)));

#define NT 512
constexpr int D_ = 1024, NB_ = 4, SEQ_ = 4096, CTX_ = 256, TPB = 4352, R_ = NB_ * TPB, INW = 3584, NE = 32, DFF = 1024;
constexpr float EPS_ = 1e-6f;
constexpr int PMAX = 77824;
constexpr int LDS_BYTES = 147456;
constexpr int ROWE_CAP = R_;

constexpr size_t OFF_CTL = 0;
constexpr size_t OFF_ROPE = 65536;
constexpr size_t OFF_MOD = 131072;
constexpr size_t OFF_WIN = 1u << 20;
constexpr size_t OFF_WOUT = OFF_WIN + (size_t)2 * INW * D_ * 2;
constexpr size_t OFF_W1 = OFF_WOUT + (size_t)2 * D_ * D_ * 2;
constexpr size_t OFF_W2 = OFF_W1 + (size_t)2 * NE * 2048 * D_ * 2;
constexpr size_t OFF_XS = OFF_W2 + (size_t)2 * NE * D_ * DFF * 2;
constexpr size_t OFF_HB = OFF_XS + (size_t)R_ * D_ * 4;
constexpr size_t OFF_PROJ = OFF_HB + (size_t)R_ * D_ * 2;
constexpr size_t OFF_MIX = OFF_PROJ + (size_t)R_ * INW * 2;
constexpr size_t OFF_OF = OFF_MIX + (size_t)R_ * D_ * 2;
constexpr size_t OFF_OB = OFF_OF + (size_t)R_ * 512 * 4;
constexpr size_t OFF_EID = OFF_OB + (size_t)R_ * 512 * 4;
constexpr size_t OFF_GATE = OFF_EID + (size_t)R_ * 16;
constexpr size_t OFF_POS = OFF_GATE + (size_t)R_ * 16;
constexpr size_t OFF_ROWL = OFF_POS + (size_t)R_ * 16;
constexpr size_t OFF_ACT = OFF_ROWL + (size_t)PMAX * 4;
constexpr size_t OFF_YBUF = OFF_ACT + (size_t)PMAX * DFF * 2;
constexpr size_t OFF_LT = OFF_YBUF + (size_t)R_ * 4 * D_ * 2;
constexpr size_t OFF_SB = OFF_LT + (size_t)2176 * 16384 * 2;
constexpr size_t OFF_DEC = OFF_SB + (size_t)2176 * 16384 * 2;
constexpr size_t OFF_QH = OFF_DEC + (size_t)2176 * 128 * 4;
constexpr size_t OFF_ROWE = OFF_QH + (size_t)2176 * 8192 * 2;
constexpr size_t WS_END = OFF_ROWE + (size_t)NE * ROWE_CAP * 4;
constexpr size_t OFF_LB = 4096;
constexpr int LDS_ROPE = 135168;
constexpr size_t OFF_BAR = 16384;
constexpr size_t OFF_TS = 32768;
constexpr size_t OFF_HS = OFF_PROJ;
static_assert((size_t)PMAX * D_ * 2 <= (size_t)R_ * INW * 2 + (size_t)R_ * D_ * 2, "hs overlay");

struct Params {
    const float *x, *c, *ctx, *c_ctx, *w_mod, *b_mod, *norm1_w, *norm2_w, *w_in, *w_out, *attn_sink, *q_norm_w, *k_norm_w, *hgrn_lb,
        *gate_norm_w, *router_w, *router_b, *w1, *b1, *w2, *b2, *final_norm_w;
    float* out;
    unsigned char* ws;
};

typedef const __attribute__((address_space(4))) Params& PRef;
typedef __bf16 bf2_t __attribute__((ext_vector_type(2)));
__device__ __forceinline__ unsigned pack2(float lo, float hi) { bf2_t v; v.x = (__bf16)lo; v.y = (__bf16)hi; return __builtin_bit_cast(unsigned, v); }
__device__ __forceinline__ unsigned f2bf(float f) { return pack2(f, 0.f) & 0xffffu; }
__device__ __forceinline__ float bflo(unsigned w) { return __uint_as_float(w << 16); }
__device__ __forceinline__ float bfhi(unsigned w) { return __uint_as_float(w & 0xffff0000u); }
__device__ __forceinline__ float wave_sum(float v) {
#pragma unroll
    for (int o = 1; o < 64; o <<= 1) v += __shfl_xor(v, o);
    return v;
}
__device__ __forceinline__ int get_tid() { int t = threadIdx.x; asm volatile("" : "+v"(t)); return t; }
__device__ __forceinline__ int get_bid() { int t = blockIdx.x; asm volatile("" : "+s"(t)); return t; }
__device__ __forceinline__ int get_nblk() { int t = gridDim.x; asm volatile("" : "+s"(t)); return t; }
__device__ __forceinline__ float sigmoidf_(float z) { return 1.f / (1.f + __expf(-z)); }

__device__ __forceinline__ int perm_row(int c, int perm) {
    const int lc = c & 255;
    if (perm == 1) { const int wcc = lc >> 6, dim = lc & 63; return (c & ~255) + 128 * (dim >> 5) + 32 * wcc + (dim & 31); }
    if (perm == 2) { const int wcc = lc >> 6, fq = (lc >> 4) & 3, bj = (lc >> 3) & 1, n = (lc >> 2) & 1, i = lc & 3; return (c & ~255) + 128 * bj + 32 * wcc + 16 * n + 4 * fq + i; }
    return c;
}
__device__ __forceinline__ void prep_transpose_item(const float* __restrict__ src, int K, int N, bf16_t* __restrict__ dst, int item, int perm, unsigned char* lds) {
    constexpr int LDO = 72;
    const int nb = N >> 8, kb = item / nb, nbk = item - kb * nb, k0 = kb * 64, n0 = nbk * 256, tid = get_tid(), kc = tid >> 6, lane = tid & 63;
    const float* s = src + (size_t)(k0 + kc * 8) * N + n0 + 4 * lane;
    f32x4 v[8];
#pragma unroll
    for (int j = 0; j < 8; ++j) v[j] = *(const f32x4*)(s + (size_t)j * N);
    bf16_t* img = (bf16_t*)lds;
#pragma unroll
    for (int ni = 0; ni < 4; ++ni) {
        u32x4 w;
        w.x = pack2(v[0][ni], v[1][ni]); w.y = pack2(v[2][ni], v[3][ni]); w.z = pack2(v[4][ni], v[5][ni]); w.w = pack2(v[6][ni], v[7][ni]);
        *(u32x4*)(img + (4 * lane + ni) * LDO + kc * 8) = w;
    }
    __syncthreads();
#pragma unroll
    for (int i = 0; i < 4; ++i) {
        const int n = (tid >> 3) + 64 * i, pc = tid & 7;
        const u32x4 w = *(const u32x4*)(img + n * LDO + pc * 8);
        *(u32x4*)(dst + (size_t)perm_row(n0 + n, perm) * K + k0 + pc * 8) = w;
    }
    __syncthreads();
}

constexpr int N_MOECONV = 32 * 128 + 32 * 64;
constexpr int CV_OUTTAIL = 240 * 8, CV_INTAIL = 72 * 8;
__device__ __forceinline__ void moe_conv_item(PRef p, int layer, int idx, unsigned char* lds) {
    if (idx < 4096) { const int m = layer * 32 + (idx >> 7), ii = idx & 127; prep_transpose_item(p.w1 + (size_t)m * D_ * 2048, D_, 2048, (bf16_t*)(p.ws + OFF_W1) + (size_t)m * 2048 * D_, ii, 2, lds); }
    else { const int j = idx - 4096, m = layer * 32 + (j >> 6), ii = j & 63; prep_transpose_item(p.w2 + (size_t)m * DFF * D_, DFF, D_, (bf16_t*)(p.ws + OFF_W2) + (size_t)m * D_ * DFF, ii, 2, lds); }
}

__device__ __forceinline__ void prep_mod_item(PRef p, int item, float* lds) {
    const int l = item / 96, col0 = (item - l * 96) * 64, tid = get_tid();
    float* s = lds;
    float* red = lds + 5 * 1024;
    for (int i = tid; i < 5 * 1024; i += NT) { const int row = i >> 10, k = i & 1023; const float cv = row < 4 ? p.c[row * 1024 + k] : p.c_ctx[k]; s[i] = cv / (1.f + __expf(-cv)); }
    __syncthreads();
    const int col = tid & 63, kq = tid >> 6;
    const float* w = p.w_mod + (size_t)l * 1024 * 6144 + col0 + col;
    float a0 = 0.f, a1 = 0.f, a2 = 0.f, a3 = 0.f, a4 = 0.f;
#pragma unroll 8
    for (int k = kq * 128; k < kq * 128 + 128; ++k) {
        const float wv = w[(size_t)k * 6144];
        a0 += s[k] * wv; a1 += s[1024 + k] * wv; a2 += s[2048 + k] * wv; a3 += s[3072 + k] * wv; a4 += s[4096 + k] * wv;
    }
    red[(kq * 5 + 0) * 64 + col] = a0; red[(kq * 5 + 1) * 64 + col] = a1; red[(kq * 5 + 2) * 64 + col] = a2; red[(kq * 5 + 3) * 64 + col] = a3; red[(kq * 5 + 4) * 64 + col] = a4;
    __syncthreads();
    if (tid < 320) {
        const int r = tid >> 6, c = tid & 63; float sum = 0.f;
#pragma unroll
        for (int q = 0; q < 8; ++q) sum += red[(q * 5 + r) * 64 + c];
        float* modv = (float*)(p.ws + OFF_MOD);
        modv[(size_t)(l * 5 + r) * 6144 + col0 + c] = sum + p.b_mod[l * 6144 + col0 + c];
    }
    __syncthreads();
}

__device__ __forceinline__ void phase_prep(PRef p, unsigned char* ldsraw) {
    float* lds = (float*)ldsraw;
    const int tid = get_tid();
    constexpr int N_MOD = 192, N_MISC = 1, N_WIN = 2 * 16 * 14, N_WOUT = 2 * 16 * 4;
    constexpr int NITEMS = N_MOD + N_MISC + N_WIN + N_WOUT;
    for (int it = get_bid(); it < NITEMS; it += get_nblk()) {
        int r = it;
        if (r < N_MOD) { prep_mod_item(p, r, lds); continue; } r -= N_MOD;
        if (r < N_MISC) {
            float* tab = (float*)(p.ws + OFF_ROPE);
            for (int i = tid; i < 1024; i += NT) { const int pos = i >> 4, fi = i & 15; const float inv = 1.0f / powf(10000.0f, (float)(2 * fi) / 32.0f); const float ang = (float)pos * inv; tab[2 * i] = cosf(ang); tab[2 * i + 1] = sinf(ang); }
            int* cnt = (int*)(p.ws + OFF_CTL);
            if (tid < 64) cnt[tid] = 0;
            float* lbt = (float*)(p.ws + OFF_LB);
            for (int i = tid; i < 1024; i += NT) lbt[i] = sigmoidf_(p.hgrn_lb[1024 + i] - p.hgrn_lb[i]);
            continue;
        } r -= N_MISC;
        if (r < N_WIN) { const int l = r / (16 * 14), ii = r - l * 16 * 14; prep_transpose_item(p.w_in + (size_t)l * D_ * INW, D_, INW, (bf16_t*)(p.ws + OFF_WIN) + (size_t)l * INW * D_, ii, 1, ldsraw); continue; } r -= N_WIN;
        { const int l = r / 64, ii = r - l * 64; prep_transpose_item(p.w_out + (size_t)l * D_ * D_, D_, D_, (bf16_t*)(p.ws + OFF_WOUT) + (size_t)l * D_ * D_, ii, 2, ldsraw); }
    }
}

__device__ __forceinline__ float row_rstd(const f32x4 (&v)[4]) {
    float ss = 0.f;
#pragma unroll
    for (int j = 0; j < 4; ++j) ss += (v[j].x * v[j].x + v[j].y * v[j].y) + (v[j].z * v[j].z + v[j].w * v[j].w);
    return rsqrtf(wave_sum(ss) * (1.0f / D_) + EPS_);
}
#define SCHED_FENCE() __builtin_amdgcn_sched_barrier(0)
__device__ __forceinline__ void load_row4(const float* src, int lane, f32x4 (&v)[4]) {
#pragma unroll
    for (int j = 0; j < 4; ++j) v[j] = *(const f32x4*)(src + 4 * lane + 256 * j);
}
__device__ __forceinline__ void norm_apply_store(const f32x4 (&v)[4], float rstd, const f32x4 (&wv)[4], const f32x4 (&scv)[4], const f32x4 (&shv)[4], bf16_t* dst, int lane, f32x4 (&hv)[4]) {
#pragma unroll
    for (int j = 0; j < 4; ++j) {
        f32x4 h;
        h.x = (v[j].x * rstd * wv[j].x) * (1.f + scv[j].x) + shv[j].x; h.y = (v[j].y * rstd * wv[j].y) * (1.f + scv[j].y) + shv[j].y;
        h.z = (v[j].z * rstd * wv[j].z) * (1.f + scv[j].z) + shv[j].z; h.w = (v[j].w * rstd * wv[j].w) * (1.f + scv[j].w) + shv[j].w;
        hv[j] = h;
        u32x2 o; o.x = pack2(h.x, h.y); o.y = pack2(h.z, h.w);
        *(u32x2*)(dst + 4 * lane + 256 * j) = o;
    }
}

__device__ __forceinline__ void phase_norm_in(PRef p) {
    const int tid = get_tid(), wave = tid >> 6, lane = tid & 63;
    float* xs = (float*)(p.ws + OFF_XS); bf16_t* hb = (bf16_t*)(p.ws + OFF_HB); const float* modv = (const float*)(p.ws + OFF_MOD);
    f32x4 wv[4]; load_row4(p.norm1_w, lane, wv);
    const int stride = get_nblk() * 8;
    int r = get_bid() * 8 + wave;
    f32x4 v[4], vn[4], scv[4], shv[4], hv[4];
#define NI_SRC(r_) (((r_) % TPB) < CTX_ ? p.ctx + ((size_t)((r_) / TPB) * CTX_ + ((r_) % TPB)) * D_ : p.x + ((size_t)((r_) / TPB) * SEQ_ + (((r_) % TPB) - CTX_)) * D_)
    if (r < R_) load_row4(NI_SRC(r), lane, v);
    for (; r < R_; r += stride) {
        const int b = r / TPB, pp = r - b * TPB;
        const float* mv = modv + (size_t)(pp < CTX_ ? 4 : b) * 6144;
        const int rn = (r + stride < R_) ? r + stride : r;
        load_row4(NI_SRC(rn), lane, vn); load_row4(mv + 1024, lane, scv); load_row4(mv, lane, shv);
        SCHED_FENCE();
#pragma unroll
        for (int j = 0; j < 4; ++j) *(f32x4*)(xs + (size_t)r * D_ + 4 * lane + 256 * j) = v[j];
        const float rstd = row_rstd(v);
        norm_apply_store(v, rstd, wv, scv, shv, hb + (size_t)r * D_, lane, hv);
#pragma unroll
        for (int j = 0; j < 4; ++j) v[j] = vn[j];
    }
#undef NI_SRC
}

namespace pg8 {
#define PG8_LAS __attribute__((address_space(3)))
constexpr int BM = 256, BK = 64, HALF = 128, HTB = HALF * BK * 2, STAGE_BYTES = 8 * HTB, NXCD = 8, WGM = 8;
__host__ __device__ __forceinline__ int lds_byte(int r, int c) { const int st = (r >> 4) * 2 + (c >> 5), rr = r & 15, cc = c & 31, ob = rr * 64 + cc * 2; return st * 1024 + (ob ^ (((ob >> 9) & 1) << 5)); }
__host__ __device__ __forceinline__ void stage_rc(int b, int& R, int& C) { const int st = b / 1024, sb = b % 1024, swz = sb ^ (((sb >> 9) & 1) << 5); R = (st >> 1) * 16 + swz / 64; C = (st & 1) * 32 + (swz % 64) / 2; }
__host__ __device__ __forceinline__ int perm32(int rho) { const int n = rho >> 4, i = rho & 15; return 8 * (i >> 2) + 4 * n + (i & 3); }
struct Unit { int pm, pn, aux; };
struct Gemm { const bf16_t* A; const bf16_t* Bt; int K; };
struct TileOrder {
    int nM, nN, nwg, G, c;
    __device__ __forceinline__ void init(int nM_, int nN_, int G_, int c_) { nM = nM_; nN = nN_; nwg = nM * nN; G = G_; c = c_; }
    __device__ __forceinline__ bool map(int i, int& pm, int& pn) const {
        const long L = (long)i * G + c; if (L >= nwg) return false;
        int wgid = (int)L; { const int q = nwg / NXCD, r = nwg % NXCD, xcd = wgid % NXCD, off = wgid / NXCD; wgid = (xcd < r ? xcd * (q + 1) : r * (q + 1) + (xcd - r) * q) + off; }
        const int nig = WGM * nN, gid = wgid / nig, fm = gid * WGM, gsz = (nM - fm) < WGM ? (nM - fm) : WGM;
        pm = fm + ((wgid % nig) % gsz); pn = (wgid % nig) / gsz; return true;
    }
};
struct DenseSched : TileOrder {
    static constexpr bool GATHER = false;
    __device__ __forceinline__ bool next(int i, Unit& u) const { u.aux = 0; return map(i, u.pm, u.pn); }
    __device__ __forceinline__ void a_ready(const Unit&) const {}
    __device__ __forceinline__ void done(const Unit&) const {}
};
template <bool GATHER_>
struct MoeSched : TileOrder {
    static constexpr bool GATHER = GATHER_;
    const int* tab; const int* rowe; int K2;
    __device__ __forceinline__ bool next(int i, Unit& u) const {
        int pm, ln; if (!map(i, pm, ln)) return false;
        const int e = tab[96 + pm];
        u.pm = pm; u.pn = e * nN + ln; u.aux = (e << 8) | ln; return true;
    }
    __device__ __forceinline__ void gather(const Unit& u, int tid, unsigned (&go)[2][2]) const {
        const int e = u.aux >> 8, pos0 = u.pm * 256 - tab[e], c = tab[40 + e];
        int idx[2][2], C[2];
#pragma unroll
        for (int i = 0; i < 2; ++i) {
            int R; stage_rc(tid * 16 + i * 8192, R, C[i]);
#pragma unroll
            for (int h = 0; h < 2; ++h) { const int pos = pos0 + h * 128 + R; idx[h][i] = pos < c ? rowe[(size_t)e * ROWE_CAP + pos] : -1; }
        }
#pragma unroll
        for (int h = 0; h < 2; ++h)
#pragma unroll
            for (int i = 0; i < 2; ++i) go[h][i] = (unsigned)((idx[h][i] < 0 ? 0 : (idx[h][i] >> 2)) * K2 + C[i] * 2);
    }
    __device__ __forceinline__ void a_ready(const Unit&) const {}
    __device__ __forceinline__ void done(const Unit&) const {}
};
template <class Epi, class Sched, bool ALIGN_EPI = false, bool SP2 = false>
__device__ __forceinline__ void gemm_phase(PG8_LAS unsigned char* lds, const Gemm g, const Sched& S, const Epi& E) {
    const int tid = get_tid(), wid = __builtin_amdgcn_readfirstlane(tid >> 6), lane = tid & 63, wr = wid >> 2, wc = wid & 3, fr = lane & 15, fq = lane >> 4;
    const int K = g.K, nt = K / BK;
    unsigned voffA[2], voffB[2];
#pragma unroll
    for (int i = 0; i < 2; ++i) { int R, C; stage_rc(tid * 16 + i * 8192, R, C); const int Rb = Epi::PERM ? ((R & ~31) + perm32(R & 31)) : R;
        voffA[i] = (unsigned)(R * K + C) * 2u; voffB[i] = (unsigned)(Rb * K + C) * 2u; }
    const size_t kstep = (size_t)(BK * 2);
    const size_t hstep = (size_t)HALF * K * 2;
    const size_t tstep = 2 * hstep;
    const unsigned ldsw = (unsigned)wid * 1024u;
    const int aoff = lds_byte(wr * 64 + fr, fq * 8), boff = lds_byte(wc * 32 + fr, fq * 8);
#define PG8_SA(b, h) (((b) * 2 + (h)) * HTB)
#define PG8_SB(b, h) ((4 + (b) * 2 + (h)) * HTB)
#define PG8_STAGE(bufoff, gbase, voff) do { _Pragma("unroll") for (int _i = 0; _i < 2; ++_i) \
        __builtin_amdgcn_global_load_lds((const unsigned*)((const char*)(gbase) + (voff)[_i]), (PG8_LAS unsigned*)(lds + (bufoff) + ldsw + _i * 8192), 16, 0, 0); } while (0)
#define PG8_STAGE_A(bufoff, kbytes, h, usenext) do { if constexpr (Sched::GATHER) { _Pragma("unroll") for (int _i = 0; _i < 2; ++_i) { const unsigned o_ = (usenext) ? ngo[h][_i] : cgo[h][_i]; \
        __builtin_amdgcn_global_load_lds((const unsigned*)((const char*)g.A + (kbytes) + o_), (PG8_LAS unsigned*)(lds + (bufoff) + ldsw + _i * 8192), 16, 0, 0); } } \
    else { PG8_STAGE(bufoff, ((usenext) ? nA : cA) + (kbytes) + (h) * hstep, voffA); } } while (0)
#define PG8_LDA(dst, b, h) do { _Pragma("unroll") for (int m = 0; m < 4; ++m) _Pragma("unroll") for (int k = 0; k < 2; ++k) dst[m][k] = *(const PG8_LAS bf16x8*)(lds + PG8_SA(b, h) + aoff + m * 2048 + k * 1024); } while (0)
#define PG8_LDB(dst, b, h) do { _Pragma("unroll") for (int n = 0; n < 2; ++n) _Pragma("unroll") for (int k = 0; k < 2; ++k) dst[n][k] = *(const PG8_LAS bf16x8*)(lds + PG8_SB(b, h) + boff + n * 2048 + k * 1024); } while (0)
#define PG8_MMA(ai, bj, At, Bt) do { __builtin_amdgcn_s_setprio(1); _Pragma("unroll") for (int m = 0; m < 4; ++m) _Pragma("unroll") for (int n = 0; n < 2; ++n) _Pragma("unroll") for (int k = 0; k < 2; ++k) \
        acc[ai][bj][m][n] = __builtin_amdgcn_mfma_f32_16x16x32_bf16(Bt[n][k], At[m][k], acc[ai][bj][m][n], 0, 0, 0); __builtin_amdgcn_s_setprio(0); } while (0)
#define PG8_WAIT_V(n) asm volatile("s_waitcnt vmcnt(" #n ")" ::: "memory")
#define PG8_WAIT_L(n) asm volatile("s_waitcnt lgkmcnt(" #n ")" ::: "memory")
#define PG8_BAR __builtin_amdgcn_s_barrier()
#define PG8_SCHED __builtin_amdgcn_sched_barrier(0)
    Unit cur, nxt; int ui = 0;
    if (!S.next(0, cur)) return;
    unsigned cgo[2][2] = {{0u, 0u}, {0u, 0u}}, ngo[2][2] = {{0u, 0u}, {0u, 0u}};
    if constexpr (Sched::GATHER) S.gather(cur, tid, cgo);
    f32x4 acc[2][2][4][2];
#pragma unroll
    for (int a = 0; a < 2; ++a)
#pragma unroll
        for (int b = 0; b < 2; ++b)
#pragma unroll
            for (int m = 0; m < 4; ++m)
#pragma unroll
                for (int n = 0; n < 2; ++n) acc[a][b][m][n] = (f32x4){0.f, 0.f, 0.f, 0.f};
    bf16x8 At[4][2], B0[2][2], B1[2][2];
    const char* cA = (const char*)g.A + (size_t)cur.pm * tstep; const char* cB = (const char*)g.Bt + (size_t)cur.pn * tstep;
    const char* nA = cA;
    S.a_ready(cur);
    if constexpr (SP2) {
        PG8_STAGE(PG8_SB(0, 0), cB, voffB); PG8_STAGE(PG8_SB(0, 1), cB + hstep, voffB); PG8_STAGE_A(PG8_SA(0, 0), 0, 0, false); PG8_STAGE_A(PG8_SA(0, 1), 0, 1, false);
        if (wr == 1) PG8_BAR;
        PG8_WAIT_V(2); PG8_BAR;
        PG8_STAGE(PG8_SB(1, 0), cB + kstep, voffB); PG8_STAGE_A(PG8_SA(1, 0), kstep, 0, false); PG8_STAGE(PG8_SB(1, 1), cB + hstep + kstep, voffB);
        PG8_WAIT_V(6); PG8_BAR;
    } else {
        PG8_STAGE(PG8_SB(0, 0), cB, voffB); PG8_STAGE_A(PG8_SA(0, 0), 0, 0, false); PG8_STAGE(PG8_SB(0, 1), cB + hstep, voffB); PG8_STAGE_A(PG8_SA(0, 1), 0, 1, false);
        if (wr == 1) PG8_BAR;
        PG8_WAIT_V(4); PG8_BAR;
        PG8_STAGE(PG8_SB(1, 0), cB + kstep, voffB); PG8_STAGE_A(PG8_SA(1, 0), kstep, 0, false); PG8_STAGE(PG8_SB(1, 1), cB + hstep + kstep, voffB);
        PG8_WAIT_V(6); PG8_BAR;
    }
    for (;;) {
        const bool has_next = S.next(ui + 1, nxt);
        nA = has_next ? (const char*)g.A + (size_t)nxt.pm * tstep : cA; const char* nB = has_next ? (const char*)g.Bt + (size_t)nxt.pn * tstep : cB;
        if constexpr (Sched::GATHER) { if (has_next) S.gather(nxt, tid, ngo); else { ngo[0][0] = cgo[0][0]; ngo[0][1] = cgo[0][1]; ngo[1][0] = cgo[1][0]; ngo[1][1] = cgo[1][1]; } }
        for (int t = 0; t < nt; t += 2) {
            const bool last = (t == nt - 2);
            const size_t k1 = (size_t)(t + 1) * kstep, k2 = last ? 0 : (size_t)(t + 2) * kstep, k3 = k2 + kstep;
            const char* b2 = last ? nB : cB + (size_t)(t + 2) * kstep; const char* b3 = b2 + kstep;
            if (last && has_next) S.a_ready(nxt);
            if constexpr (SP2) {
            PG8_LDB(B0, 0, 0); PG8_LDB(B1, 0, 1); PG8_SCHED; PG8_LDA(At, 0, 0); PG8_STAGE_A(PG8_SA(1, 1), k1, 1, false);
            PG8_WAIT_V(8); PG8_WAIT_L(0); PG8_BAR; PG8_MMA(0, 0, At, B0); PG8_MMA(0, 1, At, B1); PG8_BAR; PG8_SCHED;
            PG8_LDA(At, 0, 1); PG8_STAGE(PG8_SB(0, 0), b2, voffB); PG8_STAGE(PG8_SB(0, 1), b2 + hstep, voffB); PG8_STAGE_A(PG8_SA(0, 0), k2, 0, last);
            PG8_WAIT_V(8); PG8_WAIT_L(0); PG8_BAR; PG8_MMA(1, 0, At, B0); PG8_MMA(1, 1, At, B1); PG8_BAR; PG8_SCHED;
            PG8_LDB(B0, 1, 0); PG8_LDB(B1, 1, 1); PG8_SCHED; PG8_LDA(At, 1, 0); PG8_STAGE_A(PG8_SA(0, 1), k2, 1, last);
            PG8_WAIT_V(8); PG8_WAIT_L(0); PG8_BAR; PG8_MMA(0, 0, At, B0); PG8_MMA(0, 1, At, B1); PG8_BAR; PG8_SCHED;
            PG8_LDA(At, 1, 1); PG8_STAGE(PG8_SB(1, 0), b3, voffB); PG8_STAGE(PG8_SB(1, 1), b3 + hstep, voffB); PG8_STAGE_A(PG8_SA(1, 0), k3, 0, last);
            PG8_WAIT_V(8); PG8_WAIT_L(0); PG8_BAR; PG8_MMA(1, 0, At, B0); PG8_MMA(1, 1, At, B1); PG8_BAR; PG8_SCHED;
            } else {
            PG8_LDB(B0, 0, 0); PG8_SCHED; PG8_LDA(At, 0, 0); PG8_STAGE_A(PG8_SA(1, 1), k1, 1, false);
            PG8_WAIT_L(8); PG8_BAR; PG8_WAIT_L(0); PG8_MMA(0, 0, At, B0); PG8_BAR; PG8_SCHED;
            PG8_LDB(B1, 0, 1); PG8_STAGE(PG8_SB(0, 0), b2, voffB);
            PG8_BAR; PG8_WAIT_L(0); PG8_MMA(0, 1, At, B1); PG8_BAR;
            PG8_LDA(At, 0, 1); PG8_STAGE_A(PG8_SA(0, 0), k2, 0, last);
            PG8_BAR; PG8_WAIT_L(0); PG8_MMA(1, 0, At, B0); PG8_BAR; PG8_SCHED;
            PG8_STAGE(PG8_SB(0, 1), b2 + hstep, voffB);
            PG8_WAIT_V(6); PG8_BAR; PG8_MMA(1, 1, At, B1); PG8_BAR;
            PG8_LDB(B0, 1, 0); PG8_SCHED; PG8_LDA(At, 1, 0); PG8_STAGE_A(PG8_SA(0, 1), k2, 1, last);
            PG8_WAIT_L(8); PG8_BAR; PG8_WAIT_L(0); PG8_MMA(0, 0, At, B0); PG8_BAR; PG8_SCHED;
            PG8_LDB(B1, 1, 1); PG8_STAGE(PG8_SB(1, 0), b3, voffB);
            PG8_BAR; PG8_WAIT_L(0); PG8_MMA(0, 1, At, B1); PG8_BAR;
            PG8_LDA(At, 1, 1); PG8_STAGE_A(PG8_SA(1, 0), k3, 0, last);
            PG8_BAR; PG8_WAIT_L(0); PG8_MMA(1, 0, At, B0); PG8_BAR; PG8_SCHED;
            PG8_STAGE(PG8_SB(1, 1), b3 + hstep, voffB);
            PG8_WAIT_V(6); PG8_BAR; PG8_MMA(1, 1, At, B1); PG8_BAR;
            }
        }
        if constexpr (ALIGN_EPI) { if (wr == 0) PG8_BAR; }
        if constexpr (!Epi::AFTER_DRAIN) { E(acc, cur, wr, wc, fr, fq); S.done(cur); }
        if (!has_next) break;
#pragma unroll
        for (int a = 0; a < 2; ++a)
#pragma unroll
            for (int b = 0; b < 2; ++b)
#pragma unroll
                for (int m = 0; m < 4; ++m)
#pragma unroll
                    for (int n = 0; n < 2; ++n) acc[a][b][m][n] = (f32x4){0.f, 0.f, 0.f, 0.f};
        cur = nxt; cA = nA; cB = nB; ++ui;
        if constexpr (Sched::GATHER) { cgo[0][0] = ngo[0][0]; cgo[0][1] = ngo[0][1]; cgo[1][0] = ngo[1][0]; cgo[1][1] = ngo[1][1]; }
        if constexpr (ALIGN_EPI) { if (wr == 1) PG8_BAR; }
    }
    PG8_WAIT_V(0);
    if constexpr (!ALIGN_EPI) { if (wr == 0) PG8_BAR; }
    PG8_BAR;
    if constexpr (Epi::AFTER_DRAIN) { E.fused(acc, cur, wr, wc, fr, fq, lds, wid, lane); S.done(cur); }
#undef PG8_SA
#undef PG8_SB
#undef PG8_STAGE
#undef PG8_STAGE_A
#undef PG8_LDA
#undef PG8_LDB
#undef PG8_MMA
#undef PG8_WAIT_V
#undef PG8_WAIT_L
#undef PG8_BAR
#undef PG8_SCHED
}
}

struct EpiInProj {
    static constexpr bool PERM = false, AFTER_DRAIN = false;
    bf16_t* proj; const float* rope; const float* qn; const float* kn;
    __device__ __forceinline__ void operator()(const f32x4 (&acc)[2][2][4][2], const pg8::Unit& u, int wr, int wc, int fr, int fq) const {
        const int tile = u.pn;
        const bool attn_half = (tile == 0) || (tile == 2) || ((tile == 1 || tile == 3) && wc < 2);
        const bool is_rope = attn_half, is_norm = attn_half && tile >= 2, is_q = (tile == 0) || (tile == 2), is_silu = (tile == 4) || (tile == 5);
        const float* nw = (tile == 3) ? kn : qn;
        f32x4 nwv[2][2];
#pragma unroll
        for (int bj = 0; bj < 2; ++bj)
#pragma unroll
            for (int n = 0; n < 2; ++n) nwv[bj][n] = *(const f32x4*)(nw + 32 * bj + 16 * n + 4 * fq);
        SCHED_FENCE();
#pragma unroll
        for (int ai = 0; ai < 2; ++ai)
#pragma unroll
            for (int m = 0; m < 4; ++m) {
                const int r = u.pm * 256 + ai * 128 + wr * 64 + m * 16 + fr;
                const int b = r / TPB, pp = r - b * TPB;
                const bool latent = pp >= CTX_;
                const int nn = pp - CTX_, prow = nn >> 6, pcol = nn & 63;
                f32x4 v[2][2];
#pragma unroll
                for (int bj = 0; bj < 2; ++bj)
#pragma unroll
                    for (int n = 0; n < 2; ++n) v[bj][n] = acc[ai][bj][m][n];
                if (is_norm) {
                    float ss = 0.f;
#pragma unroll
                    for (int bj = 0; bj < 2; ++bj)
#pragma unroll
                        for (int n = 0; n < 2; ++n) ss += (v[bj][n].x * v[bj][n].x + v[bj][n].y * v[bj][n].y) + (v[bj][n].z * v[bj][n].z + v[bj][n].w * v[bj][n].w);
                    ss += __shfl_xor(ss, 16); ss += __shfl_xor(ss, 32);
                    const float rs = rsqrtf(ss * (1.0f / 64.0f) + EPS_);
#pragma unroll
                    for (int bj = 0; bj < 2; ++bj)
#pragma unroll
                        for (int n = 0; n < 2; ++n) { const f32x4 wv = nwv[bj][n]; v[bj][n].x *= rs * wv.x; v[bj][n].y *= rs * wv.y; v[bj][n].z *= rs * wv.z; v[bj][n].w *= rs * wv.w; }
                }
                if (is_rope && latent) {
#pragma unroll
                    for (int bj = 0; bj < 2; ++bj) {
                        const int pos = bj == 0 ? prow : pcol;
                        const f32x4 c0 = *(const f32x4*)(rope + (pos * 16 + 4 * fq) * 2), c1 = *(const f32x4*)(rope + (pos * 16 + 4 * fq) * 2 + 4);
                        const f32x4 a = v[bj][0], bq = v[bj][1]; f32x4 o0, o1;
                        o0.x = a.x * c0.x - bq.x * c0.y; o1.x = bq.x * c0.x + a.x * c0.y;
                        o0.y = a.y * c0.z - bq.y * c0.w; o1.y = bq.y * c0.z + a.y * c0.w;
                        o0.z = a.z * c1.x - bq.z * c1.y; o1.z = bq.z * c1.x + a.z * c1.y;
                        o0.w = a.w * c1.z - bq.w * c1.w; o1.w = bq.w * c1.z + a.w * c1.w;
                        v[bj][0] = o0; v[bj][1] = o1;
                    }
                }
                if (is_q) {
#pragma unroll
                    for (int bj = 0; bj < 2; ++bj)
#pragma unroll
                        for (int n = 0; n < 2; ++n) v[bj][n] = v[bj][n] * (0.125f * 1.4426950408889634f);
                }
                if (is_silu) {
#pragma unroll
                    for (int bj = 0; bj < 2; ++bj)
#pragma unroll
                        for (int n = 0; n < 2; ++n) { v[bj][n].x = v[bj][n].x * sigmoidf_(v[bj][n].x); v[bj][n].y = v[bj][n].y * sigmoidf_(v[bj][n].y); v[bj][n].z = v[bj][n].z * sigmoidf_(v[bj][n].z); v[bj][n].w = v[bj][n].w * sigmoidf_(v[bj][n].w); }
                }
                bf16_t* dst = proj + (size_t)r * INW + tile * 256 + wc * 64 + 4 * fq;
#pragma unroll
                for (int bj = 0; bj < 2; ++bj)
#pragma unroll
                    for (int n = 0; n < 2; ++n) { u32x2 o; o.x = pack2(v[bj][n].x, v[bj][n].y); o.y = pack2(v[bj][n].z, v[bj][n].w); *(u32x2*)(dst + 32 * bj + 16 * n) = o; }
            }
    }
};
__device__ __forceinline__ void phase_inproj(PRef p, int layer, unsigned char* lds) {
    pg8::Gemm g{(const bf16_t*)(p.ws + OFF_HB), (const bf16_t*)(p.ws + OFF_WIN) + (size_t)layer * INW * D_, D_};
    pg8::DenseSched S; S.init(R_ / 256, INW / 256, get_nblk(), get_bid());
    {
        const int tid = get_tid();
        *(u32x4*)(lds + LDS_ROPE + tid * 16) = *(const u32x4*)(p.ws + OFF_ROPE + tid * 16);
        __syncthreads();
    }
    EpiInProj E{(bf16_t*)(p.ws + OFF_PROJ), (const float*)(lds + LDS_ROPE), p.q_norm_w + layer * 64, p.k_norm_w + layer * 64};
    pg8::gemm_phase<EpiInProj, pg8::DenseSched, true, true>((PG8_LAS unsigned char*)lds, g, S, E);
    if (get_nblk() == 256 && get_bid() >= 184) {
        const int base = (layer == 1 ? CV_OUTTAIL : 0) + (get_bid() - 184);
        for (int k = 0; k < 8; ++k) moe_conv_item(p, layer, base + k * 72, lds);
    }
}

__device__ __forceinline__ void cvt8(const u32x4 w, float* d) {
    d[0] = bflo(w.x); d[1] = bfhi(w.x); d[2] = bflo(w.y); d[3] = bfhi(w.y); d[4] = bflo(w.z); d[5] = bfhi(w.z); d[6] = bflo(w.w); d[7] = bfhi(w.w);
}

__device__ __forceinline__ int chain_pos(int dir, int cc, int j) { return dir == 0 ? cc * 64 + j : (cc < 4 ? (3 - cc) * 64 + 63 - j : TPB - 1 - ((cc - 4) * 64 + j)); }

constexpr int HB_LD = 132, HQ_LD = 136, HV_LD = 72;
constexpr int H_OFF_B = 0, H_OFF_Q = 64 * HB_LD * 4, H_OFF_KK = H_OFF_Q + 64 * HQ_LD * 2, H_OFF_VT = H_OFF_KK + 64 * HQ_LD * 2, H_OFF_KHT = H_OFF_VT + 128 * HV_LD * 2,
              H_OFF_TOT = H_OFF_KHT + 128 * HV_LD * 2, H_LDS = H_OFF_TOT + 4 * 128 * 4;
static_assert(H_LDS <= LDS_BYTES, "hgrn lds");
__device__ __forceinline__ void cvt8f(const f32x4 a, const f32x4 b, float* d) { d[0] = a.x; d[1] = a.y; d[2] = a.z; d[3] = a.w; d[4] = b.x; d[5] = b.y; d[6] = b.z; d[7] = b.w; }
__device__ __forceinline__ bf16x8 pack8(const float* v) { u32x4 w; w.x = pack2(v[0], v[1]); w.y = pack2(v[2], v[3]); w.z = pack2(v[4], v[5]); w.w = pack2(v[6], v[7]); return __builtin_bit_cast(bf16x8, w); }

struct HgLoads { u32x4 z0, z1, q0, q1, v0, v1; f32x4 lb4[4]; };
__device__ __forceinline__ void hgrn_issue_loads(PRef p, int layer, int item, HgLoads& L) {
    const int cc = item % 68, chain = item / 68, dir = chain & 1, h = (chain >> 1) & 3, b = chain >> 3;
    const int tid = get_tid(), lane = tid & 63, wave = tid >> 6;
    const bf16_t* proj = (const bf16_t*)(p.ws + OFF_PROJ);
    const float* lbt = (const float*)(p.ws + OFF_LB) + dir * 512 + h * 128;
    const int j = tid >> 3, kb = (tid & 7) * 16;
    const bf16_t* row = proj + (size_t)(b * TPB + chain_pos(dir, cc, j)) * INW;
    const bf16_t* vrow = proj + (size_t)(b * TPB + chain_pos(dir, cc, lane)) * INW + 2560 + h * 128 + wave * 16;
    L.z0 = *(const u32x4*)(row + (dir == 0 ? 1536 : 2048) + h * 128 + kb); L.z1 = *(const u32x4*)(row + (dir == 0 ? 1536 : 2048) + h * 128 + kb + 8);
    L.q0 = *(const u32x4*)(row + 1024 + h * 128 + kb); L.q1 = *(const u32x4*)(row + 1024 + h * 128 + kb + 8);
    L.v0 = *(const u32x4*)vrow; L.v1 = *(const u32x4*)(vrow + 8);
#pragma unroll
    for (int e = 0; e < 4; ++e) L.lb4[e] = layer == 1 ? *(const f32x4*)(lbt + kb + 4 * e) : (f32x4){0.f, 0.f, 0.f, 0.f};
}
__device__ __forceinline__ void hgrn_load_scan(const HgLoads& L, unsigned char* lds) {
    const int tid = get_tid(), lane = tid & 63, wave = tid >> 6;
    float* Bc = (float*)(lds + H_OFF_B); bf16_t* Qs = (bf16_t*)(lds + H_OFF_Q); bf16_t* KKs = (bf16_t*)(lds + H_OFF_KK); bf16_t* VT = (bf16_t*)(lds + H_OFF_VT); float* Tot = (float*)(lds + H_OFF_TOT);
    {
        const int j = tid >> 3, kb = (tid & 7) * 16;
        const u32x4 z0 = L.z0, z1 = L.z1, q0 = L.q0, q1 = L.q1, v0 = L.v0, v1 = L.v1;
        float z[16], g[16], kk[16]; cvt8(z0, z); cvt8(z1, z + 8);
#pragma unroll
        for (int e = 0; e < 16; ++e) {
            const float lb = L.lb4[e >> 2][e & 3];
            const float sg = sigmoidf_(z[e]); const float f = lb + (1.f - lb) * sg;
            g[e] = __logf(fmaxf(f, 1e-30f)); kk[e] = (1.f - lb) * (1.f - sg);
        }
#pragma unroll
        for (int e = 0; e < 16; e += 4) *(f32x4*)(Bc + j * HB_LD + kb + e) = (f32x4){g[e], g[e + 1], g[e + 2], g[e + 3]};
        *(bf16x8*)(KKs + j * HQ_LD + kb) = pack8(kk); *(bf16x8*)(KKs + j * HQ_LD + kb + 8) = pack8(kk + 8);
        *(u32x4*)(Qs + j * HQ_LD + kb) = q0; *(u32x4*)(Qs + j * HQ_LD + kb + 8) = q1;
        bf16_t* d = VT + (wave * 16) * HV_LD + lane;
        d[0 * HV_LD] = (bf16_t)(v0.x & 0xffffu); d[1 * HV_LD] = (bf16_t)(v0.x >> 16); d[2 * HV_LD] = (bf16_t)(v0.y & 0xffffu); d[3 * HV_LD] = (bf16_t)(v0.y >> 16);
        d[4 * HV_LD] = (bf16_t)(v0.z & 0xffffu); d[5 * HV_LD] = (bf16_t)(v0.z >> 16); d[6 * HV_LD] = (bf16_t)(v0.w & 0xffffu); d[7 * HV_LD] = (bf16_t)(v0.w >> 16);
        d[8 * HV_LD] = (bf16_t)(v1.x & 0xffffu); d[9 * HV_LD] = (bf16_t)(v1.x >> 16); d[10 * HV_LD] = (bf16_t)(v1.y & 0xffffu); d[11 * HV_LD] = (bf16_t)(v1.y >> 16);
        d[12 * HV_LD] = (bf16_t)(v1.z & 0xffffu); d[13 * HV_LD] = (bf16_t)(v1.z >> 16); d[14 * HV_LD] = (bf16_t)(v1.w & 0xffffu); d[15 * HV_LD] = (bf16_t)(v1.w >> 16);
    }
    __syncthreads();
    const int k = tid & 127, seg = tid >> 7;
    float sc[16];
#pragma unroll
    for (int jj = 0; jj < 16; ++jj) sc[jj] = Bc[(seg * 16 + jj) * HB_LD + k];
    SCHED_FENCE();
#pragma unroll
    for (int jj = 1; jj < 16; ++jj) sc[jj] += sc[jj - 1];
    Tot[seg * 128 + k] = sc[15];
    __syncthreads();
    {
        const float t0 = Tot[k], t1 = Tot[128 + k], t2 = Tot[256 + k];
        const float off = seg == 0 ? 0.f : (seg == 1 ? t0 : (seg == 2 ? t0 + t1 : t0 + t1 + t2));
#pragma unroll
        for (int jj = 0; jj < 16; ++jj) Bc[(seg * 16 + jj) * HB_LD + k] = sc[jj] + off;
    }
    __syncthreads();
}

constexpr int H_OFF_PM = H_LDS, HP_LD = 72, H_LDS2 = H_OFF_PM + 64 * HP_LD * 2;
static_assert(H_LDS2 <= LDS_BYTES - 16, "hgrn lds");
__device__ __forceinline__ void hgrn_local_item(PRef p, int layer, int item, unsigned char* lds, const HgLoads& L) {
    const int cc = item % 68, chain = item / 68, dir = chain & 1, h = (chain >> 1) & 3, b = chain >> 3;
    hgrn_load_scan(L, lds);
    const int tid = get_tid(), lane = tid & 63, wave = tid >> 6, fr = lane & 15, fq = lane >> 4;
    const float* Bc = (const float*)(lds + H_OFF_B); const bf16_t* Qs = (const bf16_t*)(lds + H_OFF_Q); const bf16_t* KKs = (const bf16_t*)(lds + H_OFF_KK); const bf16_t* VT = (const bf16_t*)(lds + H_OFF_VT);
    bf16_t* KHT = (bf16_t*)(lds + H_OFF_KHT); bf16_t* Pm = (bf16_t*)(lds + H_OFF_PM);
    {
        const int j = lane, kc = wave * 16;
        float bj[16], be[16], kk[16];
        cvt8f(*(const f32x4*)(Bc + j * HB_LD + kc), *(const f32x4*)(Bc + j * HB_LD + kc + 4), bj); cvt8f(*(const f32x4*)(Bc + j * HB_LD + kc + 8), *(const f32x4*)(Bc + j * HB_LD + kc + 12), bj + 8);
        cvt8f(*(const f32x4*)(Bc + 63 * HB_LD + kc), *(const f32x4*)(Bc + 63 * HB_LD + kc + 4), be); cvt8f(*(const f32x4*)(Bc + 63 * HB_LD + kc + 8), *(const f32x4*)(Bc + 63 * HB_LD + kc + 12), be + 8);
        cvt8(*(const u32x4*)(KKs + j * HQ_LD + kc), kk); cvt8(*(const u32x4*)(KKs + j * HQ_LD + kc + 8), kk + 8);
#pragma unroll
        for (int e = 0; e < 16; ++e) KHT[(kc + e) * HV_LD + j] = (bf16_t)f2bf(kk[e] * __expf(be[e] - bj[e]));
    }
    if (tid < 128) ((float*)(p.ws + OFF_DEC))[(size_t)item * 128 + tid] = __expf(Bc[63 * HB_LD + tid]);
    {
        const int j = tid >> 3, kb = (tid & 7) * 16;
        float bt[16], q8[16], x[16];
        cvt8f(*(const f32x4*)(Bc + j * HB_LD + kb), *(const f32x4*)(Bc + j * HB_LD + kb + 4), bt); cvt8f(*(const f32x4*)(Bc + j * HB_LD + kb + 8), *(const f32x4*)(Bc + j * HB_LD + kb + 12), bt + 8);
        cvt8(*(const u32x4*)(Qs + j * HQ_LD + kb), q8); cvt8(*(const u32x4*)(Qs + j * HQ_LD + kb + 8), q8 + 8);
#pragma unroll
        for (int e = 0; e < 16; ++e) x[e] = q8[e] * __expf(bt[e]);
        bf16_t* qh = (bf16_t*)(p.ws + OFF_QH) + ((size_t)item * 64 + j) * 128 + kb;
        *(bf16x8*)qh = pack8(x); *(bf16x8*)(qh + 8) = pack8(x + 8);
        for (int i = tid; i < 64 * HP_LD * 2 / 16; i += NT) *(u32x4*)((unsigned char*)Pm + i * 16) = (u32x4){0u, 0u, 0u, 0u};
    }
    __syncthreads();
    {
        bf16x8 bfr[2];
#pragma unroll
        for (int ks = 0; ks < 2; ++ks) bfr[ks] = *(const bf16x8*)(VT + (16 * wave + fr) * HV_LD + ks * 32 + fq * 8);
        bf16_t* lt = (bf16_t*)(p.ws + OFF_LT) + ((size_t)item * 128 + 16 * wave + fr) * 128 + 4 * fq;
        bf16x8 afr[8][2];
#pragma unroll
        for (int a = 0; a < 8; ++a)
#pragma unroll
            for (int ks = 0; ks < 2; ++ks) afr[a][ks] = *(const bf16x8*)(KHT + (16 * a + fr) * HV_LD + ks * 32 + fq * 8);
        SCHED_FENCE();
#pragma unroll
        for (int a = 0; a < 8; ++a) {
            f32x4 acc = __builtin_amdgcn_mfma_f32_16x16x32_bf16(afr[a][0], bfr[0], (f32x4){0.f, 0.f, 0.f, 0.f}, 0, 0, 0);
            acc = __builtin_amdgcn_mfma_f32_16x16x32_bf16(afr[a][1], bfr[1], acc, 0, 0, 0);
            u32x2 o; o.x = pack2(acc.x, acc.y); o.y = pack2(acc.z, acc.w);
            *(u32x2*)(lt + 16 * a) = o;
        }
    }
    for (int pi = wave; pi < 10; pi += 8) {
        const int I = pi >= 6 ? 3 : (pi >= 3 ? 2 : (pi >= 1 ? 1 : 0)), J = pi - (I * (I + 1)) / 2;
        const int rrow = (J < I) ? 16 * J + 15 : 16 * I + 7;
        const int s = 16 * J + fr, t = 16 * I + fr;
        f32x4 pacc = (f32x4){0.f, 0.f, 0.f, 0.f};
#pragma unroll
        for (int k2 = 0; k2 < 4; k2 += 2) {
            f32x4 rr[2][2], sb[2][2], tb[2][2]; u32x4 kw[2], qw[2];
#pragma unroll
            for (int d = 0; d < 2; ++d) {
                const int ko = (k2 + d) * 32 + 8 * fq;
                rr[d][0] = *(const f32x4*)(Bc + rrow * HB_LD + ko); rr[d][1] = *(const f32x4*)(Bc + rrow * HB_LD + ko + 4);
                sb[d][0] = *(const f32x4*)(Bc + s * HB_LD + ko); sb[d][1] = *(const f32x4*)(Bc + s * HB_LD + ko + 4);
                tb[d][0] = *(const f32x4*)(Bc + t * HB_LD + ko); tb[d][1] = *(const f32x4*)(Bc + t * HB_LD + ko + 4);
                kw[d] = *(const u32x4*)(KKs + s * HQ_LD + ko); qw[d] = *(const u32x4*)(Qs + t * HQ_LD + ko);
            }
            SCHED_FENCE();
#pragma unroll
            for (int d = 0; d < 2; ++d) {
                float r8[8], bs[8], bt[8], kk[8], q8[8], xk[8], xq[8];
                cvt8f(rr[d][0], rr[d][1], r8); cvt8f(sb[d][0], sb[d][1], bs); cvt8f(tb[d][0], tb[d][1], bt); cvt8(kw[d], kk); cvt8(qw[d], q8);
#pragma unroll
                for (int e = 0; e < 8; ++e) { xk[e] = kk[e] * __expf(fminf(r8[e] - bs[e], 80.f)); xq[e] = q8[e] * __expf(fminf(bt[e] - r8[e], 80.f)); }
                pacc = __builtin_amdgcn_mfma_f32_16x16x32_bf16(pack8(xk), pack8(xq), pacc, 0, 0, 0);
            }
        }
        if (J == I) {
            if (4 * fq + 0 > fr) pacc.x = 0.f;
            if (4 * fq + 1 > fr) pacc.y = 0.f;
            if (4 * fq + 2 > fr) pacc.z = 0.f;
            if (4 * fq + 3 > fr) pacc.w = 0.f;
        }
        u32x2 o; o.x = pack2(pacc.x, pacc.y); o.y = pack2(pacc.z, pacc.w);
        *(u32x2*)(Pm + t * HP_LD + 16 * J + 4 * fq) = o;
    }
    __syncthreads();
    {
        float* obuf = (float*)(p.ws + (dir == 0 ? OFF_OF : OFF_OB));
        bf16x8 vf[2], pfr[4][2];
#pragma unroll
        for (int ks = 0; ks < 2; ++ks) vf[ks] = *(const bf16x8*)(VT + (16 * wave + fr) * HV_LD + ks * 32 + fq * 8);
#pragma unroll
        for (int I = 0; I < 4; ++I)
#pragma unroll
            for (int ks = 0; ks < 2; ++ks) pfr[I][ks] = *(const bf16x8*)(Pm + (16 * I + fr) * HP_LD + ks * 32 + fq * 8);
        SCHED_FENCE();
#pragma unroll
        for (int I = 0; I < 4; ++I) {
            f32x4 acc = __builtin_amdgcn_mfma_f32_16x16x32_bf16(vf[0], pfr[I][0], (f32x4){0.f, 0.f, 0.f, 0.f}, 0, 0, 0);
            if (I >= 2) acc = __builtin_amdgcn_mfma_f32_16x16x32_bf16(vf[1], pfr[I][1], acc, 0, 0, 0);
            *(f32x4*)(obuf + (size_t)(b * TPB + chain_pos(dir, cc, 16 * I + fr)) * 512 + h * 128 + 16 * wave + 4 * fq) = acc;
        }
    }
    __syncthreads();
}

__device__ __forceinline__ void phase_hgrn_c2(PRef p) {
    const int tid = get_tid();
    const bf16_t* LT = (const bf16_t*)(p.ws + OFF_LT); bf16_t* SB = (bf16_t*)(p.ws + OFF_SB); const float* DEC = (const float*)(p.ws + OFF_DEC);
    for (int e = get_bid() * NT + tid; e < 32 * 128 * 32; e += get_nblk() * NT) {
        const int chain = e >> 12, rem = e & 4095, v = rem >> 5, k4 = (rem & 31) * 4;
        float s0 = 0.f, s1 = 0.f, s2 = 0.f, s3 = 0.f;
        const size_t base = (size_t)chain * 68 * 16384 + v * 128 + k4;
        const float* dbase = DEC + (size_t)chain * 68 * 128 + k4;
#define C2_GROUP(C0_, N_) do { u32x2 l[N_]; f32x4 d[N_]; \
            _Pragma("unroll") for (int q = 0; q < (N_); ++q) { l[q] = *(const u32x2*)(LT + base + (size_t)((C0_) + q) * 16384); d[q] = *(const f32x4*)(dbase + (size_t)((C0_) + q) * 128); } \
            SCHED_FENCE(); \
            _Pragma("unroll") for (int q = 0; q < (N_); ++q) { u32x2 o; o.x = pack2(s0, s1); o.y = pack2(s2, s3); *(u32x2*)(SB + base + (size_t)((C0_) + q) * 16384) = o; \
                s0 = d[q].x * s0 + bflo(l[q].x); s1 = d[q].y * s1 + bfhi(l[q].x); s2 = d[q].z * s2 + bflo(l[q].y); s3 = d[q].w * s3 + bfhi(l[q].y); } } while (0)
#pragma unroll 1
        for (int c0 = 0; c0 < 64; c0 += 8) C2_GROUP(c0, 8);
        C2_GROUP(64, 4);
#undef C2_GROUP
    }
}

__device__ __forceinline__ void phase_hgrn_inter(PRef p, int layer, unsigned char* lds) {
    const int tid = get_tid(), lane = tid & 63, wave = tid >> 6, fr = lane & 15, fq = lane >> 4;
    const float* of = (const float*)(p.ws + OFF_OF); const float* ob = (const float*)(p.ws + OFF_OB);
    const bf16_t* proj = (const bf16_t*)(p.ws + OFF_PROJ); bf16_t* mix = (bf16_t*)(p.ws + OFF_MIX);
    for (int wi = get_bid() * 8 + wave; wi < 1088 * 4; wi += get_nblk() * 8) {
        const int tt = wi & 3, item = wi >> 2, tc = item % 68, bh = item / 68, h = bh & 3, b = bh >> 2;
        if (layer == 1 && tc < 4) continue;
        const int tau = tt * 16 + fr; const size_t r = (size_t)b * TPB + tc * 64 + tau;
        f32x4 acc[8];
        u32x2 gwd[8];
#pragma unroll
        for (int vt = 0; vt < 8; ++vt) gwd[vt] = *(const u32x2*)(proj + r * INW + 3072 + h * 128 + 16 * vt + 4 * fq);
        {
            f32x4 a0[8], a1[8];
#pragma unroll
            for (int vt = 0; vt < 8; ++vt) { a0[vt] = *(const f32x4*)(of + r * 512 + h * 128 + 16 * vt + 4 * fq); a1[vt] = *(const f32x4*)(ob + r * 512 + h * 128 + 16 * vt + 4 * fq); }
            __builtin_amdgcn_sched_barrier(0);
#pragma unroll
            for (int vt = 0; vt < 8; ++vt) acc[vt] = a0[vt] + a1[vt];
        }
#pragma unroll
        for (int dir = 0; dir < 2; ++dir) {
            const int chain = (b * 4 + h) * 2 + dir, cc = dir == 0 ? tc : (tc < 4 ? 3 - tc : 71 - tc);
            const size_t it = (size_t)chain * 68 + cc;
            const bf16_t* sb = (const bf16_t*)(p.ws + OFF_SB) + it * 16384 + fr * 128 + 8 * fq;
            const bf16_t* qh = (const bf16_t*)(p.ws + OFF_QH) + it * 8192 + (dir == 0 ? tau : 63 - tau) * 128 + 8 * fq;
#pragma unroll
            for (int kh = 0; kh < 2; ++kh) {
                bf16x8 bf[2], af[2][8];
#pragma unroll
                for (int k2 = 0; k2 < 2; ++k2) {
                    bf[k2] = *(const bf16x8*)(qh + (2 * kh + k2) * 32);
#pragma unroll
                    for (int vt = 0; vt < 8; ++vt) af[k2][vt] = *(const bf16x8*)(sb + vt * 16 * 128 + (2 * kh + k2) * 32);
                }
                __builtin_amdgcn_sched_barrier(0);
#pragma unroll
                for (int k2 = 0; k2 < 2; ++k2)
#pragma unroll
                    for (int vt = 0; vt < 8; ++vt) acc[vt] = __builtin_amdgcn_mfma_f32_16x16x32_bf16(af[k2][vt], bf[k2], acc[vt], 0, 0, 0);
                __builtin_amdgcn_sched_barrier(0);
            }
        }
        float ss = 0.f;
#pragma unroll
        for (int vt = 0; vt < 8; ++vt) ss += (acc[vt].x * acc[vt].x + acc[vt].y * acc[vt].y) + (acc[vt].z * acc[vt].z + acc[vt].w * acc[vt].w);
        ss += __shfl_xor(ss, 16); ss += __shfl_xor(ss, 32);
        const float rs = rsqrtf(ss * (1.0f / 128.0f) + EPS_);
        f32x4 gwv[8];
#pragma unroll
        for (int vt = 0; vt < 8; ++vt) gwv[vt] = *(const f32x4*)(p.gate_norm_w + layer * 128 + 16 * vt + 4 * fq);
        SCHED_FENCE();
#pragma unroll
        for (int vt = 0; vt < 8; ++vt) {
            const int vcol = h * 128 + 16 * vt + 4 * fq;
            const f32x4 gw = gwv[vt];
            const float g0 = bflo(gwd[vt].x), g1 = bfhi(gwd[vt].x), g2 = bflo(gwd[vt].y), g3 = bfhi(gwd[vt].y);
            u32x2 o;
            o.x = pack2(acc[vt].x * rs * gw.x * (g0 * sigmoidf_(g0)), acc[vt].y * rs * gw.y * (g1 * sigmoidf_(g1)));
            o.y = pack2(acc[vt].z * rs * gw.z * (g2 * sigmoidf_(g2)), acc[vt].w * rs * gw.w * (g3 * sigmoidf_(g3)));
            *(u32x2*)(mix + r * D_ + 512 + vcol) = o;
        }
    }
}

constexpr int AT_LDK = 80, AT_LDV = 136;
constexpr int AT_KBYTES = 128 * AT_LDK * 2, AT_VBYTES = 64 * AT_LDV * 2, AT_STAGE = AT_KBYTES + AT_VBYTES;
static_assert(2 * AT_STAGE <= LDS_BYTES - 16, "attention lds");
constexpr float LOG2E_ = 1.4426950408889634f;
struct AtRegs { u32x4 k0, k1, v0, v1; };
__device__ __forceinline__ float max3f(float a, float b, float c) { float r; asm("v_max3_f32 %0, %1, %2, %3" : "=v"(r) : "v"(a), "v"(b), "v"(c)); return r; }
__device__ __forceinline__ void at_tile(const unsigned char* Ks, const unsigned char* VT, const bf16x8 (&qf)[2][2], f32x4 (&oacc)[2][4], float (&m)[2], float (&l)[2],
                                        int fr, int fq, bool masked, int nq0, int nk0, bool first) {
    f32x4 sacc[2][2][4];
    {
        bf16x8 kf[2][4][2];
        const unsigned char* kp = Ks + (fr * AT_LDK + fq * 8) * 2;
#pragma unroll
        for (int h = 0; h < 2; ++h)
#pragma unroll
            for (int n = 0; n < 4; ++n)
#pragma unroll
                for (int ks = 0; ks < 2; ++ks) kf[h][n][ks] = *(const bf16x8*)(kp + ((h * 64 + n * 16) * AT_LDK + ks * 32) * 2);
        SCHED_FENCE();
#pragma unroll
        for (int h = 0; h < 2; ++h)
#pragma unroll
            for (int qt = 0; qt < 2; ++qt)
#pragma unroll
                for (int n = 0; n < 4; ++n) {
                    sacc[h][qt][n] = __builtin_amdgcn_mfma_f32_16x16x32_bf16(kf[h][n][0], qf[qt][0], (f32x4){-m[qt], -m[qt], -m[qt], -m[qt]}, 0, 0, 0);
                    sacc[h][qt][n] = __builtin_amdgcn_mfma_f32_16x16x32_bf16(kf[h][n][1], qf[qt][1], sacc[h][qt][n], 0, 0, 0);
                }
    }
    if (masked) {
#pragma unroll
        for (int h = 0; h < 2; ++h)
#pragma unroll
            for (int qt = 0; qt < 2; ++qt) {
                const int nq = nq0 + qt * 16;
#pragma unroll
                for (int n = 0; n < 4; ++n)
#pragma unroll
                    for (int i = 0; i < 4; ++i) { const int df = nq - (nk0 + h * 64 + n * 16 + i); if (df > 128 || df < -128) sacc[h][qt][n][i] = -1e30f; }
            }
    }
    float mx[2];
#pragma unroll
    for (int qt = 0; qt < 2; ++qt) {
        float t = max3f(sacc[0][qt][0].x, sacc[0][qt][0].y, sacc[0][qt][0].z);
#pragma unroll
        for (int h = 0; h < 2; ++h)
#pragma unroll
            for (int n = 0; n < 4; ++n) { if (h | n) t = max3f(t, sacc[h][qt][n].x, sacc[h][qt][n].y); t = max3f(t, sacc[h][qt][n].z, sacc[h][qt][n].w); }
        mx[qt] = t;
    }
    { const float a0 = __shfl_xor(mx[0], 16), a1 = __shfl_xor(mx[1], 16); mx[0] = fmaxf(mx[0], a0); mx[1] = fmaxf(mx[1], a1); }
    { const float a0 = __shfl_xor(mx[0], 32), a1 = __shfl_xor(mx[1], 32); mx[0] = fmaxf(mx[0], a0); mx[1] = fmaxf(mx[1], a1); }
    if (first || __any(fmaxf(mx[0], mx[1]) > 8.f)) {
#pragma unroll
        for (int qt = 0; qt < 2; ++qt) {
            const float dl = first ? fmaxf(mx[qt], -1e30f) : fmaxf(mx[qt], 0.f);
            const float corr = __builtin_amdgcn_exp2f(-dl);
            m[qt] += dl; l[qt] *= corr;
#pragma unroll
            for (int dt = 0; dt < 4; ++dt) oacc[qt][dt] = oacc[qt][dt] * corr;
#pragma unroll
            for (int h = 0; h < 2; ++h)
#pragma unroll
                for (int n = 0; n < 4; ++n) sacc[h][qt][n] = sacc[h][qt][n] - dl;
        }
    }
#pragma unroll
    for (int h = 0; h < 2; ++h) {
        u32x2 vlo[4][2], vhi[4][2];
        const unsigned char* vp = VT + (fr * AT_LDV + h * 64 + 4 * fq) * 2;
#pragma unroll
        for (int dt = 0; dt < 4; ++dt)
#pragma unroll
            for (int s = 0; s < 2; ++s) {
                vlo[dt][s] = *(const u32x2*)(vp + (dt * 16 * AT_LDV + s * 32) * 2);
                vhi[dt][s] = *(const u32x2*)(vp + (dt * 16 * AT_LDV + s * 32 + 16) * 2);
            }
        bf16x8 pf[2][2];
#pragma unroll
        for (int qt = 0; qt < 2; ++qt) {
            float ls = l[qt];
            float pe[4][4];
#pragma unroll
            for (int n = 0; n < 4; ++n) { pe[n][0] = __builtin_amdgcn_exp2f(sacc[h][qt][n].x); pe[n][1] = __builtin_amdgcn_exp2f(sacc[h][qt][n].y); pe[n][2] = __builtin_amdgcn_exp2f(sacc[h][qt][n].z); pe[n][3] = __builtin_amdgcn_exp2f(sacc[h][qt][n].w);
                                          ls += (pe[n][0] + pe[n][1]) + (pe[n][2] + pe[n][3]); }
            l[qt] = ls;
#pragma unroll
            for (int s = 0; s < 2; ++s) {
                u32x4 w; w.x = pack2(pe[2 * s][0], pe[2 * s][1]); w.y = pack2(pe[2 * s][2], pe[2 * s][3]); w.z = pack2(pe[2 * s + 1][0], pe[2 * s + 1][1]); w.w = pack2(pe[2 * s + 1][2], pe[2 * s + 1][3]);
                pf[qt][s] = __builtin_bit_cast(bf16x8, w);
            }
        }
#pragma unroll
        for (int dt = 0; dt < 4; ++dt)
#pragma unroll
            for (int s = 0; s < 2; ++s) {
                u32x4 w; w.x = vlo[dt][s].x; w.y = vlo[dt][s].y; w.z = vhi[dt][s].x; w.w = vhi[dt][s].y;
                const bf16x8 vf = __builtin_bit_cast(bf16x8, w);
#pragma unroll
                for (int qt = 0; qt < 2; ++qt) oacc[qt][dt] = __builtin_amdgcn_mfma_f32_16x16x32_bf16(vf, pf[qt][s], oacc[qt][dt], 0, 0, 0);
            }
    }
}
__device__ __forceinline__ void attn_mfma_item(PRef p, int layer, int item, unsigned char* lds) {
    const int tid = get_tid(), lane = tid & 63, wave = tid >> 6, fr = lane & 15, fq = lane >> 4;
    const int mixer = item / 272; int rem = item - mixer * 272; const int b = rem / 68; rem -= b * 68; const int kvh = rem / 34, qb = rem - kvh * 34;
    const int p0 = qb * 128; const bool ctxblk = p0 < CTX_;
    const int head = kvh * 2 + (wave >> 2);
    const int qrow0 = p0 + (wave & 3) * 32;
    const bf16_t* proj = (const bf16_t*)(p.ws + OFF_PROJ);
    bf16_t* mix = (bf16_t*)(p.ws + OFF_MIX);
    const int qcol = (mixer == 0 ? 0 : 512) + head * 64, kcol = (mixer == 0 ? 256 : 768) + kvh * 64, vcol = (mixer == 0 ? 384 : 896) + kvh * 64;
    bf16x8 qf[2][2];
#pragma unroll
    for (int qt = 0; qt < 2; ++qt)
#pragma unroll
        for (int ks = 0; ks < 2; ++ks) qf[qt][ks] = *(const bf16x8*)(proj + (size_t)(b * TPB + qrow0 + qt * 16 + fr) * INW + qcol + ks * 32 + fq * 8);
    f32x4 oacc[2][4];
#pragma unroll
    for (int qt = 0; qt < 2; ++qt)
#pragma unroll
        for (int dt = 0; dt < 4; ++dt) oacc[qt][dt] = (f32x4){0.f, 0.f, 0.f, 0.f};
    float m[2], l[2];
    if (mixer == 0) { const float sk = p.attn_sink[layer * 4 + head] * LOG2E_; m[0] = sk; m[1] = sk; l[0] = fq == 0 ? 1.f : 0.f; l[1] = l[0]; }
    else { m[0] = 0.f; m[1] = 0.f; l[0] = 0.f; l[1] = 0.f; }
    int tlo, thi;
    if (ctxblk) { tlo = 2; thi = 1; } else if (mixer == 1) { tlo = 2; thi = 33; } else { tlo = qb - 1 < 2 ? 2 : qb - 1; thi = qb + 1 > 33 ? 33 : qb + 1; }
    const int ntile = 2 + (thi - tlo + 1);
    const int srow = tid >> 3, sc8 = tid & 7;
    const bf16_t* kbase = proj + (size_t)(b * TPB + srow) * INW + kcol + sc8 * 8;
    const bf16_t* vbase = proj + (size_t)(b * TPB + lane) * INW + vcol + wave * 8;
    const int nq0 = qrow0 + fr - CTX_;
    const bool mixA = (mixer == 0);
#define AT_TID(ti_) ((ti_) < 2 ? (ti_) : tlo + (ti_) - 2)
#define AT_CL(ti_) ((ti_) < ntile ? (ti_) : ntile - 1)
#define AT_LOAD(R_, ti_) do { const size_t ro_ = (size_t)AT_TID(AT_CL(ti_)) * 128 * INW; R_.k0 = *(const u32x4*)(kbase + ro_); R_.k1 = *(const u32x4*)(kbase + ro_ + (size_t)64 * INW); \
                              R_.v0 = *(const u32x4*)(vbase + ro_); R_.v1 = *(const u32x4*)(vbase + ro_ + (size_t)64 * INW); } while (0)
#define AT_ST8(VT_, key_, w_) do { VT_[(wave * 8 + 0) * AT_LDV + (key_)] = (bf16_t)((w_).x & 0xffffu); VT_[(wave * 8 + 1) * AT_LDV + (key_)] = (bf16_t)((w_).x >> 16); \
        VT_[(wave * 8 + 2) * AT_LDV + (key_)] = (bf16_t)((w_).y & 0xffffu); VT_[(wave * 8 + 3) * AT_LDV + (key_)] = (bf16_t)((w_).y >> 16); \
        VT_[(wave * 8 + 4) * AT_LDV + (key_)] = (bf16_t)((w_).z & 0xffffu); VT_[(wave * 8 + 5) * AT_LDV + (key_)] = (bf16_t)((w_).z >> 16); \
        VT_[(wave * 8 + 6) * AT_LDV + (key_)] = (bf16_t)((w_).w & 0xffffu); VT_[(wave * 8 + 7) * AT_LDV + (key_)] = (bf16_t)((w_).w >> 16); } while (0)
#define AT_STORE(buf_, R_) do { unsigned char* Ks_ = lds + (buf_) * AT_STAGE; bf16_t* VT_ = (bf16_t*)(Ks_ + AT_KBYTES); \
        *(u32x4*)(Ks_ + (srow * AT_LDK + sc8 * 8) * 2) = R_.k0; *(u32x4*)(Ks_ + ((srow + 64) * AT_LDK + sc8 * 8) * 2) = R_.k1; \
        AT_ST8(VT_, lane, R_.v0); AT_ST8(VT_, lane + 64, R_.v1); } while (0)
    AtRegs RA;
    asm volatile("" :: "v"(qf[0][0]), "v"(qf[0][1]), "v"(qf[1][0]), "v"(qf[1][1]));
    AT_LOAD(RA, 0); AT_STORE(0, RA);
    AT_LOAD(RA, 1);
    __syncthreads();
#pragma unroll 1
    for (int ti = 0; ti < ntile; ++ti) {
        const int t_ = AT_TID(ti); const bool mk_ = mixA && (t_ >= 2); const int nk_ = t_ * 128 + 4 * fq - CTX_;
        const int buf = ti & 1;
        AT_STORE(buf ^ 1, RA);
        AT_LOAD(RA, ti + 2); SCHED_FENCE();
        const unsigned char* Ks = lds + buf * AT_STAGE;
        at_tile(Ks, Ks + AT_KBYTES, qf, oacc, m, l, fr, fq, mk_, nq0, nk_, ti == 0);
        __syncthreads();
    }
#undef AT_TID
#undef AT_CL
#undef AT_LOAD
#undef AT_ST8
#undef AT_STORE
#pragma unroll
    for (int qt = 0; qt < 2; ++qt) {
        float lt = l[qt]; lt += __shfl_xor(lt, 16); lt += __shfl_xor(lt, 32);
        const float inv = 1.f / lt;
        bf16_t* dst = mix + (size_t)(b * TPB + qrow0 + qt * 16 + fr) * D_ + (mixer == 0 ? 0 : 256) + head * 64 + 4 * fq;
#pragma unroll
        for (int dt = 0; dt < 4; ++dt) { u32x2 o; o.x = pack2(oacc[qt][dt].x * inv, oacc[qt][dt].y * inv); o.y = pack2(oacc[qt][dt].z * inv, oacc[qt][dt].w * inv); *(u32x2*)(dst + dt * 16) = o; }
    }
}

__device__ __forceinline__ void phase_mixers(PRef p, int layer, unsigned char* lds) {
    constexpr int N_A = 544, N_C1 = 2176;
    const int nblk = get_nblk();
    int it = get_bid();
    int cidx = (nblk == 256 ? (layer == 1 ? CV_OUTTAIL + CV_INTAIL : CV_INTAIL) : 0) + get_bid();
    if (get_bid() & 1) { for (; cidx < N_MOECONV; cidx += nblk) moe_conv_item(p, layer, cidx, lds); }
    for (; it < N_A; it += nblk) {
        int a;
        if (it < 256) { const int g = it >> 5, qb = 2 + (it & 31); a = 272 + g * 34 + qb; }
        else if (it < 512) { const int j = it - 256, g = j >> 5, qb = 2 + (j & 31); a = g * 34 + qb; }
        else if (it < 528) { const int j = it - 512; a = 272 + (j >> 1) * 34 + (j & 1); }
        else { const int j = it - 528; a = (j >> 1) * 34 + (j & 1); }
        for (int rep = 0; rep < (((PROBE_MASK1 >> (it < 256 ? 13 : 15)) & 1) ? 2 : 1); ++rep) { attn_mfma_item(p, layer, a, lds); __syncthreads(); }
    }
    if (it < N_A + N_C1) {
        HgLoads cur; hgrn_issue_loads(p, layer, it - N_A, cur);
        for (; it < N_A + N_C1; it += nblk) {
            HgLoads nxt; const bool hn = it + nblk < N_A + N_C1;
            hgrn_issue_loads(p, layer, (hn ? it + nblk : it) - N_A, nxt);
            SCHED_FENCE();
            for (int rep = 0; rep < (((PROBE_MASK1 >> 14) & 1) ? 2 : 1); ++rep) hgrn_local_item(p, layer, it - N_A, lds, cur);
            cur = nxt;
            __syncthreads();
        }
    }
    for (; cidx < N_MOECONV; cidx += nblk) moe_conv_item(p, layer, cidx, lds);
}

struct EpiOutProj {
    static constexpr bool PERM = false, AFTER_DRAIN = false;
    float* xs; const float* modl;
    __device__ __forceinline__ void operator()(const f32x4 (&acc)[2][2][4][2], const pg8::Unit& u, int wr, int wc, int fr, int fq) const {
        const int col0 = u.pn * 256 + wc * 64 + 16 * fq;
        const int r00 = u.pm * 256, b0 = r00 / TPB, pp0 = r00 - b0 * TPB;
        const float* g1 = modl + (size_t)(pp0 < CTX_ ? 4 : b0) * 6144 + 2048 + col0;
        f32x4 gv[4];
#pragma unroll
        for (int q = 0; q < 4; ++q) gv[q] = *(const f32x4*)(g1 + 4 * q);
#pragma unroll
        for (int ai = 0; ai < 2; ++ai)
#pragma unroll
            for (int m = 0; m < 4; m += 2) {
                float* xp0 = xs + (size_t)(u.pm * 256 + ai * 128 + wr * 64 + m * 16 + fr) * D_ + col0;
                float* xp1 = xp0 + (size_t)16 * D_;
                f32x4 x0[4], x1[4];
#pragma unroll
                for (int q = 0; q < 4; ++q) { x0[q] = *(const f32x4*)(xp0 + 4 * q); x1[q] = *(const f32x4*)(xp1 + 4 * q); }
                SCHED_FENCE();
#pragma unroll
                for (int bj = 0; bj < 2; ++bj)
#pragma unroll
                    for (int n = 0; n < 2; ++n) {
                        const int q = 2 * bj + n;
                        *(f32x4*)(xp0 + 4 * q) = x0[q] + gv[q] * acc[ai][bj][m][n];
                        *(f32x4*)(xp1 + 4 * q) = x1[q] + gv[q] * acc[ai][bj][m + 1][n];
                    }
                SCHED_FENCE();
            }
    }
};
struct OutProjSched : pg8::TileOrder {
    static constexpr bool GATHER = false;
    bool skipctx;
    __device__ __forceinline__ bool next(int i, pg8::Unit& u) const { int pm, pn; if (!map(i, pm, pn)) return false; u.pm = skipctx ? pm + (pm >> 4) + 1 : pm; u.pn = pn; u.aux = 0; return true; }
    __device__ __forceinline__ void a_ready(const pg8::Unit&) const {}
    __device__ __forceinline__ void done(const pg8::Unit&) const {}
};
__device__ __forceinline__ void phase_outproj(PRef p, int layer, unsigned char* lds) {
    pg8::Gemm g{(const bf16_t*)(p.ws + OFF_MIX), (const bf16_t*)(p.ws + OFF_WOUT) + (size_t)layer * D_ * D_, D_};
    OutProjSched S; S.skipctx = (layer == 1); S.init(layer == 1 ? 64 : R_ / 256, D_ / 256, get_nblk(), get_bid());
    EpiOutProj E{(float*)(p.ws + OFF_XS), (const float*)(p.ws + OFF_MOD) + (size_t)layer * 5 * 6144};
    pg8::gemm_phase<EpiOutProj, OutProjSched, true, true>((PG8_LAS unsigned char*)lds, g, S, E);
    if (layer == 0 && get_nblk() == 256 && get_bid() >= 16) {
        for (int k = 0; k < 8; ++k) moe_conv_item(p, 1, (get_bid() - 16) + k * 240, lds);
    }
}

constexpr int RW_LD = 1028;
__device__ __forceinline__ float router_reduce(float (&part)[32], int lane) {
#pragma unroll
    for (int i = 0; i < 16; ++i) { const bool hi = (lane & 32) != 0; const float send = hi ? part[i] : part[i + 16], keep = hi ? part[i + 16] : part[i]; part[i] = keep + __shfl_xor(send, 32); }
#pragma unroll
    for (int i = 0; i < 8; ++i) { const bool hi = (lane & 16) != 0; const float send = hi ? part[i] : part[i + 8], keep = hi ? part[i + 8] : part[i]; part[i] = keep + __shfl_xor(send, 16); }
#pragma unroll
    for (int i = 0; i < 4; ++i) { const bool hi = (lane & 8) != 0; const float send = hi ? part[i] : part[i + 4], keep = hi ? part[i + 4] : part[i]; part[i] = keep + __shfl_xor(send, 8); }
#pragma unroll
    for (int i = 0; i < 2; ++i) { const bool hi = (lane & 4) != 0; const float send = hi ? part[i] : part[i + 2], keep = hi ? part[i + 2] : part[i]; part[i] = keep + __shfl_xor(send, 4); }
    { const bool hi = (lane & 2) != 0; const float send = hi ? part[0] : part[1], keep = hi ? part[1] : part[0]; part[0] = keep + __shfl_xor(send, 2); }
    return part[0] + __shfl_xor(part[0], 1);
}
__device__ __forceinline__ void router_commit(float myv, int lane, bool routed, int lr, int* lcnt, int* lsel, int* lpos, float* lgate) {
    const int e_me = lane >> 1;
    int rank = 0;
#pragma unroll
    for (int e = 0; e < 32; ++e) {
        const float le = __int_as_float(__builtin_amdgcn_readlane(__float_as_int(myv), 2 * e));
        rank += ((le > myv) || (le == myv && e < e_me)) ? 1 : 0;
    }
    if (lane & 1) rank = 99;
    int sel[4]; float sv[4];
#pragma unroll
    for (int t = 0; t < 4; ++t) {
        const unsigned long long mk = __builtin_amdgcn_ballot_w64(rank == t);
        const int src = __builtin_amdgcn_readfirstlane((int)__builtin_ctzll(mk));
        sel[t] = src >> 1; sv[t] = __int_as_float(__builtin_amdgcn_readlane(__float_as_int(myv), src));
    }
    const float e0 = 1.f, e1 = __expf(sv[1] - sv[0]), e2 = __expf(sv[2] - sv[0]), e3 = __expf(sv[3] - sv[0]);
    const float isum = 1.f / (e0 + e1 + e2 + e3);
    if (lane == 0) {
        const float gs[4] = {e0 * isum, e1 * isum, e2 * isum, e3 * isum};
#pragma unroll
        for (int t = 0; t < 4; ++t) {
            if (routed) { const int lp = atomicAdd(lcnt + sel[t], 1); lsel[lr * 4 + t] = sel[t]; lpos[lr * 4 + t] = lp; lgate[lr * 4 + t] = gs[t]; }
            else { lsel[lr * 4 + t] = -1; lpos[lr * 4 + t] = 0; lgate[lr * 4 + t] = 0.f; }
        }
    }
}
__device__ __forceinline__ void phase_router(PRef p, int layer, unsigned char* ldsraw) {
    float* RW = (float*)ldsraw;
    int* lcnt = (int*)(ldsraw + 32 * RW_LD * 4);
    int* lbase = lcnt + 32;
    int* lsel = lbase + 32; int* lpos = lsel + 288; float* lgate = (float*)(lpos + 288);
    const int tid = get_tid(), wave = tid >> 6, lane = tid & 63;
    {
        f32x4 rw[16];
#pragma unroll
        for (int q = 0; q < 16; ++q) rw[q] = *(const f32x4*)(p.router_w + (size_t)layer * 32768 + (size_t)(q * NT + tid) * 4);
        SCHED_FENCE();
#pragma unroll
        for (int q = 0; q < 16; ++q) { const int i = (q * NT + tid) * 4, c = i >> 5, e = i & 31; RW[e * RW_LD + c] = rw[q].x; RW[(e + 1) * RW_LD + c] = rw[q].y; RW[(e + 2) * RW_LD + c] = rw[q].z; RW[(e + 3) * RW_LD + c] = rw[q].w; }
    }
    if (tid < 32) lcnt[tid] = 0;
    __syncthreads();
    float* xs = (float*)(p.ws + OFF_XS); bf16_t* hb = (bf16_t*)(p.ws + OFF_HB);
    const float* modv = (const float*)(p.ws + OFF_MOD) + (size_t)layer * 5 * 6144;
    const int chunk = (R_ + get_nblk() - 1) / get_nblk();
    const int r0 = get_bid() * chunk, r1 = (r0 + chunk < R_) ? r0 + chunk : R_;
    const float rbias = p.router_b[layer * 32 + (lane >> 1)];
    f32x4 wv2[4]; load_row4(p.norm2_w + layer * D_, lane, wv2);
    for (int rA = r0 + wave; rA < r1; rA += 16) {
        const bool hasB = rA + 8 < r1; const int rB = hasB ? rA + 8 : rA;
        const int bA = rA / TPB, ppA = rA - bA * TPB, bB = rB / TPB, ppB = rB - bB * TPB;
        f32x4 hvA[4], hvB[4];
        {
            f32x4 vA[4], vB[4], scA[4], shA[4], scB[4], shB[4];
            const float* mvA = modv + (size_t)(ppA < CTX_ ? 4 : bA) * 6144; const float* mvB = modv + (size_t)(ppB < CTX_ ? 4 : bB) * 6144;
            load_row4(xs + (size_t)rA * D_, lane, vA); load_row4(xs + (size_t)rB * D_, lane, vB);
            load_row4(mvA + 4096, lane, scA); load_row4(mvA + 3072, lane, shA); load_row4(mvB + 4096, lane, scB); load_row4(mvB + 3072, lane, shB);
            SCHED_FENCE();
            const float rsA = row_rstd(vA), rsB = row_rstd(vB);
            norm_apply_store(vA, rsA, wv2, scA, shA, hb + (size_t)rA * D_, lane, hvA);
            norm_apply_store(vB, rsB, wv2, scB, shB, hb + (size_t)rB * D_, lane, hvB);
        }
        float pA[32], pB[32];
#pragma unroll
        for (int e0 = 0; e0 < 32; e0 += 4) {
            f32x4 w[4][4];
#pragma unroll
            for (int q = 0; q < 4; ++q)
#pragma unroll
                for (int j = 0; j < 4; ++j) w[q][j] = *(const f32x4*)(RW + (e0 + q) * RW_LD + 4 * lane + 256 * j);
            SCHED_FENCE();
#pragma unroll
            for (int q = 0; q < 4; ++q) {
                float a = 0.f, c = 0.f;
#pragma unroll
                for (int j = 0; j < 4; ++j) { a = fmaf(hvA[j].x, w[q][j].x, a); a = fmaf(hvA[j].y, w[q][j].y, a); a = fmaf(hvA[j].z, w[q][j].z, a); a = fmaf(hvA[j].w, w[q][j].w, a);
                                              c = fmaf(hvB[j].x, w[q][j].x, c); c = fmaf(hvB[j].y, w[q][j].y, c); c = fmaf(hvB[j].z, w[q][j].z, c); c = fmaf(hvB[j].w, w[q][j].w, c); }
                pA[e0 + q] = a; pB[e0 + q] = c;
            }
            SCHED_FENCE();
        }
        const float lgA = router_reduce(pA, lane) + rbias, lgB = router_reduce(pB, lane) + rbias;
        router_commit(lgA, lane, !(layer == 1 && ppA < CTX_), rA - r0, lcnt, lsel, lpos, lgate);
        if (hasB) router_commit(lgB, lane, !(layer == 1 && ppB < CTX_), rB - r0, lcnt, lsel, lpos, lgate);
    }
    __syncthreads();
    if (tid < 32) lbase[tid] = atomicAdd((int*)(p.ws + OFF_CTL) + layer * 32 + tid, lcnt[tid]);
    __syncthreads();
    float* gate = (float*)(p.ws + OFF_GATE); int* rowe = (int*)(p.ws + OFF_ROWE);
    for (int i = tid; i < (r1 - r0) * 4; i += NT) { const int e = lsel[i]; if (e >= 0) { rowe[(size_t)e * ROWE_CAP + lbase[e] + lpos[i]] = r0 * 4 + i; gate[r0 * 4 + i] = lgate[i]; } }
    __syncthreads();
}

__device__ __forceinline__ void moe_offsets(PRef p, int layer, int* off) {
    const int tid = get_tid();
    if (tid == 0) { const int* cnt = (const int*)(p.ws + OFF_CTL) + layer * 32; int a = 0; for (int e = 0; e < 32; ++e) { const int c = cnt[e]; off[e] = a; off[40 + e] = c; a += (c + 255) & ~255; } off[32] = a; }
    __syncthreads();
    if (tid < PMAX / 256) { int e = 0; for (int q = 1; q < 32; ++q) e += (off[q] <= tid * 256) ? 1 : 0; off[96 + tid] = e; }
    __syncthreads();
}

struct EpiMoe1 {
    static constexpr bool PERM = false, AFTER_DRAIN = false;
    bf16_t* act; const float* b1l;
    __device__ __forceinline__ void operator()(const f32x4 (&acc)[2][2][4][2], const pg8::Unit& u, int wr, int wc, int fr, int fq) const {
        const int e = u.aux >> 8, ln = u.aux & 255;
        const int ucol0 = ln * 256 + wc * 64 + 16 * fq;
        const float* b1 = b1l + (size_t)e * 2048 + ucol0;
        f32x4 bv[2][2];
#pragma unroll
        for (int bj = 0; bj < 2; ++bj)
#pragma unroll
            for (int n = 0; n < 2; ++n) bv[bj][n] = *(const f32x4*)(b1 + 8 * bj + 4 * n);
#pragma unroll
        for (int ai = 0; ai < 2; ++ai)
#pragma unroll
            for (int m = 0; m < 4; ++m) {
                const int prow = u.pm * 256 + ai * 128 + wr * 64 + m * 16 + fr;
                u32x4 o; unsigned ow[4];
#pragma unroll
                for (int bj = 0; bj < 2; ++bj)
#pragma unroll
                    for (int n = 0; n < 2; ++n) {
                        const f32x4 uu = acc[ai][bj][m][n] + bv[bj][n];
                        const float g0 = fminf(uu.x, 7.f), l0 = fminf(fmaxf(uu.y, -7.f), 7.f), g1 = fminf(uu.z, 7.f), l1 = fminf(fmaxf(uu.w, -7.f), 7.f);
                        const float y0 = g0 * sigmoidf_(1.702f * g0) * (l0 + 1.f), y1 = g1 * sigmoidf_(1.702f * g1) * (l1 + 1.f);
                        ow[2 * bj + n] = pack2(y0, y1);
                    }
                o.x = ow[0]; o.y = ow[1]; o.z = ow[2]; o.w = ow[3];
                *(u32x4*)(act + (size_t)prow * DFF + (ucol0 >> 1)) = o;
            }
    }
};
__device__ __forceinline__ void phase_moe1(PRef p, int layer, unsigned char* lds) {
    int* off = (int*)(lds + pg8::STAGE_BYTES);
    moe_offsets(p, layer, off);
    pg8::Gemm g{(const bf16_t*)(p.ws + OFF_HB), (const bf16_t*)(p.ws + OFF_W1) + (size_t)layer * NE * 2048 * D_, D_};
    pg8::MoeSched<true> S; S.init(off[32] >> 8, 8, get_nblk(), get_bid()); S.tab = off; S.rowe = (const int*)(p.ws + OFF_ROWE); S.K2 = D_ * 2;
    EpiMoe1 E{(bf16_t*)(p.ws + OFF_ACT), p.b1 + (size_t)layer * NE * 2048};
    pg8::gemm_phase<EpiMoe1, pg8::MoeSched<true>, true, true>((PG8_LAS unsigned char*)lds, g, S, E);
}

struct EpiMoe2 {
    static constexpr bool PERM = false, AFTER_DRAIN = false;
    bf16_t* ybuf; const float* b2l; const int* rowe; const int* tab; const float* gate;
    __device__ __forceinline__ void operator()(const f32x4 (&acc)[2][2][4][2], const pg8::Unit& u, int wr, int wc, int fr, int fq) const {
        const int e = u.aux >> 8, ln = u.aux & 255;
        const int col0 = ln * 256 + wc * 64 + 16 * fq;
        const float* b2 = b2l + (size_t)e * D_ + col0;
        f32x4 bv[2][2];
#pragma unroll
        for (int bj = 0; bj < 2; ++bj)
#pragma unroll
            for (int n = 0; n < 2; ++n) bv[bj][n] = *(const f32x4*)(b2 + 8 * bj + 4 * n);
#pragma unroll
        for (int ai = 0; ai < 2; ++ai)
#pragma unroll
            for (int m = 0; m < 4; ++m) {
                const int pos = u.pm * 256 - tab[e] + ai * 128 + wr * 64 + m * 16 + fr;
                const int idx = pos < tab[40 + e] ? rowe[(size_t)e * ROWE_CAP + pos] : -1;
                if (idx >= 0) {
                    const float gt = gate[idx];
                    unsigned ow[8];
#pragma unroll
                    for (int bj = 0; bj < 2; ++bj)
#pragma unroll
                        for (int n = 0; n < 2; ++n) { const f32x4 y = (acc[ai][bj][m][n] + bv[bj][n]) * gt; ow[4 * bj + 2 * n] = pack2(y.x, y.y); ow[4 * bj + 2 * n + 1] = pack2(y.z, y.w); }
                    u32x4 o0, o1; o0.x = ow[0]; o0.y = ow[1]; o0.z = ow[2]; o0.w = ow[3]; o1.x = ow[4]; o1.y = ow[5]; o1.z = ow[6]; o1.w = ow[7];
                    bf16_t* d = ybuf + (size_t)idx * D_ + col0;
                    *(u32x4*)d = o0; *(u32x4*)(d + 8) = o1;
                }
            }
    }
};
__device__ __forceinline__ void phase_moe2(PRef p, int layer, unsigned char* lds) {
    int* off = (int*)(lds + pg8::STAGE_BYTES);
    moe_offsets(p, layer, off);
    pg8::Gemm g{(const bf16_t*)(p.ws + OFF_ACT), (const bf16_t*)(p.ws + OFF_W2) + (size_t)layer * NE * D_ * DFF, DFF};
    pg8::MoeSched<false> S; S.init(off[32] >> 8, 4, get_nblk(), get_bid()); S.tab = off; S.rowe = nullptr; S.K2 = 0;
    EpiMoe2 E{(bf16_t*)(p.ws + OFF_YBUF), p.b2 + (size_t)layer * NE * D_, (const int*)(p.ws + OFF_ROWE), off, (const float*)(p.ws + OFF_GATE)};
    pg8::gemm_phase<EpiMoe2, pg8::MoeSched<false>, true, true>((PG8_LAS unsigned char*)lds, g, S, E);
}

__device__ __forceinline__ void phase_combine(PRef p, int layer) {
    const int tid = get_tid(), wave = tid >> 6, lane = tid & 63;
    float* xs = (float*)(p.ws + OFF_XS); bf16_t* hb = (bf16_t*)(p.ws + OFF_HB); const bf16_t* ybuf = (const bf16_t*)(p.ws + OFF_YBUF);
    const float* modv = (const float*)(p.ws + OFF_MOD);
    f32x4 wv[4]; load_row4(layer == 0 ? p.norm1_w + D_ : p.final_norm_w, lane, wv);
    for (int r = get_bid() * 8 + wave; r < R_; r += get_nblk() * 8) {
        const int b = r / TPB, pp = r - b * TPB;
        if (layer == 1 && pp < CTX_) continue;
        const int mi = pp < CTX_ ? 4 : b;
        u32x2 yw[4][4]; f32x4 gv[4], xv[4], scv[4], shv[4], v[4], hv[4];
#pragma unroll
        for (int j = 0; j < 4; ++j)
#pragma unroll
            for (int s = 0; s < 4; ++s) yw[j][s] = *(const u32x2*)(ybuf + ((size_t)r * 4 + s) * D_ + 4 * lane + 256 * j);
        load_row4(modv + (size_t)(layer * 5 + mi) * 6144 + 5120, lane, gv);
        load_row4(xs + (size_t)r * D_, lane, xv);
        if (layer == 0) { const float* mv = modv + (size_t)(5 + mi) * 6144; load_row4(mv + 1024, lane, scv); load_row4(mv, lane, shv); }
        SCHED_FENCE();
#pragma unroll
        for (int j = 0; j < 4; ++j) {
            f32x4 f = (f32x4){0.f, 0.f, 0.f, 0.f};
#pragma unroll
            for (int s = 0; s < 4; ++s) { f.x += bflo(yw[j][s].x); f.y += bfhi(yw[j][s].x); f.z += bflo(yw[j][s].y); f.w += bfhi(yw[j][s].y); }
            v[j] = xv[j] + gv[j] * f;
        }
        const float rstd = row_rstd(v);
        if (layer == 0) {
#pragma unroll
            for (int j = 0; j < 4; ++j) *(f32x4*)(xs + (size_t)r * D_ + 4 * lane + 256 * j) = v[j];
            norm_apply_store(v, rstd, wv, scv, shv, hb + (size_t)r * D_, lane, hv);
        } else {
            float* dst = p.out + ((size_t)b * SEQ_ + (pp - CTX_)) * D_;
#pragma unroll
            for (int j = 0; j < 4; ++j) { f32x4 o; o.x = v[j].x * rstd * wv[j].x; o.y = v[j].y * rstd * wv[j].y; o.z = v[j].z * rstd * wv[j].z; o.w = v[j].w * rstd * wv[j].w; *(f32x4*)(dst + 4 * lane + 256 * j) = o; }
        }
    }
}

#define LAS __attribute__((address_space(3)))
#define XB_TMO      128
#define XB_XCNT(j)  (256  + 64 * (j))
#define XB_XSUB(j)  (1280 + 64 * (j))
#define XB_XGEN(j)  (2304 + 64 * (j))
#define XB_TOP      3328
#define XB_TOPGEN   3392
#define XCD_BAR_WORDS 3456
#define XB_SPIN_CAP (1u << 18)

__device__ __forceinline__ unsigned xb_ld(unsigned* p)              { return __hip_atomic_load(p, __ATOMIC_RELAXED, __HIP_MEMORY_SCOPE_AGENT); }
__device__ __forceinline__ unsigned xb_add(unsigned* p, unsigned v) { return __hip_atomic_fetch_add(p, v, __ATOMIC_RELAXED, __HIP_MEMORY_SCOPE_AGENT); }
__device__ __forceinline__ unsigned xb_xcc_id() { return (unsigned)__builtin_amdgcn_s_getreg((3 << 11) | 20) & 0xFu; }
#define XB_SPIN(cond, bar) do { unsigned _sp = 0; while (cond) { __builtin_amdgcn_s_sleep(1); \
    if ((++_sp & 255u) == 0u) { if (xb_ld(&(bar)[XB_TMO])) break; if (_sp > XB_SPIN_CAP) { atomicAdd(&(bar)[XB_TMO], 1u); break; } } } } while (0)

struct XcdBarrier {
    unsigned* bar; unsigned x;
    volatile LAS unsigned* st;
};

__device__ __forceinline__ XcdBarrier xcd_barrier_post(unsigned* bar, volatile LAS unsigned* st) {
    XcdBarrier b; b.bar = bar; b.x = xb_xcc_id(); b.st = st;
    if (threadIdx.x == 0) (void)xb_add(&bar[XB_XCNT(b.x)], 1u);
    return b;
}
__device__ __forceinline__ void xcd_barrier_complete(unsigned* bar, unsigned x, unsigned& nloc, unsigned& nx) {
    const unsigned G = gridDim.x * gridDim.y * gridDim.z;
    unsigned sum, cnt, mine, sp = 0u;
    for (;;) {
        sum = 0u; cnt = 0u; mine = 0u;
#pragma unroll
        for (unsigned j = 0; j < 16; ++j) { const unsigned c = xb_ld(&bar[XB_XCNT(j)]); sum += c; cnt += (c > 0u) ? 1u : 0u; mine = (j == x) ? c : mine; }
        if (sum == G) break;
        __builtin_amdgcn_s_sleep(1);
        if ((++sp & 255u) == 0u) { if (xb_ld(&bar[XB_TMO])) break; if (sp > XB_SPIN_CAP) { atomicAdd(&bar[XB_TMO], 1u); break; } }
    }
    nloc = mine > 0u ? mine : 1u; nx = cnt > 0u ? cnt : 1u;
}

__device__ __forceinline__ void xcd_barrier(const XcdBarrier& b) {
    asm volatile("s_waitcnt vmcnt(0)" ::: "memory");
    __syncthreads();
    if (threadIdx.x == 0) {
        unsigned* bar = b.bar;
        __builtin_amdgcn_s_waitcnt(0);
        unsigned nloc = b.st[0], nx = b.st[1];
        if (nloc == 0u) { xcd_barrier_complete(bar, b.x, nloc, nx); b.st[0] = nloc; b.st[1] = nx; }
        const unsigned old = xb_add(&bar[XB_XSUB(b.x)], 1u);
        const unsigned gen = old / nloc;
        if (old + 1u == (gen + 1u) * nloc) {
            __builtin_amdgcn_fence(__ATOMIC_RELEASE, "agent");
            asm volatile("s_waitcnt vmcnt(0)" ::: "memory");
            const unsigned og = xb_add(&bar[XB_TOP], 1u);
            const unsigned tg = og / nx;
            if (og + 1u == (tg + 1u) * nx) xb_add(&bar[XB_TOPGEN], 1u);
            else XB_SPIN(xb_ld(&bar[XB_TOPGEN]) == tg, bar);
            __builtin_amdgcn_fence(__ATOMIC_ACQUIRE, "agent");
            xb_add(&bar[XB_XGEN(b.x)], 1u);
            asm volatile("s_waitcnt vmcnt(0)" ::: "memory");
        } else {
            XB_SPIN(xb_ld(&bar[XB_XGEN(b.x)]) == gen, bar);
            __builtin_amdgcn_fence(__ATOMIC_ACQUIRE, "agent");
            asm volatile("s_waitcnt vmcnt(0)" ::: "memory");
        }
    }
    __syncthreads();
}


constexpr int NPHASE = 24;
typedef const __attribute__((address_space(4))) Params* KArgs;
__device__ __forceinline__ KArgs kargs() { KArgs q = (KArgs)__builtin_amdgcn_kernarg_segment_ptr(); asm volatile("" : "+s"(q)); return q; }
__device__ __forceinline__ void grid_bar(unsigned char* lds) {
    XcdBarrier b; b.bar = (unsigned*)(kargs()->ws + OFF_BAR); b.x = xb_xcc_id(); b.st = (volatile LAS unsigned*)((LAS unsigned char*)lds + LDS_BYTES - 16);
    xcd_barrier(b);
}
__global__ void __launch_bounds__(NT) fwd_kernel(Params p_unused) {
    extern __shared__ __attribute__((aligned(16))) unsigned char lds[];
    {
        volatile LAS unsigned* bst = (volatile LAS unsigned*)((LAS unsigned char*)lds + LDS_BYTES - 16);
        if (threadIdx.x == 0) { bst[0] = 0u; bst[1] = 0u; }
        __syncthreads();
        (void)xcd_barrier_post((unsigned*)(kargs()->ws + OFF_BAR), bst);
    }
#define PH(ty, last, call) do { const int nrep_ = ((PROBE_MASK1 >> (ty)) & 1) ? 2 : 1; for (int rep_ = 0; rep_ < nrep_; ++rep_) { { PRef p = *kargs(); call; } if (!(last) || rep_ + 1 < nrep_) grid_bar(lds); } } while (0)
    { PRef p = *kargs(); phase_prep(p, lds); }
    cg::this_grid().sync();
    if ((PROBE_MASK1 >> 0) & 1) { { PRef p = *kargs(); phase_prep(p, lds); } grid_bar(lds); }
    PH(1, false, phase_norm_in(p));
#pragma nounroll
    for (int L = 0; L < 2; ++L) {
        PH(2, false, phase_inproj(p, L, lds));
        PH(3, false, phase_mixers(p, L, lds));
        PH(4, false, phase_hgrn_c2(p));
        PH(5, false, phase_hgrn_inter(p, L, lds));
        PH(7, false, phase_outproj(p, L, lds));
        PH(8, false, phase_router(p, L, lds));
        PH(10, false, phase_moe1(p, L, lds));
        PH(11, false, phase_moe2(p, L, lds));
        PH(12, L == 1, phase_combine(p, L));
    }
#undef PH
}

extern "C" void kernel_launch(void* const* d_in, const int* in_sizes, int n_in, void* d_out, int out_size, void* d_ws, size_t ws_size, hipStream_t stream) {
    static int grid = 0;
    if (grid == 0) {
        if (ws_size < WS_END) { fprintf(stderr, "kernel_launch: workspace too small (%zu < %zu)\n", ws_size, (size_t)WS_END); grid = -1; return; }
        int dev = 0, cus = 0, per_cu = 0;
        (void)hipGetDevice(&dev);
        (void)hipDeviceGetAttribute(&cus, hipDeviceAttributeMultiprocessorCount, dev);
        (void)hipFuncSetAttribute((const void*)fwd_kernel, hipFuncAttributeMaxDynamicSharedMemorySize, LDS_BYTES);
        (void)hipOccupancyMaxActiveBlocksPerMultiprocessor(&per_cu, (const void*)fwd_kernel, NT, LDS_BYTES);
        if (per_cu < 1) { fprintf(stderr, "kernel_launch: occupancy query reports %d blocks per CU\n", per_cu); }
        grid = cus;
        (void)hipGetLastError();
    }
    if (grid < 0) return;
    Params p{};
    const float** pin = (const float**)&p;
    for (int i = 0; i < 22; ++i) pin[i] = (const float*)d_in[i];
    p.out = (float*)d_out; p.ws = (unsigned char*)d_ws;
    (void)hipMemsetAsync((char*)d_ws + OFF_BAR, 0, XCD_BAR_WORDS * 4, stream);
    void* args[] = {&p};
    hipError_t e = hipLaunchCooperativeKernel((const void*)fwd_kernel, dim3(grid), dim3(NT), args, LDS_BYTES, stream);
    if (e != hipSuccess) fprintf(stderr, "cooperative launch failed: %s (grid %d)\n", hipGetErrorString(e), grid);
}
```

```cpp
#include <hip/hip_runtime.h>
#include <hip/hip_cooperative_groups.h>
#include <stdint.h>
#include <stdio.h>
namespace cg = cooperative_groups;

#ifndef MEGA
#define MEGA 1
#endif
#ifndef PROBE
#define PROBE 0
#endif
#define PROBE_MASK1 0x0
#define PROBE_MASK2 0x0

typedef unsigned short bf16_t;
typedef short bf16x8 __attribute__((ext_vector_type(8)));
typedef float f32x4 __attribute__((ext_vector_type(4)));
typedef unsigned u32x4 __attribute__((ext_vector_type(4)));
typedef unsigned u32x2 __attribute__((ext_vector_type(2)));

#define NT 512
constexpr int D_ = 1024, NB_ = 4, SEQ_ = 4096, CTX_ = 256, TPB = 4352, R_ = NB_ * TPB, INW = 3584, NE = 32, DFF = 1024;
constexpr float EPS_ = 1e-6f;
constexpr int PMAX = 77824;
constexpr int LDS_BYTES = 147456;
constexpr int ROWE_CAP = R_;

constexpr size_t OFF_CTL = 0;
constexpr size_t OFF_ROPE = 65536;
constexpr size_t OFF_MOD = 131072;
constexpr size_t OFF_WIN = 1u << 20;
constexpr size_t OFF_WOUT = OFF_WIN + (size_t)2 * INW * D_ * 2;
constexpr size_t OFF_W1 = OFF_WOUT + (size_t)2 * D_ * D_ * 2;
constexpr size_t OFF_W2 = OFF_W1 + (size_t)2 * NE * 2048 * D_ * 2;
constexpr size_t OFF_XS = OFF_W2 + (size_t)2 * NE * D_ * DFF * 2;
constexpr size_t OFF_HB = OFF_XS + (size_t)R_ * D_ * 4;
constexpr size_t OFF_PROJ = OFF_HB + (size_t)R_ * D_ * 2;
constexpr size_t OFF_MIX = OFF_PROJ + (size_t)R_ * INW * 2;
constexpr size_t OFF_OF = OFF_MIX + (size_t)R_ * D_ * 2;
constexpr size_t OFF_OB = OFF_OF + (size_t)R_ * 512 * 4;
constexpr size_t OFF_EID = OFF_OB + (size_t)R_ * 512 * 4;
constexpr size_t OFF_GATE = OFF_EID + (size_t)R_ * 16;
constexpr size_t OFF_POS = OFF_GATE + (size_t)R_ * 16;
constexpr size_t OFF_ROWL = OFF_POS + (size_t)R_ * 16;
constexpr size_t OFF_ACT = OFF_ROWL + (size_t)PMAX * 4;
constexpr size_t OFF_YBUF = OFF_ACT + (size_t)PMAX * DFF * 2;
constexpr size_t OFF_LT = OFF_YBUF + (size_t)R_ * 4 * D_ * 2;
constexpr size_t OFF_SB = OFF_LT + (size_t)2176 * 16384 * 2;
constexpr size_t OFF_DEC = OFF_SB + (size_t)2176 * 16384 * 2;
constexpr size_t OFF_QH = OFF_DEC + (size_t)2176 * 128 * 4;
constexpr size_t OFF_ROWE = OFF_QH + (size_t)2176 * 8192 * 2;
constexpr size_t WS_END = OFF_ROWE + (size_t)NE * ROWE_CAP * 4;
constexpr size_t OFF_LB = 4096;
constexpr int LDS_ROPE = 135168;
constexpr size_t OFF_BAR = 16384;
constexpr size_t OFF_TS = 32768;
constexpr size_t OFF_HS = OFF_PROJ;
static_assert((size_t)PMAX * D_ * 2 <= (size_t)R_ * INW * 2 + (size_t)R_ * D_ * 2, "hs overlay");

struct Params {
    const float *x, *c, *ctx, *c_ctx, *w_mod, *b_mod, *norm1_w, *norm2_w, *w_in, *w_out, *attn_sink, *q_norm_w, *k_norm_w, *hgrn_lb,
        *gate_norm_w, *router_w, *router_b, *w1, *b1, *w2, *b2, *final_norm_w;
    float* out;
    unsigned char* ws;
};

typedef const __attribute__((address_space(4))) Params& PRef;
typedef __bf16 bf2_t __attribute__((ext_vector_type(2)));
__device__ __forceinline__ unsigned pack2(float lo, float hi) { bf2_t v; v.x = (__bf16)lo; v.y = (__bf16)hi; return __builtin_bit_cast(unsigned, v); }
__device__ __forceinline__ unsigned f2bf(float f) { return pack2(f, 0.f) & 0xffffu; }
__device__ __forceinline__ float bflo(unsigned w) { return __uint_as_float(w << 16); }
__device__ __forceinline__ float bfhi(unsigned w) { return __uint_as_float(w & 0xffff0000u); }
__device__ __forceinline__ float xadd16(float v) { auto r = __builtin_amdgcn_permlane16_swap(__float_as_uint(v), __float_as_uint(v), false, false); return __uint_as_float(r[0]) + __uint_as_float(r[1]); }
__device__ __forceinline__ float xadd32(float v) { auto r = __builtin_amdgcn_permlane32_swap(__float_as_uint(v), __float_as_uint(v), false, false); return __uint_as_float(r[0]) + __uint_as_float(r[1]); }
__device__ __forceinline__ float xmax16(float v) { auto r = __builtin_amdgcn_permlane16_swap(__float_as_uint(v), __float_as_uint(v), false, false); return fmaxf(__uint_as_float(r[0]), __uint_as_float(r[1])); }
__device__ __forceinline__ float xmax32(float v) { auto r = __builtin_amdgcn_permlane32_swap(__float_as_uint(v), __float_as_uint(v), false, false); return fmaxf(__uint_as_float(r[0]), __uint_as_float(r[1])); }
__device__ __forceinline__ float wave_sum(float v) {
    v += __int_as_float(__builtin_amdgcn_update_dpp(0, __float_as_int(v), 0x111, 0xf, 0xf, true));
    v += __int_as_float(__builtin_amdgcn_update_dpp(0, __float_as_int(v), 0x112, 0xf, 0xf, true));
    v += __int_as_float(__builtin_amdgcn_update_dpp(0, __float_as_int(v), 0x114, 0xf, 0xf, true));
    v += __int_as_float(__builtin_amdgcn_update_dpp(0, __float_as_int(v), 0x118, 0xf, 0xf, true));
    v += __int_as_float(__builtin_amdgcn_update_dpp(0, __float_as_int(v), 0x142, 0xa, 0xf, false));
    v += __int_as_float(__builtin_amdgcn_update_dpp(0, __float_as_int(v), 0x143, 0xc, 0xf, false));
    return __int_as_float(__builtin_amdgcn_readlane(__float_as_int(v), 63));
}
__device__ __forceinline__ int get_tid() { int t = threadIdx.x; asm volatile("" : "+v"(t)); return t; }
__device__ __forceinline__ int get_bid() { int t = blockIdx.x; asm volatile("" : "+s"(t)); return t; }
__device__ __forceinline__ int get_nblk() { int t = gridDim.x; asm volatile("" : "+s"(t)); return t; }
__device__ __forceinline__ float sigmoidf_(float z) { return 1.f / (1.f + __expf(-z)); }

__device__ __forceinline__ int perm_row(int c, int perm) {
    const int lc = c & 255;
    if (perm == 1) { const int wcc = lc >> 6, dim = lc & 63; return (c & ~255) + 128 * (dim >> 5) + 32 * wcc + (dim & 31); }
    if (perm == 2) { const int wcc = lc >> 6, fq = (lc >> 4) & 3, bj = (lc >> 3) & 1, n = (lc >> 2) & 1, i = lc & 3; return (c & ~255) + 128 * bj + 32 * wcc + 16 * n + 4 * fq + i; }
    return c;
}
__device__ __forceinline__ void prep_transpose_item(const float* __restrict__ src, int K, int N, bf16_t* __restrict__ dst, int item, int perm, unsigned char* lds) {
    constexpr int LDO = 72;
    const int nb = N >> 8, kb = item / nb, nbk = item - kb * nb, k0 = kb * 64, n0 = nbk * 256, tid = get_tid(), kc = tid >> 6, lane = tid & 63;
    const float* s = src + (size_t)(k0 + kc * 8) * N + n0 + 4 * lane;
    f32x4 v[8];
#pragma unroll
    for (int j = 0; j < 8; ++j) v[j] = *(const f32x4*)(s + (size_t)j * N);
    bf16_t* img = (bf16_t*)lds;
#pragma unroll
    for (int ni = 0; ni < 4; ++ni) {
        u32x4 w;
        w.x = pack2(v[0][ni], v[1][ni]); w.y = pack2(v[2][ni], v[3][ni]); w.z = pack2(v[4][ni], v[5][ni]); w.w = pack2(v[6][ni], v[7][ni]);
        *(u32x4*)(img + (4 * lane + ni) * LDO + kc * 8) = w;
    }
    __syncthreads();
#pragma unroll
    for (int i = 0; i < 4; ++i) {
        const int n = (tid >> 3) + 64 * i, pc = tid & 7;
        const u32x4 w = *(const u32x4*)(img + n * LDO + pc * 8);
        *(u32x4*)(dst + (size_t)perm_row(n0 + n, perm) * K + k0 + pc * 8) = w;
    }
    __syncthreads();
}

constexpr int N_MOECONV = 32 * 128 + 32 * 64;
constexpr int CV_OUTTAIL = 240 * 8, CV_INTAIL = 72 * 8;
__device__ __forceinline__ void moe_conv_item(PRef p, int layer, int idx, unsigned char* lds) {
    if (idx < 4096) { const int m = layer * 32 + (idx >> 7), ii = idx & 127; prep_transpose_item(p.w1 + (size_t)m * D_ * 2048, D_, 2048, (bf16_t*)(p.ws + OFF_W1) + (size_t)m * 2048 * D_, ii, 2, lds); }
    else { const int j = idx - 4096, m = layer * 32 + (j >> 6), ii = j & 63; prep_transpose_item(p.w2 + (size_t)m * DFF * D_, DFF, D_, (bf16_t*)(p.ws + OFF_W2) + (size_t)m * D_ * DFF, ii, 2, lds); }
}

__device__ __forceinline__ void prep_mod_item(PRef p, int item, float* lds) {
    const int l = item / 96, col0 = (item - l * 96) * 64, tid = get_tid();
    float* s = lds;
    float* red = lds + 5 * 1024;
    for (int i = tid; i < 5 * 1024; i += NT) { const int row = i >> 10, k = i & 1023; const float cv = row < 4 ? p.c[row * 1024 + k] : p.c_ctx[k]; s[i] = cv / (1.f + __expf(-cv)); }
    __syncthreads();
    const int col = tid & 63, kq = tid >> 6;
    const float* w = p.w_mod + (size_t)l * 1024 * 6144 + col0 + col;
    float a0 = 0.f, a1 = 0.f, a2 = 0.f, a3 = 0.f, a4 = 0.f;
#pragma unroll 8
    for (int k = kq * 128; k < kq * 128 + 128; ++k) {
        const float wv = w[(size_t)k * 6144];
        a0 += s[k] * wv; a1 += s[1024 + k] * wv; a2 += s[2048 + k] * wv; a3 += s[3072 + k] * wv; a4 += s[4096 + k] * wv;
    }
    red[(kq * 5 + 0) * 64 + col] = a0; red[(kq * 5 + 1) * 64 + col] = a1; red[(kq * 5 + 2) * 64 + col] = a2; red[(kq * 5 + 3) * 64 + col] = a3; red[(kq * 5 + 4) * 64 + col] = a4;
    __syncthreads();
    if (tid < 320) {
        const int r = tid >> 6, c = tid & 63; float sum = 0.f;
#pragma unroll
        for (int q = 0; q < 8; ++q) sum += red[(q * 5 + r) * 64 + c];
        float* modv = (float*)(p.ws + OFF_MOD);
        modv[(size_t)(l * 5 + r) * 6144 + col0 + c] = sum + p.b_mod[l * 6144 + col0 + c];
    }
    __syncthreads();
}

__device__ __forceinline__ void phase_prep(PRef p, unsigned char* ldsraw) {
    float* lds = (float*)ldsraw;
    const int tid = get_tid();
    constexpr int N_MOD = 192, N_MISC = 1, N_WIN = 2 * 16 * 14, N_WOUT = 2 * 16 * 4;
    constexpr int NITEMS = N_MOD + N_MISC + N_WIN + N_WOUT;
    for (int it = get_bid(); it < NITEMS; it += get_nblk()) {
        int r = it;
        if (r < N_MOD) { prep_mod_item(p, r, lds); continue; } r -= N_MOD;
        if (r < N_MISC) {
            float* tab = (float*)(p.ws + OFF_ROPE);
            for (int i = tid; i < 1024; i += NT) { const int pos = i >> 4, fi = i & 15; const float inv = 1.0f / powf(10000.0f, (float)(2 * fi) / 32.0f); const float ang = (float)pos * inv; tab[2 * i] = cosf(ang); tab[2 * i + 1] = sinf(ang); }
            int* cnt = (int*)(p.ws + OFF_CTL);
            if (tid < 64) cnt[tid] = 0;
            float* lbt = (float*)(p.ws + OFF_LB);
            for (int i = tid; i < 1024; i += NT) lbt[i] = sigmoidf_(p.hgrn_lb[1024 + i] - p.hgrn_lb[i]);
            continue;
        } r -= N_MISC;
        if (r < N_WIN) { const int l = r / (16 * 14), ii = r - l * 16 * 14; prep_transpose_item(p.w_in + (size_t)l * D_ * INW, D_, INW, (bf16_t*)(p.ws + OFF_WIN) + (size_t)l * INW * D_, ii, 1, ldsraw); continue; } r -= N_WIN;
        { const int l = r / 64, ii = r - l * 64; prep_transpose_item(p.w_out + (size_t)l * D_ * D_, D_, D_, (bf16_t*)(p.ws + OFF_WOUT) + (size_t)l * D_ * D_, ii, 2, ldsraw); }
    }
}

__device__ __forceinline__ float row_rstd(const f32x4 (&v)[4]) {
    float ss = 0.f;
#pragma unroll
    for (int j = 0; j < 4; ++j) ss += (v[j].x * v[j].x + v[j].y * v[j].y) + (v[j].z * v[j].z + v[j].w * v[j].w);
    return rsqrtf(wave_sum(ss) * (1.0f / D_) + EPS_);
}
#define SCHED_FENCE() __builtin_amdgcn_sched_barrier(0)
__device__ __forceinline__ void load_row4(const float* src, int lane, f32x4 (&v)[4]) {
#pragma unroll
    for (int j = 0; j < 4; ++j) v[j] = *(const f32x4*)(src + 4 * lane + 256 * j);
}
__device__ __forceinline__ void norm_apply_store(const f32x4 (&v)[4], float rstd, const f32x4 (&wv)[4], const f32x4 (&scv)[4], const f32x4 (&shv)[4], bf16_t* dst, int lane, f32x4 (&hv)[4]) {
#pragma unroll
    for (int j = 0; j < 4; ++j) {
        f32x4 h;
        h.x = (v[j].x * rstd * wv[j].x) * (1.f + scv[j].x) + shv[j].x; h.y = (v[j].y * rstd * wv[j].y) * (1.f + scv[j].y) + shv[j].y;
        h.z = (v[j].z * rstd * wv[j].z) * (1.f + scv[j].z) + shv[j].z; h.w = (v[j].w * rstd * wv[j].w) * (1.f + scv[j].w) + shv[j].w;
        hv[j] = h;
        u32x2 o; o.x = pack2(h.x, h.y); o.y = pack2(h.z, h.w);
        *(u32x2*)(dst + 4 * lane + 256 * j) = o;
    }
}

__device__ __forceinline__ void phase_norm_in(PRef p) {
    const int tid = get_tid(), wave = tid >> 6, lane = tid & 63;
    float* xs = (float*)(p.ws + OFF_XS); bf16_t* hb = (bf16_t*)(p.ws + OFF_HB); const float* modv = (const float*)(p.ws + OFF_MOD);
    f32x4 wv[4]; load_row4(p.norm1_w, lane, wv);
    const int stride = get_nblk() * 8;
    int r = get_bid() * 8 + wave;
    f32x4 v[4], vn[4], scv[4], shv[4], hv[4];
#define NI_SRC(r_) (((r_) % TPB) < CTX_ ? p.ctx + ((size_t)((r_) / TPB) * CTX_ + ((r_) % TPB)) * D_ : p.x + ((size_t)((r_) / TPB) * SEQ_ + (((r_) % TPB) - CTX_)) * D_)
    if (r < R_) load_row4(NI_SRC(r), lane, v);
    for (; r < R_; r += stride) {
        const int b = r / TPB, pp = r - b * TPB;
        const float* mv = modv + (size_t)(pp < CTX_ ? 4 : b) * 6144;
        const int rn = (r + stride < R_) ? r + stride : r;
        load_row4(NI_SRC(rn), lane, vn); load_row4(mv + 1024, lane, scv); load_row4(mv, lane, shv);
        SCHED_FENCE();
#pragma unroll
        for (int j = 0; j < 4; ++j) *(f32x4*)(xs + (size_t)r * D_ + 4 * lane + 256 * j) = v[j];
        const float rstd = row_rstd(v);
        norm_apply_store(v, rstd, wv, scv, shv, hb + (size_t)r * D_, lane, hv);
#pragma unroll
        for (int j = 0; j < 4; ++j) v[j] = vn[j];
    }
#undef NI_SRC
}

namespace pg8 {
#define PG8_LAS __attribute__((address_space(3)))
constexpr int BM = 256, BK = 64, HALF = 128, HTB = HALF * BK * 2, STAGE_BYTES = 8 * HTB, NXCD = 8, WGM = 8;
__host__ __device__ __forceinline__ int lds_byte(int r, int c) { const int st = (r >> 4) * 2 + (c >> 5), rr = r & 15, cc = c & 31, ob = rr * 64 + cc * 2; return st * 1024 + (ob ^ (((ob >> 9) & 1) << 5)); }
__host__ __device__ __forceinline__ void stage_rc(int b, int& R, int& C) { const int st = b / 1024, sb = b % 1024, swz = sb ^ (((sb >> 9) & 1) << 5); R = (st >> 1) * 16 + swz / 64; C = (st & 1) * 32 + (swz % 64) / 2; }
__host__ __device__ __forceinline__ int perm32(int rho) { const int n = rho >> 4, i = rho & 15; return 8 * (i >> 2) + 4 * n + (i & 3); }
struct Unit { int pm, pn, aux; };
struct Gemm { const bf16_t* A; const bf16_t* Bt; int K; };
struct TileOrder {
    int nM, nN, nwg, G, c;
    __device__ __forceinline__ void init(int nM_, int nN_, int G_, int c_) { nM = nM_; nN = nN_; nwg = nM * nN; G = G_; c = c_; }
    __device__ __forceinline__ bool map(int i, int& pm, int& pn) const {
        const long L = (long)i * G + c; if (L >= nwg) return false;
        int wgid = (int)L; { const int q = nwg / NXCD, r = nwg % NXCD, xcd = wgid % NXCD, off = wgid / NXCD; wgid = (xcd < r ? xcd * (q + 1) : r * (q + 1) + (xcd - r) * q) + off; }
        const int nig = WGM * nN, gid = wgid / nig, fm = gid * WGM, gsz = (nM - fm) < WGM ? (nM - fm) : WGM;
        pm = fm + ((wgid % nig) % gsz); pn = (wgid % nig) / gsz; return true;
    }
};
struct DenseSched : TileOrder {
    static constexpr bool GATHER = false;
    __device__ __forceinline__ bool next(int i, Unit& u) const { u.aux = 0; return map(i, u.pm, u.pn); }
    __device__ __forceinline__ void a_ready(const Unit&) const {}
    __device__ __forceinline__ void done(const Unit&) const {}
};
template <bool GATHER_>
struct MoeSched : TileOrder {
    static constexpr bool GATHER = GATHER_;
    const int* tab; const int* rowe; int K2;
    __device__ __forceinline__ bool next(int i, Unit& u) const {
        int pm, ln; if (!map(i, pm, ln)) return false;
        const int e = tab[96 + pm];
        u.pm = pm; u.pn = e * nN + ln; u.aux = (e << 8) | ln; return true;
    }
    __device__ __forceinline__ void gather(const Unit& u, int tid, unsigned (&go)[2][2]) const {
        const int e = u.aux >> 8, pos0 = u.pm * 256 - tab[e], c = tab[40 + e];
        int idx[2][2], C[2];
#pragma unroll
        for (int i = 0; i < 2; ++i) {
            int R; stage_rc(tid * 16 + i * 8192, R, C[i]);
#pragma unroll
            for (int h = 0; h < 2; ++h) { const int pos = pos0 + h * 128 + R; idx[h][i] = pos < c ? rowe[(size_t)e * ROWE_CAP + pos] : -1; }
        }
#pragma unroll
        for (int h = 0; h < 2; ++h)
#pragma unroll
            for (int i = 0; i < 2; ++i) go[h][i] = (unsigned)((idx[h][i] < 0 ? 0 : (idx[h][i] >> 2)) * K2 + C[i] * 2);
    }
    __device__ __forceinline__ void a_ready(const Unit&) const {}
    __device__ __forceinline__ void done(const Unit&) const {}
};
template <class Epi, class Sched, bool ALIGN_EPI = false, bool SP2 = false>
__device__ __forceinline__ void gemm_phase(PG8_LAS unsigned char* lds, const Gemm g, const Sched& S, const Epi& E) {
    const int tid = get_tid(), wid = __builtin_amdgcn_readfirstlane(tid >> 6), lane = tid & 63, wr = wid >> 2, wc = wid & 3, fr = lane & 15, fq = lane >> 4;
    const int K = g.K, nt = K / BK;
    unsigned voffA[2], voffB[2];
#pragma unroll
    for (int i = 0; i < 2; ++i) { int R, C; stage_rc(tid * 16 + i * 8192, R, C); const int Rb = Epi::PERM ? ((R & ~31) + perm32(R & 31)) : R;
        voffA[i] = (unsigned)(R * K + C) * 2u; voffB[i] = (unsigned)(Rb * K + C) * 2u; }
    const size_t kstep = (size_t)(BK * 2);
    const size_t hstep = (size_t)HALF * K * 2;
    const size_t tstep = 2 * hstep;
    const unsigned ldsw = (unsigned)wid * 1024u;
    const int aoff = lds_byte(wr * 64 + fr, fq * 8), boff = lds_byte(wc * 32 + fr, fq * 8);
#define PG8_SA(b, h) (((b) * 2 + (h)) * HTB)
#define PG8_SB(b, h) ((4 + (b) * 2 + (h)) * HTB)
#define PG8_STAGE(bufoff, gbase, voff) do { _Pragma("unroll") for (int _i = 0; _i < 2; ++_i) \
        __builtin_amdgcn_global_load_lds((const unsigned*)((const char*)(gbase) + (voff)[_i]), (PG8_LAS unsigned*)(lds + (bufoff) + ldsw + _i * 8192), 16, 0, 0); } while (0)
#define PG8_STAGE_A(bufoff, kbytes, h, usenext) do { if constexpr (Sched::GATHER) { _Pragma("unroll") for (int _i = 0; _i < 2; ++_i) { const unsigned o_ = (usenext) ? ngo[h][_i] : cgo[h][_i]; \
        __builtin_amdgcn_global_load_lds((const unsigned*)((const char*)g.A + (kbytes) + o_), (PG8_LAS unsigned*)(lds + (bufoff) + ldsw + _i * 8192), 16, 0, 0); } } \
    else { PG8_STAGE(bufoff, ((usenext) ? nA : cA) + (kbytes) + (h) * hstep, voffA); } } while (0)
#define PG8_LDA(dst, b, h) do { _Pragma("unroll") for (int m = 0; m < 4; ++m) _Pragma("unroll") for (int k = 0; k < 2; ++k) dst[m][k] = *(const PG8_LAS bf16x8*)(lds + PG8_SA(b, h) + aoff + m * 2048 + k * 1024); } while (0)
#define PG8_LDB(dst, b, h) do { _Pragma("unroll") for (int n = 0; n < 2; ++n) _Pragma("unroll") for (int k = 0; k < 2; ++k) dst[n][k] = *(const PG8_LAS bf16x8*)(lds + PG8_SB(b, h) + boff + n * 2048 + k * 1024); } while (0)
#define PG8_MMA(ai, bj, At, Bt) do { __builtin_amdgcn_s_setprio(1); _Pragma("unroll") for (int m = 0; m < 4; ++m) _Pragma("unroll") for (int n = 0; n < 2; ++n) _Pragma("unroll") for (int k = 0; k < 2; ++k) \
        acc[ai][bj][m][n] = __builtin_amdgcn_mfma_f32_16x16x32_bf16(Bt[n][k], At[m][k], acc[ai][bj][m][n], 0, 0, 0); __builtin_amdgcn_s_setprio(0); } while (0)
#define PG8_WAIT_V(n) asm volatile("s_waitcnt vmcnt(" #n ")" ::: "memory")
#define PG8_WAIT_L(n) asm volatile("s_waitcnt lgkmcnt(" #n ")" ::: "memory")
#define PG8_BAR __builtin_amdgcn_s_barrier()
#define PG8_SCHED __builtin_amdgcn_sched_barrier(0)
    Unit cur, nxt; int ui = 0;
    if (!S.next(0, cur)) return;
    unsigned cgo[2][2] = {{0u, 0u}, {0u, 0u}}, ngo[2][2] = {{0u, 0u}, {0u, 0u}};
    if constexpr (Sched::GATHER) S.gather(cur, tid, cgo);
    f32x4 acc[2][2][4][2];
#pragma unroll
    for (int a = 0; a < 2; ++a)
#pragma unroll
        for (int b = 0; b < 2; ++b)
#pragma unroll
            for (int m = 0; m < 4; ++m)
#pragma unroll
                for (int n = 0; n < 2; ++n) acc[a][b][m][n] = (f32x4){0.f, 0.f, 0.f, 0.f};
    bf16x8 At[4][2], B0[2][2], B1[2][2];
    const char* cA = (const char*)g.A + (size_t)cur.pm * tstep; const char* cB = (const char*)g.Bt + (size_t)cur.pn * tstep;
    const char* nA = cA;
    S.a_ready(cur);
    if constexpr (SP2) {
        PG8_STAGE(PG8_SB(0, 0), cB, voffB); PG8_STAGE(PG8_SB(0, 1), cB + hstep, voffB); PG8_STAGE_A(PG8_SA(0, 0), 0, 0, false); PG8_STAGE_A(PG8_SA(0, 1), 0, 1, false);
        if (wr == 1) PG8_BAR;
        PG8_WAIT_V(2); PG8_BAR;
        PG8_STAGE(PG8_SB(1, 0), cB + kstep, voffB); PG8_STAGE_A(PG8_SA(1, 0), kstep, 0, false); PG8_STAGE(PG8_SB(1, 1), cB + hstep + kstep, voffB);
        PG8_WAIT_V(6); PG8_BAR;
    } else {
        PG8_STAGE(PG8_SB(0, 0), cB, voffB); PG8_STAGE_A(PG8_SA(0, 0), 0, 0, false); PG8_STAGE(PG8_SB(0, 1), cB + hstep, voffB); PG8_STAGE_A(PG8_SA(0, 1), 0, 1, false);
        if (wr == 1) PG8_BAR;
        PG8_WAIT_V(4); PG8_BAR;
        PG8_STAGE(PG8_SB(1, 0), cB + kstep, voffB); PG8_STAGE_A(PG8_SA(1, 0), kstep, 0, false); PG8_STAGE(PG8_SB(1, 1), cB + hstep + kstep, voffB);
        PG8_WAIT_V(6); PG8_BAR;
    }
    for (;;) {
        const bool has_next = S.next(ui + 1, nxt);
        nA = has_next ? (const char*)g.A + (size_t)nxt.pm * tstep : cA; const char* nB = has_next ? (const char*)g.Bt + (size_t)nxt.pn * tstep : cB;
        if constexpr (Sched::GATHER) { if (has_next) S.gather(nxt, tid, ngo); else { ngo[0][0] = cgo[0][0]; ngo[0][1] = cgo[0][1]; ngo[1][0] = cgo[1][0]; ngo[1][1] = cgo[1][1]; } }
        for (int t = 0; t < nt; t += 2) {
            const bool last = (t == nt - 2);
            const size_t k1 = (size_t)(t + 1) * kstep, k2 = last ? 0 : (size_t)(t + 2) * kstep, k3 = k2 + kstep;
            const char* b2 = last ? nB : cB + (size_t)(t + 2) * kstep; const char* b3 = b2 + kstep;
            if (last && has_next) S.a_ready(nxt);
            if constexpr (SP2) {
            PG8_LDB(B0, 0, 0); PG8_LDB(B1, 0, 1); PG8_SCHED; PG8_LDA(At, 0, 0); PG8_STAGE_A(PG8_SA(1, 1), k1, 1, false);
            PG8_WAIT_V(8); PG8_WAIT_L(0); PG8_BAR; PG8_MMA(0, 0, At, B0); PG8_MMA(0, 1, At, B1); PG8_BAR; PG8_SCHED;
            PG8_LDA(At, 0, 1); PG8_STAGE(PG8_SB(0, 0), b2, voffB); PG8_STAGE(PG8_SB(0, 1), b2 + hstep, voffB); PG8_STAGE_A(PG8_SA(0, 0), k2, 0, last);
            PG8_WAIT_V(8); PG8_WAIT_L(0); PG8_BAR; PG8_MMA(1, 0, At, B0); PG8_MMA(1, 1, At, B1); PG8_BAR; PG8_SCHED;
            PG8_LDB(B0, 1, 0); PG8_LDB(B1, 1, 1); PG8_SCHED; PG8_LDA(At, 1, 0); PG8_STAGE_A(PG8_SA(0, 1), k2, 1, last);
            PG8_WAIT_V(8); PG8_WAIT_L(0); PG8_BAR; PG8_MMA(0, 0, At, B0); PG8_MMA(0, 1, At, B1); PG8_BAR; PG8_SCHED;
            PG8_LDA(At, 1, 1); PG8_STAGE(PG8_SB(1, 0), b3, voffB); PG8_STAGE(PG8_SB(1, 1), b3 + hstep, voffB); PG8_STAGE_A(PG8_SA(1, 0), k3, 0, last);
            PG8_WAIT_V(8); PG8_WAIT_L(0); PG8_BAR; PG8_MMA(1, 0, At, B0); PG8_MMA(1, 1, At, B1); PG8_BAR; PG8_SCHED;
            } else {
            PG8_LDB(B0, 0, 0); PG8_SCHED; PG8_LDA(At, 0, 0); PG8_STAGE_A(PG8_SA(1, 1), k1, 1, false);
            PG8_WAIT_L(8); PG8_BAR; PG8_WAIT_L(0); PG8_MMA(0, 0, At, B0); PG8_BAR; PG8_SCHED;
            PG8_LDB(B1, 0, 1); PG8_STAGE(PG8_SB(0, 0), b2, voffB);
            PG8_BAR; PG8_WAIT_L(0); PG8_MMA(0, 1, At, B1); PG8_BAR;
            PG8_LDA(At, 0, 1); PG8_STAGE_A(PG8_SA(0, 0), k2, 0, last);
            PG8_BAR; PG8_WAIT_L(0); PG8_MMA(1, 0, At, B0); PG8_BAR; PG8_SCHED;
            PG8_STAGE(PG8_SB(0, 1), b2 + hstep, voffB);
            PG8_WAIT_V(6); PG8_BAR; PG8_MMA(1, 1, At, B1); PG8_BAR;
            PG8_LDB(B0, 1, 0); PG8_SCHED; PG8_LDA(At, 1, 0); PG8_STAGE_A(PG8_SA(0, 1), k2, 1, last);
            PG8_WAIT_L(8); PG8_BAR; PG8_WAIT_L(0); PG8_MMA(0, 0, At, B0); PG8_BAR; PG8_SCHED;
            PG8_LDB(B1, 1, 1); PG8_STAGE(PG8_SB(1, 0), b3, voffB);
            PG8_BAR; PG8_WAIT_L(0); PG8_MMA(0, 1, At, B1); PG8_BAR;
            PG8_LDA(At, 1, 1); PG8_STAGE_A(PG8_SA(1, 0), k3, 0, last);
            PG8_BAR; PG8_WAIT_L(0); PG8_MMA(1, 0, At, B0); PG8_BAR; PG8_SCHED;
            PG8_STAGE(PG8_SB(1, 1), b3 + hstep, voffB);
            PG8_WAIT_V(6); PG8_BAR; PG8_MMA(1, 1, At, B1); PG8_BAR;
            }
        }
        if constexpr (ALIGN_EPI) { if (wr == 0) PG8_BAR; }
        if constexpr (!Epi::AFTER_DRAIN) { E(acc, cur, wr, wc, fr, fq); S.done(cur); }
        if (!has_next) break;
#pragma unroll
        for (int a = 0; a < 2; ++a)
#pragma unroll
            for (int b = 0; b < 2; ++b)
#pragma unroll
                for (int m = 0; m < 4; ++m)
#pragma unroll
                    for (int n = 0; n < 2; ++n) acc[a][b][m][n] = (f32x4){0.f, 0.f, 0.f, 0.f};
        cur = nxt; cA = nA; cB = nB; ++ui;
        if constexpr (Sched::GATHER) { cgo[0][0] = ngo[0][0]; cgo[0][1] = ngo[0][1]; cgo[1][0] = ngo[1][0]; cgo[1][1] = ngo[1][1]; }
        if constexpr (ALIGN_EPI) { if (wr == 1) PG8_BAR; }
    }
    PG8_WAIT_V(0);
    if constexpr (!ALIGN_EPI) { if (wr == 0) PG8_BAR; }
    PG8_BAR;
    if constexpr (Epi::AFTER_DRAIN) { E.fused(acc, cur, wr, wc, fr, fq, lds, wid, lane); S.done(cur); }
#undef PG8_SA
#undef PG8_SB
#undef PG8_STAGE
#undef PG8_STAGE_A
#undef PG8_LDA
#undef PG8_LDB
#undef PG8_MMA
#undef PG8_WAIT_V
#undef PG8_WAIT_L
#undef PG8_BAR
#undef PG8_SCHED
}
}

struct EpiInProj {
    static constexpr bool PERM = false, AFTER_DRAIN = false;
    bf16_t* proj; const float* rope; const float* qn; const float* kn;
    __device__ __forceinline__ void operator()(const f32x4 (&acc)[2][2][4][2], const pg8::Unit& u, int wr, int wc, int fr, int fq) const {
        const int tile = u.pn;
        const bool attn_half = (tile == 0) || (tile == 2) || ((tile == 1 || tile == 3) && wc < 2);
        const bool is_rope = attn_half, is_norm = attn_half && tile >= 2, is_q = (tile == 0) || (tile == 2), is_silu = (tile == 4) || (tile == 5);
        const float* nw = (tile == 3) ? kn : qn;
        f32x4 nwv[2][2];
#pragma unroll
        for (int bj = 0; bj < 2; ++bj)
#pragma unroll
            for (int n = 0; n < 2; ++n) nwv[bj][n] = *(const f32x4*)(nw + 32 * bj + 16 * n + 4 * fq);
        SCHED_FENCE();
#pragma unroll
        for (int ai = 0; ai < 2; ++ai)
#pragma unroll
            for (int m = 0; m < 4; ++m) {
                const int r = u.pm * 256 + ai * 128 + wr * 64 + m * 16 + fr;
                const int b = r / TPB, pp = r - b * TPB;
                const bool latent = pp >= CTX_;
                const int nn = pp - CTX_, prow = nn >> 6, pcol = nn & 63;
                f32x4 v[2][2];
#pragma unroll
                for (int bj = 0; bj < 2; ++bj)
#pragma unroll
                    for (int n = 0; n < 2; ++n) v[bj][n] = acc[ai][bj][m][n];
                if (is_norm) {
                    float ss = 0.f;
#pragma unroll
                    for (int bj = 0; bj < 2; ++bj)
#pragma unroll
                        for (int n = 0; n < 2; ++n) ss += (v[bj][n].x * v[bj][n].x + v[bj][n].y * v[bj][n].y) + (v[bj][n].z * v[bj][n].z + v[bj][n].w * v[bj][n].w);
                    ss = xadd32(xadd16(ss));
                    const float rs = rsqrtf(ss * (1.0f / 64.0f) + EPS_);
#pragma unroll
                    for (int bj = 0; bj < 2; ++bj)
#pragma unroll
                        for (int n = 0; n < 2; ++n) { const f32x4 wv = nwv[bj][n]; v[bj][n].x *= rs * wv.x; v[bj][n].y *= rs * wv.y; v[bj][n].z *= rs * wv.z; v[bj][n].w *= rs * wv.w; }
                }
                if (is_rope && latent) {
#pragma unroll
                    for (int bj = 0; bj < 2; ++bj) {
                        const int pos = bj == 0 ? prow : pcol;
                        const f32x4 c0 = *(const f32x4*)(rope + (pos * 16 + 4 * fq) * 2), c1 = *(const f32x4*)(rope + (pos * 16 + 4 * fq) * 2 + 4);
                        const f32x4 a = v[bj][0], bq = v[bj][1]; f32x4 o0, o1;
                        o0.x = a.x * c0.x - bq.x * c0.y; o1.x = bq.x * c0.x + a.x * c0.y;
                        o0.y = a.y * c0.z - bq.y * c0.w; o1.y = bq.y * c0.z + a.y * c0.w;
                        o0.z = a.z * c1.x - bq.z * c1.y; o1.z = bq.z * c1.x + a.z * c1.y;
                        o0.w = a.w * c1.z - bq.w * c1.w; o1.w = bq.w * c1.z + a.w * c1.w;
                        v[bj][0] = o0; v[bj][1] = o1;
                    }
                }
                if (is_q) {
#pragma unroll
                    for (int bj = 0; bj < 2; ++bj)
#pragma unroll
                        for (int n = 0; n < 2; ++n) v[bj][n] = v[bj][n] * (0.125f * 1.4426950408889634f);
                }
                if (is_silu) {
#pragma unroll
                    for (int bj = 0; bj < 2; ++bj)
#pragma unroll
                        for (int n = 0; n < 2; ++n) { v[bj][n].x = v[bj][n].x * sigmoidf_(v[bj][n].x); v[bj][n].y = v[bj][n].y * sigmoidf_(v[bj][n].y); v[bj][n].z = v[bj][n].z * sigmoidf_(v[bj][n].z); v[bj][n].w = v[bj][n].w * sigmoidf_(v[bj][n].w); }
                }
                bf16_t* dst = proj + (size_t)r * INW + tile * 256 + wc * 64 + 4 * fq;
#pragma unroll
                for (int bj = 0; bj < 2; ++bj)
#pragma unroll
                    for (int n = 0; n < 2; ++n) { u32x2 o; o.x = pack2(v[bj][n].x, v[bj][n].y); o.y = pack2(v[bj][n].z, v[bj][n].w); *(u32x2*)(dst + 32 * bj + 16 * n) = o; }
            }
    }
};
__device__ __forceinline__ void phase_inproj(PRef p, int layer, unsigned char* lds) {
    pg8::Gemm g{(const bf16_t*)(p.ws + OFF_HB), (const bf16_t*)(p.ws + OFF_WIN) + (size_t)layer * INW * D_, D_};
    pg8::DenseSched S; S.init(R_ / 256, INW / 256, get_nblk(), get_bid());
    {
        const int tid = get_tid();
        *(u32x4*)(lds + LDS_ROPE + tid * 16) = *(const u32x4*)(p.ws + OFF_ROPE + tid * 16);
        __syncthreads();
    }
    EpiInProj E{(bf16_t*)(p.ws + OFF_PROJ), (const float*)(lds + LDS_ROPE), p.q_norm_w + layer * 64, p.k_norm_w + layer * 64};
    pg8::gemm_phase<EpiInProj, pg8::DenseSched, true, true>((PG8_LAS unsigned char*)lds, g, S, E);
    if (get_nblk() == 256 && get_bid() >= 184) {
        const int base = (layer == 1 ? CV_OUTTAIL : 0) + (get_bid() - 184);
        for (int k = 0; k < 8; ++k) moe_conv_item(p, layer, base + k * 72, lds);
    }
}

__device__ __forceinline__ void cvt8(const u32x4 w, float* d) {
    d[0] = bflo(w.x); d[1] = bfhi(w.x); d[2] = bflo(w.y); d[3] = bfhi(w.y); d[4] = bflo(w.z); d[5] = bfhi(w.z); d[6] = bflo(w.w); d[7] = bfhi(w.w);
}

__device__ __forceinline__ int chain_pos(int dir, int cc, int j) { return dir == 0 ? cc * 64 + j : (cc < 4 ? (3 - cc) * 64 + 63 - j : TPB - 1 - ((cc - 4) * 64 + j)); }

constexpr int HB_LD = 132, HQ_LD = 136, HV_LD = 72;
constexpr int H_OFF_B = 0, H_OFF_Q = 64 * HB_LD * 4, H_OFF_KK = H_OFF_Q + 64 * HQ_LD * 2, H_OFF_VT = H_OFF_KK + 64 * HQ_LD * 2, H_OFF_KHT = H_OFF_VT + 128 * HV_LD * 2,
              H_OFF_TOT = H_OFF_KHT + 128 * HV_LD * 2, H_LDS = H_OFF_TOT + 4 * 128 * 4;
static_assert(H_LDS <= LDS_BYTES, "hgrn lds");
__device__ __forceinline__ void cvt8f(const f32x4 a, const f32x4 b, float* d) { d[0] = a.x; d[1] = a.y; d[2] = a.z; d[3] = a.w; d[4] = b.x; d[5] = b.y; d[6] = b.z; d[7] = b.w; }
__device__ __forceinline__ bf16x8 pack8(const float* v) { u32x4 w; w.x = pack2(v[0], v[1]); w.y = pack2(v[2], v[3]); w.z = pack2(v[4], v[5]); w.w = pack2(v[6], v[7]); return __builtin_bit_cast(bf16x8, w); }

struct HgLoads { u32x4 z0, z1, q0, q1, v0, v1; f32x4 lb4[4]; };
__device__ __forceinline__ void hgrn_issue_loads(PRef p, int layer, int item, HgLoads& L) {
    const int cc = item % 68, chain = item / 68, dir = chain & 1, h = (chain >> 1) & 3, b = chain >> 3;
    const int tid = get_tid(), lane = tid & 63, wave = tid >> 6;
    const bf16_t* proj = (const bf16_t*)(p.ws + OFF_PROJ);
    const float* lbt = (const float*)(p.ws + OFF_LB) + dir * 512 + h * 128;
    const int j = tid >> 3, kb = (tid & 7) * 16;
    const bf16_t* row = proj + (size_t)(b * TPB + chain_pos(dir, cc, j)) * INW;
    const bf16_t* vrow = proj + (size_t)(b * TPB + chain_pos(dir, cc, lane)) * INW + 2560 + h * 128 + wave * 16;
    L.z0 = *(const u32x4*)(row + (dir == 0 ? 1536 : 2048) + h * 128 + kb); L.z1 = *(const u32x4*)(row + (dir == 0 ? 1536 : 2048) + h * 128 + kb + 8);
    L.q0 = *(const u32x4*)(row + 1024 + h * 128 + kb); L.q1 = *(const u32x4*)(row + 1024 + h * 128 + kb + 8);
    L.v0 = *(const u32x4*)vrow; L.v1 = *(const u32x4*)(vrow + 8);
#pragma unroll
    for (int e = 0; e < 4; ++e) L.lb4[e] = layer == 1 ? *(const f32x4*)(lbt + kb + 4 * e) : (f32x4){0.f, 0.f, 0.f, 0.f};
}
__device__ __forceinline__ void hgrn_load_scan(const HgLoads& L, unsigned char* lds) {
    const int tid = get_tid(), lane = tid & 63, wave = tid >> 6;
    float* Bc = (float*)(lds + H_OFF_B); bf16_t* Qs = (bf16_t*)(lds + H_OFF_Q); bf16_t* KKs = (bf16_t*)(lds + H_OFF_KK); bf16_t* VT = (bf16_t*)(lds + H_OFF_VT); float* Tot = (float*)(lds + H_OFF_TOT);
    {
        const int j = tid >> 3, kb = (tid & 7) * 16;
        const u32x4 z0 = L.z0, z1 = L.z1, q0 = L.q0, q1 = L.q1, v0 = L.v0, v1 = L.v1;
        float z[16], g[16], kk[16]; cvt8(z0, z); cvt8(z1, z + 8);
#pragma unroll
        for (int e = 0; e < 16; ++e) {
            const float lb = L.lb4[e >> 2][e & 3];
            const float sg = sigmoidf_(z[e]); const float f = lb + (1.f - lb) * sg;
            g[e] = __logf(fmaxf(f, 1e-30f)); kk[e] = (1.f - lb) * (1.f - sg);
        }
#pragma unroll
        for (int e = 0; e < 16; e += 4) *(f32x4*)(Bc + j * HB_LD + kb + e) = (f32x4){g[e], g[e + 1], g[e + 2], g[e + 3]};
        *(bf16x8*)(KKs + j * HQ_LD + kb) = pack8(kk); *(bf16x8*)(KKs + j * HQ_LD + kb + 8) = pack8(kk + 8);
        *(u32x4*)(Qs + j * HQ_LD + kb) = q0; *(u32x4*)(Qs + j * HQ_LD + kb + 8) = q1;
        bf16_t* d = VT + (wave * 16) * HV_LD + lane;
        d[0 * HV_LD] = (bf16_t)(v0.x & 0xffffu); d[1 * HV_LD] = (bf16_t)(v0.x >> 16); d[2 * HV_LD] = (bf16_t)(v0.y & 0xffffu); d[3 * HV_LD] = (bf16_t)(v0.y >> 16);
        d[4 * HV_LD] = (bf16_t)(v0.z & 0xffffu); d[5 * HV_LD] = (bf16_t)(v0.z >> 16); d[6 * HV_LD] = (bf16_t)(v0.w & 0xffffu); d[7 * HV_LD] = (bf16_t)(v0.w >> 16);
        d[8 * HV_LD] = (bf16_t)(v1.x & 0xffffu); d[9 * HV_LD] = (bf16_t)(v1.x >> 16); d[10 * HV_LD] = (bf16_t)(v1.y & 0xffffu); d[11 * HV_LD] = (bf16_t)(v1.y >> 16);
        d[12 * HV_LD] = (bf16_t)(v1.z & 0xffffu); d[13 * HV_LD] = (bf16_t)(v1.z >> 16); d[14 * HV_LD] = (bf16_t)(v1.w & 0xffffu); d[15 * HV_LD] = (bf16_t)(v1.w >> 16);
    }
    __syncthreads();
    const int k = tid & 127, seg = tid >> 7;
    float sc[16];
#pragma unroll
    for (int jj = 0; jj < 16; ++jj) sc[jj] = Bc[(seg * 16 + jj) * HB_LD + k];
    SCHED_FENCE();
#pragma unroll
    for (int jj = 1; jj < 16; ++jj) sc[jj] += sc[jj - 1];
    Tot[seg * 128 + k] = sc[15];
    __syncthreads();
    {
        const float t0 = Tot[k], t1 = Tot[128 + k], t2 = Tot[256 + k];
        const float off = seg == 0 ? 0.f : (seg == 1 ? t0 : (seg == 2 ? t0 + t1 : t0 + t1 + t2));
#pragma unroll
        for (int jj = 0; jj < 16; ++jj) Bc[(seg * 16 + jj) * HB_LD + k] = sc[jj] + off;
    }
    __syncthreads();
}

constexpr int H_OFF_PM = H_LDS, HP_LD = 72, H_LDS2 = H_OFF_PM + 64 * HP_LD * 2;
static_assert(H_LDS2 <= LDS_BYTES - 16, "hgrn lds");
__device__ __forceinline__ void hgrn_local_item(PRef p, int layer, int item, unsigned char* lds, const HgLoads& L) {
    const int cc = item % 68, chain = item / 68, dir = chain & 1, h = (chain >> 1) & 3, b = chain >> 3;
    hgrn_load_scan(L, lds);
    const int tid = get_tid(), lane = tid & 63, wave = tid >> 6, fr = lane & 15, fq = lane >> 4;
    const float* Bc = (const float*)(lds + H_OFF_B); const bf16_t* Qs = (const bf16_t*)(lds + H_OFF_Q); const bf16_t* KKs = (const bf16_t*)(lds + H_OFF_KK); const bf16_t* VT = (const bf16_t*)(lds + H_OFF_VT);
    bf16_t* KHT = (bf16_t*)(lds + H_OFF_KHT); bf16_t* Pm = (bf16_t*)(lds + H_OFF_PM);
    {
        const int j = lane, kc = wave * 16;
        float bj[16], be[16], kk[16];
        cvt8f(*(const f32x4*)(Bc + j * HB_LD + kc), *(const f32x4*)(Bc + j * HB_LD + kc + 4), bj); cvt8f(*(const f32x4*)(Bc + j * HB_LD + kc + 8), *(const f32x4*)(Bc + j * HB_LD + kc + 12), bj + 8);
        cvt8f(*(const f32x4*)(Bc + 63 * HB_LD + kc), *(const f32x4*)(Bc + 63 * HB_LD + kc + 4), be); cvt8f(*(const f32x4*)(Bc + 63 * HB_LD + kc + 8), *(const f32x4*)(Bc + 63 * HB_LD + kc + 12), be + 8);
        cvt8(*(const u32x4*)(KKs + j * HQ_LD + kc), kk); cvt8(*(const u32x4*)(KKs + j * HQ_LD + kc + 8), kk + 8);
#pragma unroll
        for (int e = 0; e < 16; ++e) KHT[(kc + e) * HV_LD + j] = (bf16_t)f2bf(kk[e] * __expf(be[e] - bj[e]));
    }
    if (tid < 128) ((float*)(p.ws + OFF_DEC))[(size_t)item * 128 + tid] = __expf(Bc[63 * HB_LD + tid]);
    {
        const int j = tid >> 3, kb = (tid & 7) * 16;
        float bt[16], q8[16], x[16];
        cvt8f(*(const f32x4*)(Bc + j * HB_LD + kb), *(const f32x4*)(Bc + j * HB_LD + kb + 4), bt); cvt8f(*(const f32x4*)(Bc + j * HB_LD + kb + 8), *(const f32x4*)(Bc + j * HB_LD + kb + 12), bt + 8);
        cvt8(*(const u32x4*)(Qs + j * HQ_LD + kb), q8); cvt8(*(const u32x4*)(Qs + j * HQ_LD + kb + 8), q8 + 8);
#pragma unroll
        for (int e = 0; e < 16; ++e) x[e] = q8[e] * __expf(bt[e]);
        bf16_t* qh = (bf16_t*)(p.ws + OFF_QH) + ((size_t)item * 64 + j) * 128 + kb;
        *(bf16x8*)qh = pack8(x); *(bf16x8*)(qh + 8) = pack8(x + 8);
        for (int i = tid; i < 64 * HP_LD * 2 / 16; i += NT) *(u32x4*)((unsigned char*)Pm + i * 16) = (u32x4){0u, 0u, 0u, 0u};
    }
    __syncthreads();
    {
        bf16x8 bfr[2];
#pragma unroll
        for (int ks = 0; ks < 2; ++ks) bfr[ks] = *(const bf16x8*)(VT + (16 * wave + fr) * HV_LD + ks * 32 + fq * 8);
        bf16_t* lt = (bf16_t*)(p.ws + OFF_LT) + ((size_t)item * 128 + 16 * wave + fr) * 128 + 4 * fq;
        bf16x8 afr[8][2];
#pragma unroll
        for (int a = 0; a < 8; ++a)
#pragma unroll
            for (int ks = 0; ks < 2; ++ks) afr[a][ks] = *(const bf16x8*)(KHT + (16 * a + fr) * HV_LD + ks * 32 + fq * 8);
        SCHED_FENCE();
#pragma unroll
        for (int a = 0; a < 8; ++a) {
            f32x4 acc = __builtin_amdgcn_mfma_f32_16x16x32_bf16(afr[a][0], bfr[0], (f32x4){0.f, 0.f, 0.f, 0.f}, 0, 0, 0);
            acc = __builtin_amdgcn_mfma_f32_16x16x32_bf16(afr[a][1], bfr[1], acc, 0, 0, 0);
            u32x2 o; o.x = pack2(acc.x, acc.y); o.y = pack2(acc.z, acc.w);
            *(u32x2*)(lt + 16 * a) = o;
        }
    }
    for (int pi = wave; pi < 10; pi += 8) {
        const int I = pi >= 6 ? 3 : (pi >= 3 ? 2 : (pi >= 1 ? 1 : 0)), J = pi - (I * (I + 1)) / 2;
        const int rrow = (J < I) ? 16 * J + 15 : 16 * I + 7;
        const int s = 16 * J + fr, t = 16 * I + fr;
        f32x4 pacc = (f32x4){0.f, 0.f, 0.f, 0.f};
#pragma unroll
        for (int k2 = 0; k2 < 4; k2 += 2) {
            f32x4 rr[2][2], sb[2][2], tb[2][2]; u32x4 kw[2], qw[2];
#pragma unroll
            for (int d = 0; d < 2; ++d) {
                const int ko = (k2 + d) * 32 + 8 * fq;
                rr[d][0] = *(const f32x4*)(Bc + rrow * HB_LD + ko); rr[d][1] = *(const f32x4*)(Bc + rrow * HB_LD + ko + 4);
                sb[d][0] = *(const f32x4*)(Bc + s * HB_LD + ko); sb[d][1] = *(const f32x4*)(Bc + s * HB_LD + ko + 4);
                tb[d][0] = *(const f32x4*)(Bc + t * HB_LD + ko); tb[d][1] = *(const f32x4*)(Bc + t * HB_LD + ko + 4);
                kw[d] = *(const u32x4*)(KKs + s * HQ_LD + ko); qw[d] = *(const u32x4*)(Qs + t * HQ_LD + ko);
            }
            SCHED_FENCE();
#pragma unroll
            for (int d = 0; d < 2; ++d) {
                float r8[8], bs[8], bt[8], kk[8], q8[8], xk[8], xq[8];
                cvt8f(rr[d][0], rr[d][1], r8); cvt8f(sb[d][0], sb[d][1], bs); cvt8f(tb[d][0], tb[d][1], bt); cvt8(kw[d], kk); cvt8(qw[d], q8);
#pragma unroll
                for (int e = 0; e < 8; ++e) { xk[e] = kk[e] * __expf(fminf(r8[e] - bs[e], 80.f)); xq[e] = q8[e] * __expf(fminf(bt[e] - r8[e], 80.f)); }
                pacc = __builtin_amdgcn_mfma_f32_16x16x32_bf16(pack8(xk), pack8(xq), pacc, 0, 0, 0);
            }
        }
        if (J == I) {
            if (4 * fq + 0 > fr) pacc.x = 0.f;
            if (4 * fq + 1 > fr) pacc.y = 0.f;
            if (4 * fq + 2 > fr) pacc.z = 0.f;
            if (4 * fq + 3 > fr) pacc.w = 0.f;
        }
        u32x2 o; o.x = pack2(pacc.x, pacc.y); o.y = pack2(pacc.z, pacc.w);
        *(u32x2*)(Pm + t * HP_LD + 16 * J + 4 * fq) = o;
    }
    __syncthreads();
    {
        float* obuf = (float*)(p.ws + (dir == 0 ? OFF_OF : OFF_OB));
        bf16x8 vf[2], pfr[4][2];
#pragma unroll
        for (int ks = 0; ks < 2; ++ks) vf[ks] = *(const bf16x8*)(VT + (16 * wave + fr) * HV_LD + ks * 32 + fq * 8);
#pragma unroll
        for (int I = 0; I < 4; ++I)
#pragma unroll
            for (int ks = 0; ks < 2; ++ks) pfr[I][ks] = *(const bf16x8*)(Pm + (16 * I + fr) * HP_LD + ks * 32 + fq * 8);
        SCHED_FENCE();
#pragma unroll
        for (int I = 0; I < 4; ++I) {
            f32x4 acc = __builtin_amdgcn_mfma_f32_16x16x32_bf16(vf[0], pfr[I][0], (f32x4){0.f, 0.f, 0.f, 0.f}, 0, 0, 0);
            if (I >= 2) acc = __builtin_amdgcn_mfma_f32_16x16x32_bf16(vf[1], pfr[I][1], acc, 0, 0, 0);
            *(f32x4*)(obuf + (size_t)(b * TPB + chain_pos(dir, cc, 16 * I + fr)) * 512 + h * 128 + 16 * wave + 4 * fq) = acc;
        }
    }
    __syncthreads();
}

__device__ __forceinline__ void phase_hgrn_c2(PRef p) {
    const int tid = get_tid();
    const bf16_t* LT = (const bf16_t*)(p.ws + OFF_LT); bf16_t* SB = (bf16_t*)(p.ws + OFF_SB); const float* DEC = (const float*)(p.ws + OFF_DEC);
    for (int e = get_bid() * NT + tid; e < 32 * 128 * 32; e += get_nblk() * NT) {
        const int chain = e >> 12, rem = e & 4095, v = rem >> 5, k4 = (rem & 31) * 4;
        float s0 = 0.f, s1 = 0.f, s2 = 0.f, s3 = 0.f;
        const size_t base = (size_t)chain * 68 * 16384 + v * 128 + k4;
        const float* dbase = DEC + (size_t)chain * 68 * 128 + k4;
#define C2_GROUP(C0_, N_) do { u32x2 l[N_]; f32x4 d[N_]; \
            _Pragma("unroll") for (int q = 0; q < (N_); ++q) { l[q] = *(const u32x2*)(LT + base + (size_t)((C0_) + q) * 16384); d[q] = *(const f32x4*)(dbase + (size_t)((C0_) + q) * 128); } \
            SCHED_FENCE(); \
            _Pragma("unroll") for (int q = 0; q < (N_); ++q) { u32x2 o; o.x = pack2(s0, s1); o.y = pack2(s2, s3); *(u32x2*)(SB + base + (size_t)((C0_) + q) * 16384) = o; \
                s0 = d[q].x * s0 + bflo(l[q].x); s1 = d[q].y * s1 + bfhi(l[q].x); s2 = d[q].z * s2 + bflo(l[q].y); s3 = d[q].w * s3 + bfhi(l[q].y); } } while (0)
#pragma unroll 1
        for (int c0 = 0; c0 < 64; c0 += 8) C2_GROUP(c0, 8);
        C2_GROUP(64, 4);
#undef C2_GROUP
    }
}

__device__ __forceinline__ void phase_hgrn_inter(PRef p, int layer, unsigned char* lds) {
    const int tid = get_tid(), lane = tid & 63, wave = tid >> 6, fr = lane & 15, fq = lane >> 4;
    const float* of = (const float*)(p.ws + OFF_OF); const float* ob = (const float*)(p.ws + OFF_OB);
    const bf16_t* proj = (const bf16_t*)(p.ws + OFF_PROJ); bf16_t* mix = (bf16_t*)(p.ws + OFF_MIX);
    for (int wi = get_bid() * 8 + wave; wi < 1088 * 4; wi += get_nblk() * 8) {
        const int tt = wi & 3, item = wi >> 2, tc = item % 68, bh = item / 68, h = bh & 3, b = bh >> 2;
        if (layer == 1 && tc < 4) continue;
        const int tau = tt * 16 + fr; const size_t r = (size_t)b * TPB + tc * 64 + tau;
        f32x4 acc[8];
        u32x2 gwd[8];
#pragma unroll
        for (int vt = 0; vt < 8; ++vt) gwd[vt] = *(const u32x2*)(proj + r * INW + 3072 + h * 128 + 16 * vt + 4 * fq);
        {
            f32x4 a0[8], a1[8];
#pragma unroll
            for (int vt = 0; vt < 8; ++vt) { a0[vt] = *(const f32x4*)(of + r * 512 + h * 128 + 16 * vt + 4 * fq); a1[vt] = *(const f32x4*)(ob + r * 512 + h * 128 + 16 * vt + 4 * fq); }
            __builtin_amdgcn_sched_barrier(0);
#pragma unroll
            for (int vt = 0; vt < 8; ++vt) acc[vt] = a0[vt] + a1[vt];
        }
#pragma unroll
        for (int dir = 0; dir < 2; ++dir) {
            const int chain = (b * 4 + h) * 2 + dir, cc = dir == 0 ? tc : (tc < 4 ? 3 - tc : 71 - tc);
            const size_t it = (size_t)chain * 68 + cc;
            const bf16_t* sb = (const bf16_t*)(p.ws + OFF_SB) + it * 16384 + fr * 128 + 8 * fq;
            const bf16_t* qh = (const bf16_t*)(p.ws + OFF_QH) + it * 8192 + (dir == 0 ? tau : 63 - tau) * 128 + 8 * fq;
#pragma unroll
            for (int kh = 0; kh < 2; ++kh) {
                bf16x8 bf[2], af[2][8];
#pragma unroll
                for (int k2 = 0; k2 < 2; ++k2) {
                    bf[k2] = *(const bf16x8*)(qh + (2 * kh + k2) * 32);
#pragma unroll
                    for (int vt = 0; vt < 8; ++vt) af[k2][vt] = *(const bf16x8*)(sb + vt * 16 * 128 + (2 * kh + k2) * 32);
                }
                __builtin_amdgcn_sched_barrier(0);
#pragma unroll
                for (int k2 = 0; k2 < 2; ++k2)
#pragma unroll
                    for (int vt = 0; vt < 8; ++vt) acc[vt] = __builtin_amdgcn_mfma_f32_16x16x32_bf16(af[k2][vt], bf[k2], acc[vt], 0, 0, 0);
                __builtin_amdgcn_sched_barrier(0);
            }
        }
        float ss = 0.f;
#pragma unroll
        for (int vt = 0; vt < 8; ++vt) ss += (acc[vt].x * acc[vt].x + acc[vt].y * acc[vt].y) + (acc[vt].z * acc[vt].z + acc[vt].w * acc[vt].w);
        ss = xadd32(xadd16(ss));
        const float rs = rsqrtf(ss * (1.0f / 128.0f) + EPS_);
        f32x4 gwv[8];
#pragma unroll
        for (int vt = 0; vt < 8; ++vt) gwv[vt] = *(const f32x4*)(p.gate_norm_w + layer * 128 + 16 * vt + 4 * fq);
        SCHED_FENCE();
#pragma unroll
        for (int vt = 0; vt < 8; ++vt) {
            const int vcol = h * 128 + 16 * vt + 4 * fq;
            const f32x4 gw = gwv[vt];
            const float g0 = bflo(gwd[vt].x), g1 = bfhi(gwd[vt].x), g2 = bflo(gwd[vt].y), g3 = bfhi(gwd[vt].y);
            u32x2 o;
            o.x = pack2(acc[vt].x * rs * gw.x * (g0 * sigmoidf_(g0)), acc[vt].y * rs * gw.y * (g1 * sigmoidf_(g1)));
            o.y = pack2(acc[vt].z * rs * gw.z * (g2 * sigmoidf_(g2)), acc[vt].w * rs * gw.w * (g3 * sigmoidf_(g3)));
            *(u32x2*)(mix + r * D_ + 512 + vcol) = o;
        }
    }
}

constexpr int AT_LDK = 80, AT_LDV = 136;
constexpr int AT_KBYTES = 128 * AT_LDK * 2, AT_VBYTES = 64 * AT_LDV * 2, AT_STAGE = AT_KBYTES + AT_VBYTES;
static_assert(2 * AT_STAGE <= LDS_BYTES - 16, "attention lds");
constexpr float LOG2E_ = 1.4426950408889634f;
struct AtRegs { u32x4 k0, k1, v0, v1; };
__device__ __forceinline__ float max3f(float a, float b, float c) { float r; asm("v_max3_f32 %0, %1, %2, %3" : "=v"(r) : "v"(a), "v"(b), "v"(c)); return r; }
__device__ __forceinline__ void at_tile(const unsigned char* Ks, const unsigned char* VT, const bf16x8 (&qf)[2][2], f32x4 (&oacc)[2][4], float (&m)[2], float (&l)[2],
                                        int fr, int fq, bool masked, int nq0, int nk0, bool first) {
    f32x4 sacc[2][2][4];
    {
        bf16x8 kf[2][4][2];
        const unsigned char* kp = Ks + (fr * AT_LDK + fq * 8) * 2;
#pragma unroll
        for (int h = 0; h < 2; ++h)
#pragma unroll
            for (int n = 0; n < 4; ++n)
#pragma unroll
                for (int ks = 0; ks < 2; ++ks) kf[h][n][ks] = *(const bf16x8*)(kp + ((h * 64 + n * 16) * AT_LDK + ks * 32) * 2);
        SCHED_FENCE();
#pragma unroll
        for (int h = 0; h < 2; ++h)
#pragma unroll
            for (int qt = 0; qt < 2; ++qt)
#pragma unroll
                for (int n = 0; n < 4; ++n) {
                    sacc[h][qt][n] = __builtin_amdgcn_mfma_f32_16x16x32_bf16(kf[h][n][0], qf[qt][0], (f32x4){-m[qt], -m[qt], -m[qt], -m[qt]}, 0, 0, 0);
                    sacc[h][qt][n] = __builtin_amdgcn_mfma_f32_16x16x32_bf16(kf[h][n][1], qf[qt][1], sacc[h][qt][n], 0, 0, 0);
                }
    }
    if (masked) {
#pragma unroll
        for (int h = 0; h < 2; ++h)
#pragma unroll
            for (int qt = 0; qt < 2; ++qt) {
                const int nq = nq0 + qt * 16;
#pragma unroll
                for (int n = 0; n < 4; ++n)
#pragma unroll
                    for (int i = 0; i < 4; ++i) { const int df = nq - (nk0 + h * 64 + n * 16 + i); if (df > 128 || df < -128) sacc[h][qt][n][i] = -1e30f; }
            }
    }
    float mx[2];
#pragma unroll
    for (int qt = 0; qt < 2; ++qt) {
        float t = max3f(sacc[0][qt][0].x, sacc[0][qt][0].y, sacc[0][qt][0].z);
#pragma unroll
        for (int h = 0; h < 2; ++h)
#pragma unroll
            for (int n = 0; n < 4; ++n) { if (h | n) t = max3f(t, sacc[h][qt][n].x, sacc[h][qt][n].y); t = max3f(t, sacc[h][qt][n].z, sacc[h][qt][n].w); }
        mx[qt] = t;
    }
    mx[0] = xmax32(xmax16(mx[0])); mx[1] = xmax32(xmax16(mx[1]));
    if (first || __any(fmaxf(mx[0], mx[1]) > 8.f)) {
#pragma unroll
        for (int qt = 0; qt < 2; ++qt) {
            const float dl = first ? fmaxf(mx[qt], -1e30f) : fmaxf(mx[qt], 0.f);
            const float corr = __builtin_amdgcn_exp2f(-dl);
            m[qt] += dl; l[qt] *= corr;
#pragma unroll
            for (int dt = 0; dt < 4; ++dt) oacc[qt][dt] = oacc[qt][dt] * corr;
#pragma unroll
            for (int h = 0; h < 2; ++h)
#pragma unroll
                for (int n = 0; n < 4; ++n) sacc[h][qt][n] = sacc[h][qt][n] - dl;
        }
    }
#pragma unroll
    for (int h = 0; h < 2; ++h) {
        u32x2 vlo[4][2], vhi[4][2];
        const unsigned char* vp = VT + (fr * AT_LDV + h * 64 + 4 * fq) * 2;
#pragma unroll
        for (int dt = 0; dt < 4; ++dt)
#pragma unroll
            for (int s = 0; s < 2; ++s) {
                vlo[dt][s] = *(const u32x2*)(vp + (dt * 16 * AT_LDV + s * 32) * 2);
                vhi[dt][s] = *(const u32x2*)(vp + (dt * 16 * AT_LDV + s * 32 + 16) * 2);
            }
        bf16x8 pf[2][2];
#pragma unroll
        for (int qt = 0; qt < 2; ++qt) {
            float ls = l[qt];
            float pe[4][4];
#pragma unroll
            for (int n = 0; n < 4; ++n) { pe[n][0] = __builtin_amdgcn_exp2f(sacc[h][qt][n].x); pe[n][1] = __builtin_amdgcn_exp2f(sacc[h][qt][n].y); pe[n][2] = __builtin_amdgcn_exp2f(sacc[h][qt][n].z); pe[n][3] = __builtin_amdgcn_exp2f(sacc[h][qt][n].w);
                                          ls += (pe[n][0] + pe[n][1]) + (pe[n][2] + pe[n][3]); }
            l[qt] = ls;
#pragma unroll
            for (int s = 0; s < 2; ++s) {
                u32x4 w; w.x = pack2(pe[2 * s][0], pe[2 * s][1]); w.y = pack2(pe[2 * s][2], pe[2 * s][3]); w.z = pack2(pe[2 * s + 1][0], pe[2 * s + 1][1]); w.w = pack2(pe[2 * s + 1][2], pe[2 * s + 1][3]);
                pf[qt][s] = __builtin_bit_cast(bf16x8, w);
            }
        }
#pragma unroll
        for (int dt = 0; dt < 4; ++dt)
#pragma unroll
            for (int s = 0; s < 2; ++s) {
                u32x4 w; w.x = vlo[dt][s].x; w.y = vlo[dt][s].y; w.z = vhi[dt][s].x; w.w = vhi[dt][s].y;
                const bf16x8 vf = __builtin_bit_cast(bf16x8, w);
#pragma unroll
                for (int qt = 0; qt < 2; ++qt) oacc[qt][dt] = __builtin_amdgcn_mfma_f32_16x16x32_bf16(vf, pf[qt][s], oacc[qt][dt], 0, 0, 0);
            }
    }
}
__device__ __forceinline__ void attn_mfma_item(PRef p, int layer, int item, unsigned char* lds) {
    const int tid = get_tid(), lane = tid & 63, wave = tid >> 6, fr = lane & 15, fq = lane >> 4;
    const int mixer = item / 272; int rem = item - mixer * 272; const int b = rem / 68; rem -= b * 68; const int kvh = rem / 34, qb = rem - kvh * 34;
    const int p0 = qb * 128; const bool ctxblk = p0 < CTX_;
    const int head = kvh * 2 + (wave >> 2);
    const int qrow0 = p0 + (wave & 3) * 32;
    const bf16_t* proj = (const bf16_t*)(p.ws + OFF_PROJ);
    bf16_t* mix = (bf16_t*)(p.ws + OFF_MIX);
    const int qcol = (mixer == 0 ? 0 : 512) + head * 64, kcol = (mixer == 0 ? 256 : 768) + kvh * 64, vcol = (mixer == 0 ? 384 : 896) + kvh * 64;
    bf16x8 qf[2][2];
#pragma unroll
    for (int qt = 0; qt < 2; ++qt)
#pragma unroll
        for (int ks = 0; ks < 2; ++ks) qf[qt][ks] = *(const bf16x8*)(proj + (size_t)(b * TPB + qrow0 + qt * 16 + fr) * INW + qcol + ks * 32 + fq * 8);
    f32x4 oacc[2][4];
#pragma unroll
    for (int qt = 0; qt < 2; ++qt)
#pragma unroll
        for (int dt = 0; dt < 4; ++dt) oacc[qt][dt] = (f32x4){0.f, 0.f, 0.f, 0.f};
    float m[2], l[2];
    if (mixer == 0) { const float sk = p.attn_sink[layer * 4 + head] * LOG2E_; m[0] = sk; m[1] = sk; l[0] = fq == 0 ? 1.f : 0.f; l[1] = l[0]; }
    else { m[0] = 0.f; m[1] = 0.f; l[0] = 0.f; l[1] = 0.f; }
    int tlo, thi;
    if (ctxblk) { tlo = 2; thi = 1; } else if (mixer == 1) { tlo = 2; thi = 33; } else { tlo = qb - 1 < 2 ? 2 : qb - 1; thi = qb + 1 > 33 ? 33 : qb + 1; }
    const int ntile = 2 + (thi - tlo + 1);
    const int srow = tid >> 3, sc8 = tid & 7;
    const bf16_t* kbase = proj + (size_t)(b * TPB + srow) * INW + kcol + sc8 * 8;
    const bf16_t* vbase = proj + (size_t)(b * TPB + lane) * INW + vcol + wave * 8;
    const int nq0 = qrow0 + fr - CTX_;
    const bool mixA = (mixer == 0);
#define AT_TID(ti_) ((ti_) < 2 ? (ti_) : tlo + (ti_) - 2)
#define AT_CL(ti_) ((ti_) < ntile ? (ti_) : ntile - 1)
#define AT_LOAD(R_, ti_) do { const size_t ro_ = (size_t)AT_TID(AT_CL(ti_)) * 128 * INW; R_.k0 = *(const u32x4*)(kbase + ro_); R_.k1 = *(const u32x4*)(kbase + ro_ + (size_t)64 * INW); \
                              R_.v0 = *(const u32x4*)(vbase + ro_); R_.v1 = *(const u32x4*)(vbase + ro_ + (size_t)64 * INW); } while (0)
#define AT_ST8(VT_, key_, w_) do { VT_[(wave * 8 + 0) * AT_LDV + (key_)] = (bf16_t)((w_).x & 0xffffu); VT_[(wave * 8 + 1) * AT_LDV + (key_)] = (bf16_t)((w_).x >> 16); \
        VT_[(wave * 8 + 2) * AT_LDV + (key_)] = (bf16_t)((w_).y & 0xffffu); VT_[(wave * 8 + 3) * AT_LDV + (key_)] = (bf16_t)((w_).y >> 16); \
        VT_[(wave * 8 + 4) * AT_LDV + (key_)] = (bf16_t)((w_).z & 0xffffu); VT_[(wave * 8 + 5) * AT_LDV + (key_)] = (bf16_t)((w_).z >> 16); \
        VT_[(wave * 8 + 6) * AT_LDV + (key_)] = (bf16_t)((w_).w & 0xffffu); VT_[(wave * 8 + 7) * AT_LDV + (key_)] = (bf16_t)((w_).w >> 16); } while (0)
#define AT_STORE(buf_, R_) do { unsigned char* Ks_ = lds + (buf_) * AT_STAGE; bf16_t* VT_ = (bf16_t*)(Ks_ + AT_KBYTES); \
        *(u32x4*)(Ks_ + (srow * AT_LDK + sc8 * 8) * 2) = R_.k0; *(u32x4*)(Ks_ + ((srow + 64) * AT_LDK + sc8 * 8) * 2) = R_.k1; \
        AT_ST8(VT_, lane, R_.v0); AT_ST8(VT_, lane + 64, R_.v1); } while (0)
    AtRegs RA;
    asm volatile("" :: "v"(qf[0][0]), "v"(qf[0][1]), "v"(qf[1][0]), "v"(qf[1][1]));
    AT_LOAD(RA, 0); AT_STORE(0, RA);
    AT_LOAD(RA, 1);
    __syncthreads();
#pragma unroll 1
    for (int ti = 0; ti < ntile; ++ti) {
        const int t_ = AT_TID(ti); const bool mk_ = mixA && (t_ >= 2); const int nk_ = t_ * 128 + 4 * fq - CTX_;
        const int buf = ti & 1;
        AT_STORE(buf ^ 1, RA);
        AT_LOAD(RA, ti + 2); SCHED_FENCE();
        const unsigned char* Ks = lds + buf * AT_STAGE;
        at_tile(Ks, Ks + AT_KBYTES, qf, oacc, m, l, fr, fq, mk_, nq0, nk_, ti == 0);
        __syncthreads();
    }
#undef AT_TID
#undef AT_CL
#undef AT_LOAD
#undef AT_ST8
#undef AT_STORE
#pragma unroll
    for (int qt = 0; qt < 2; ++qt) {
        const float lt = xadd32(xadd16(l[qt]));
        const float inv = 1.f / lt;
        bf16_t* dst = mix + (size_t)(b * TPB + qrow0 + qt * 16 + fr) * D_ + (mixer == 0 ? 0 : 256) + head * 64 + 4 * fq;
#pragma unroll
        for (int dt = 0; dt < 4; ++dt) { u32x2 o; o.x = pack2(oacc[qt][dt].x * inv, oacc[qt][dt].y * inv); o.y = pack2(oacc[qt][dt].z * inv, oacc[qt][dt].w * inv); *(u32x2*)(dst + dt * 16) = o; }
    }
}

__device__ __forceinline__ void phase_mixers(PRef p, int layer, unsigned char* lds) {
    constexpr int N_A = 544, N_C1 = 2176;
    const int nblk = get_nblk();
    int it = get_bid();
    int cidx = (nblk == 256 ? (layer == 1 ? CV_OUTTAIL + CV_INTAIL : CV_INTAIL) : 0) + get_bid();
    if (get_bid() & 1) { for (; cidx < N_MOECONV; cidx += nblk) moe_conv_item(p, layer, cidx, lds); }
    for (; it < N_A; it += nblk) {
        int a;
        if (it < 256) { const int g = it >> 5, qb = 2 + (it & 31); a = 272 + g * 34 + qb; }
        else if (it < 512) { const int j = it - 256, g = j >> 5, qb = 2 + (j & 31); a = g * 34 + qb; }
        else if (it < 528) { const int j = it - 512; a = 272 + (j >> 1) * 34 + (j & 1); }
        else { const int j = it - 528; a = (j >> 1) * 34 + (j & 1); }
        for (int rep = 0; rep < (((PROBE_MASK1 >> (it < 256 ? 13 : 15)) & 1) ? 2 : 1); ++rep) { attn_mfma_item(p, layer, a, lds); __syncthreads(); }
    }
    if (it < N_A + N_C1) {
        HgLoads cur; hgrn_issue_loads(p, layer, it - N_A, cur);
        for (; it < N_A + N_C1; it += nblk) {
            HgLoads nxt; const bool hn = it + nblk < N_A + N_C1;
            hgrn_issue_loads(p, layer, (hn ? it + nblk : it) - N_A, nxt);
            SCHED_FENCE();
            for (int rep = 0; rep < (((PROBE_MASK1 >> 14) & 1) ? 2 : 1); ++rep) hgrn_local_item(p, layer, it - N_A, lds, cur);
            cur = nxt;
            __syncthreads();
        }
    }
    for (; cidx < N_MOECONV; cidx += nblk) moe_conv_item(p, layer, cidx, lds);
}

struct EpiOutProj {
    static constexpr bool PERM = false, AFTER_DRAIN = false;
    float* xs; const float* modl;
    __device__ __forceinline__ void operator()(const f32x4 (&acc)[2][2][4][2], const pg8::Unit& u, int wr, int wc, int fr, int fq) const {
        const int col0 = u.pn * 256 + wc * 64 + 16 * fq;
        const int r00 = u.pm * 256, b0 = r00 / TPB, pp0 = r00 - b0 * TPB;
        const float* g1 = modl + (size_t)(pp0 < CTX_ ? 4 : b0) * 6144 + 2048 + col0;
        f32x4 gv[4];
#pragma unroll
        for (int q = 0; q < 4; ++q) gv[q] = *(const f32x4*)(g1 + 4 * q);
#pragma unroll
        for (int ai = 0; ai < 2; ++ai)
#pragma unroll
            for (int m = 0; m < 4; m += 2) {
                float* xp0 = xs + (size_t)(u.pm * 256 + ai * 128 + wr * 64 + m * 16 + fr) * D_ + col0;
                float* xp1 = xp0 + (size_t)16 * D_;
                f32x4 x0[4], x1[4];
#pragma unroll
                for (int q = 0; q < 4; ++q) { x0[q] = *(const f32x4*)(xp0 + 4 * q); x1[q] = *(const f32x4*)(xp1 + 4 * q); }
                SCHED_FENCE();
#pragma unroll
                for (int bj = 0; bj < 2; ++bj)
#pragma unroll
                    for (int n = 0; n < 2; ++n) {
                        const int q = 2 * bj + n;
                        *(f32x4*)(xp0 + 4 * q) = x0[q] + gv[q] * acc[ai][bj][m][n];
                        *(f32x4*)(xp1 + 4 * q) = x1[q] + gv[q] * acc[ai][bj][m + 1][n];
                    }
                SCHED_FENCE();
            }
    }
};
struct OutProjSched : pg8::TileOrder {
    static constexpr bool GATHER = false;
    bool skipctx;
    __device__ __forceinline__ bool next(int i, pg8::Unit& u) const { int pm, pn; if (!map(i, pm, pn)) return false; u.pm = skipctx ? pm + (pm >> 4) + 1 : pm; u.pn = pn; u.aux = 0; return true; }
    __device__ __forceinline__ void a_ready(const pg8::Unit&) const {}
    __device__ __forceinline__ void done(const pg8::Unit&) const {}
};
__device__ __forceinline__ void phase_outproj(PRef p, int layer, unsigned char* lds) {
    pg8::Gemm g{(const bf16_t*)(p.ws + OFF_MIX), (const bf16_t*)(p.ws + OFF_WOUT) + (size_t)layer * D_ * D_, D_};
    OutProjSched S; S.skipctx = (layer == 1); S.init(layer == 1 ? 64 : R_ / 256, D_ / 256, get_nblk(), get_bid());
    EpiOutProj E{(float*)(p.ws + OFF_XS), (const float*)(p.ws + OFF_MOD) + (size_t)layer * 5 * 6144};
    pg8::gemm_phase<EpiOutProj, OutProjSched, true, true>((PG8_LAS unsigned char*)lds, g, S, E);
    if (layer == 0 && get_nblk() == 256 && get_bid() >= 16) {
        for (int k = 0; k < 8; ++k) moe_conv_item(p, 1, (get_bid() - 16) + k * 240, lds);
    }
}

constexpr int RW_LD = 1028;
__device__ __forceinline__ float router_reduce(float (&part)[32], int lane) {
#pragma unroll
    for (int i = 0; i < 16; ++i) { auto r = __builtin_amdgcn_permlane32_swap(__float_as_uint(part[i]), __float_as_uint(part[i + 16]), false, false); part[i] = __uint_as_float(r[0]) + __uint_as_float(r[1]); }
#pragma unroll
    for (int i = 0; i < 8; ++i) { auto r = __builtin_amdgcn_permlane16_swap(__float_as_uint(part[i]), __float_as_uint(part[i + 8]), false, false); part[i] = __uint_as_float(r[0]) + __uint_as_float(r[1]); }
#pragma unroll
    for (int i = 0; i < 4; ++i) { const bool hi = (lane & 8) != 0; const float send = hi ? part[i] : part[i + 4], keep = hi ? part[i + 4] : part[i]; part[i] = keep + __shfl_xor(send, 8); }
#pragma unroll
    for (int i = 0; i < 2; ++i) { const bool hi = (lane & 4) != 0; const float send = hi ? part[i] : part[i + 2], keep = hi ? part[i + 2] : part[i]; part[i] = keep + __shfl_xor(send, 4); }
    { const bool hi = (lane & 2) != 0; const float send = hi ? part[0] : part[1], keep = hi ? part[1] : part[0]; part[0] = keep + __shfl_xor(send, 2); }
    return part[0] + __shfl_xor(part[0], 1);
}
__device__ __forceinline__ void router_commit(float myv, int lane, bool routed, int lr, int* lcnt, int* lsel, int* lpos, float* lgate) {
    const int e_me = lane >> 1;
    int rank = 0;
#pragma unroll
    for (int e = 0; e < 32; ++e) {
        const float le = __int_as_float(__builtin_amdgcn_readlane(__float_as_int(myv), 2 * e));
        rank += ((le > myv) || (le == myv && e < e_me)) ? 1 : 0;
    }
    if (lane & 1) rank = 99;
    int sel[4]; float sv[4];
#pragma unroll
    for (int t = 0; t < 4; ++t) {
        const unsigned long long mk = __builtin_amdgcn_ballot_w64(rank == t);
        const int src = __builtin_amdgcn_readfirstlane((int)__builtin_ctzll(mk));
        sel[t] = src >> 1; sv[t] = __int_as_float(__builtin_amdgcn_readlane(__float_as_int(myv), src));
    }
    const float e0 = 1.f, e1 = __expf(sv[1] - sv[0]), e2 = __expf(sv[2] - sv[0]), e3 = __expf(sv[3] - sv[0]);
    const float isum = 1.f / (e0 + e1 + e2 + e3);
    if (lane == 0) {
        const float gs[4] = {e0 * isum, e1 * isum, e2 * isum, e3 * isum};
#pragma unroll
        for (int t = 0; t < 4; ++t) {
            if (routed) { const int lp = atomicAdd(lcnt + sel[t], 1); lsel[lr * 4 + t] = sel[t]; lpos[lr * 4 + t] = lp; lgate[lr * 4 + t] = gs[t]; }
            else { lsel[lr * 4 + t] = -1; lpos[lr * 4 + t] = 0; lgate[lr * 4 + t] = 0.f; }
        }
    }
}
__device__ __forceinline__ void phase_router(PRef p, int layer, unsigned char* ldsraw) {
    float* RW = (float*)ldsraw;
    int* lcnt = (int*)(ldsraw + 32 * RW_LD * 4);
    int* lbase = lcnt + 32;
    int* lsel = lbase + 32; int* lpos = lsel + 288; float* lgate = (float*)(lpos + 288);
    const int tid = get_tid(), wave = tid >> 6, lane = tid & 63;
    {
        f32x4 rw[16];
#pragma unroll
        for (int q = 0; q < 16; ++q) rw[q] = *(const f32x4*)(p.router_w + (size_t)layer * 32768 + (size_t)(q * NT + tid) * 4);
        SCHED_FENCE();
#pragma unroll
        for (int q = 0; q < 16; ++q) { const int i = (q * NT + tid) * 4, c = i >> 5, e = i & 31; RW[e * RW_LD + c] = rw[q].x; RW[(e + 1) * RW_LD + c] = rw[q].y; RW[(e + 2) * RW_LD + c] = rw[q].z; RW[(e + 3) * RW_LD + c] = rw[q].w; }
    }
    if (tid < 32) lcnt[tid] = 0;
    __syncthreads();
    float* xs = (float*)(p.ws + OFF_XS); bf16_t* hb = (bf16_t*)(p.ws + OFF_HB);
    const float* modv = (const float*)(p.ws + OFF_MOD) + (size_t)layer * 5 * 6144;
    const int chunk = (R_ + get_nblk() - 1) / get_nblk();
    const int r0 = get_bid() * chunk, r1 = (r0 + chunk < R_) ? r0 + chunk : R_;
    const float rbias = p.router_b[layer * 32 + (lane >> 1)];
    f32x4 wv2[4]; load_row4(p.norm2_w + layer * D_, lane, wv2);
    for (int rA = r0 + wave; rA < r1; rA += 16) {
        const bool hasB = rA + 8 < r1; const int rB = hasB ? rA + 8 : rA;
        const int bA = rA / TPB, ppA = rA - bA * TPB, bB = rB / TPB, ppB = rB - bB * TPB;
        f32x4 hvA[4], hvB[4];
        {
            f32x4 vA[4], vB[4], scA[4], shA[4], scB[4], shB[4];
            const float* mvA = modv + (size_t)(ppA < CTX_ ? 4 : bA) * 6144; const float* mvB = modv + (size_t)(ppB < CTX_ ? 4 : bB) * 6144;
            load_row4(xs + (size_t)rA * D_, lane, vA); load_row4(xs + (size_t)rB * D_, lane, vB);
            load_row4(mvA + 4096, lane, scA); load_row4(mvA + 3072, lane, shA); load_row4(mvB + 4096, lane, scB); load_row4(mvB + 3072, lane, shB);
            SCHED_FENCE();
            const float rsA = row_rstd(vA), rsB = row_rstd(vB);
            norm_apply_store(vA, rsA, wv2, scA, shA, hb + (size_t)rA * D_, lane, hvA);
            norm_apply_store(vB, rsB, wv2, scB, shB, hb + (size_t)rB * D_, lane, hvB);
        }
        float pA[32], pB[32];
#pragma unroll
        for (int e0 = 0; e0 < 32; e0 += 4) {
            f32x4 w[4][4];
#pragma unroll
            for (int q = 0; q < 4; ++q)
#pragma unroll
                for (int j = 0; j < 4; ++j) w[q][j] = *(const f32x4*)(RW + (e0 + q) * RW_LD + 4 * lane + 256 * j);
            SCHED_FENCE();
#pragma unroll
            for (int q = 0; q < 4; ++q) {
                float a = 0.f, c = 0.f;
#pragma unroll
                for (int j = 0; j < 4; ++j) { a = fmaf(hvA[j].x, w[q][j].x, a); a = fmaf(hvA[j].y, w[q][j].y, a); a = fmaf(hvA[j].z, w[q][j].z, a); a = fmaf(hvA[j].w, w[q][j].w, a);
                                              c = fmaf(hvB[j].x, w[q][j].x, c); c = fmaf(hvB[j].y, w[q][j].y, c); c = fmaf(hvB[j].z, w[q][j].z, c); c = fmaf(hvB[j].w, w[q][j].w, c); }
                pA[e0 + q] = a; pB[e0 + q] = c;
            }
            SCHED_FENCE();
        }
        const float lgA = router_reduce(pA, lane) + rbias, lgB = router_reduce(pB, lane) + rbias;
        router_commit(lgA, lane, !(layer == 1 && ppA < CTX_), rA - r0, lcnt, lsel, lpos, lgate);
        if (hasB) router_commit(lgB, lane, !(layer == 1 && ppB < CTX_), rB - r0, lcnt, lsel, lpos, lgate);
    }
    __syncthreads();
    if (tid < 32) lbase[tid] = atomicAdd((int*)(p.ws + OFF_CTL) + layer * 32 + tid, lcnt[tid]);
    __syncthreads();
    float* gate = (float*)(p.ws + OFF_GATE); int* rowe = (int*)(p.ws + OFF_ROWE);
    for (int i = tid; i < (r1 - r0) * 4; i += NT) { const int e = lsel[i]; if (e >= 0) { rowe[(size_t)e * ROWE_CAP + lbase[e] + lpos[i]] = r0 * 4 + i; gate[r0 * 4 + i] = lgate[i]; } }
    __syncthreads();
}

__device__ __forceinline__ void moe_offsets(PRef p, int layer, int* off) {
    const int tid = get_tid();
    if (tid == 0) { const int* cnt = (const int*)(p.ws + OFF_CTL) + layer * 32; int a = 0; for (int e = 0; e < 32; ++e) { const int c = cnt[e]; off[e] = a; off[40 + e] = c; a += (c + 255) & ~255; } off[32] = a; }
    __syncthreads();
    if (tid < PMAX / 256) { int e = 0; for (int q = 1; q < 32; ++q) e += (off[q] <= tid * 256) ? 1 : 0; off[96 + tid] = e; }
    __syncthreads();
}

struct EpiMoe1 {
    static constexpr bool PERM = false, AFTER_DRAIN = false;
    bf16_t* act; const float* b1l;
    __device__ __forceinline__ void operator()(const f32x4 (&acc)[2][2][4][2], const pg8::Unit& u, int wr, int wc, int fr, int fq) const {
        const int e = u.aux >> 8, ln = u.aux & 255;
        const int ucol0 = ln * 256 + wc * 64 + 16 * fq;
        const float* b1 = b1l + (size_t)e * 2048 + ucol0;
        f32x4 bv[2][2];
#pragma unroll
        for (int bj = 0; bj < 2; ++bj)
#pragma unroll
            for (int n = 0; n < 2; ++n) bv[bj][n] = *(const f32x4*)(b1 + 8 * bj + 4 * n);
#pragma unroll
        for (int ai = 0; ai < 2; ++ai)
#pragma unroll
            for (int m = 0; m < 4; ++m) {
                const int prow = u.pm * 256 + ai * 128 + wr * 64 + m * 16 + fr;
                u32x4 o; unsigned ow[4];
#pragma unroll
                for (int bj = 0; bj < 2; ++bj)
#pragma unroll
                    for (int n = 0; n < 2; ++n) {
                        const f32x4 uu = acc[ai][bj][m][n] + bv[bj][n];
                        const float g0 = fminf(uu.x, 7.f), l0 = fminf(fmaxf(uu.y, -7.f), 7.f), g1 = fminf(uu.z, 7.f), l1 = fminf(fmaxf(uu.w, -7.f), 7.f);
                        const float y0 = g0 * sigmoidf_(1.702f * g0) * (l0 + 1.f), y1 = g1 * sigmoidf_(1.702f * g1) * (l1 + 1.f);
                        ow[2 * bj + n] = pack2(y0, y1);
                    }
                o.x = ow[0]; o.y = ow[1]; o.z = ow[2]; o.w = ow[3];
                *(u32x4*)(act + (size_t)prow * DFF + (ucol0 >> 1)) = o;
            }
    }
};
__device__ __forceinline__ void phase_moe1(PRef p, int layer, unsigned char* lds) {
    int* off = (int*)(lds + pg8::STAGE_BYTES);
    moe_offsets(p, layer, off);
    pg8::Gemm g{(const bf16_t*)(p.ws + OFF_HB), (const bf16_t*)(p.ws + OFF_W1) + (size_t)layer * NE * 2048 * D_, D_};
    pg8::MoeSched<true> S; S.init(off[32] >> 8, 8, get_nblk(), get_bid()); S.tab = off; S.rowe = (const int*)(p.ws + OFF_ROWE); S.K2 = D_ * 2;
    EpiMoe1 E{(bf16_t*)(p.ws + OFF_ACT), p.b1 + (size_t)layer * NE * 2048};
    pg8::gemm_phase<EpiMoe1, pg8::MoeSched<true>, true, true>((PG8_LAS unsigned char*)lds, g, S, E);
}

struct EpiMoe2 {
    static constexpr bool PERM = false, AFTER_DRAIN = false;
    bf16_t* ybuf; const float* b2l; const int* rowe; const int* tab; const float* gate;
    __device__ __forceinline__ void operator()(const f32x4 (&acc)[2][2][4][2], const pg8::Unit& u, int wr, int wc, int fr, int fq) const {
        const int e = u.aux >> 8, ln = u.aux & 255;
        const int col0 = ln * 256 + wc * 64 + 16 * fq;
        const float* b2 = b2l + (size_t)e * D_ + col0;
        f32x4 bv[2][2];
#pragma unroll
        for (int bj = 0; bj < 2; ++bj)
#pragma unroll
            for (int n = 0; n < 2; ++n) bv[bj][n] = *(const f32x4*)(b2 + 8 * bj + 4 * n);
#pragma unroll
        for (int ai = 0; ai < 2; ++ai)
#pragma unroll
            for (int m = 0; m < 4; ++m) {
                const int pos = u.pm * 256 - tab[e] + ai * 128 + wr * 64 + m * 16 + fr;
                const int idx = pos < tab[40 + e] ? rowe[(size_t)e * ROWE_CAP + pos] : -1;
                if (idx >= 0) {
                    const float gt = gate[idx];
                    unsigned ow[8];
#pragma unroll
                    for (int bj = 0; bj < 2; ++bj)
#pragma unroll
                        for (int n = 0; n < 2; ++n) { const f32x4 y = (acc[ai][bj][m][n] + bv[bj][n]) * gt; ow[4 * bj + 2 * n] = pack2(y.x, y.y); ow[4 * bj + 2 * n + 1] = pack2(y.z, y.w); }
                    u32x4 o0, o1; o0.x = ow[0]; o0.y = ow[1]; o0.z = ow[2]; o0.w = ow[3]; o1.x = ow[4]; o1.y = ow[5]; o1.z = ow[6]; o1.w = ow[7];
                    bf16_t* d = ybuf + (size_t)idx * D_ + col0;
                    *(u32x4*)d = o0; *(u32x4*)(d + 8) = o1;
                }
            }
    }
};
__device__ __forceinline__ void phase_moe2(PRef p, int layer, unsigned char* lds) {
    int* off = (int*)(lds + pg8::STAGE_BYTES);
    moe_offsets(p, layer, off);
    pg8::Gemm g{(const bf16_t*)(p.ws + OFF_ACT), (const bf16_t*)(p.ws + OFF_W2) + (size_t)layer * NE * D_ * DFF, DFF};
    pg8::MoeSched<false> S; S.init(off[32] >> 8, 4, get_nblk(), get_bid()); S.tab = off; S.rowe = nullptr; S.K2 = 0;
    EpiMoe2 E{(bf16_t*)(p.ws + OFF_YBUF), p.b2 + (size_t)layer * NE * D_, (const int*)(p.ws + OFF_ROWE), off, (const float*)(p.ws + OFF_GATE)};
    pg8::gemm_phase<EpiMoe2, pg8::MoeSched<false>, true, true>((PG8_LAS unsigned char*)lds, g, S, E);
}

__device__ __forceinline__ void phase_combine(PRef p, int layer) {
    const int tid = get_tid(), wave = tid >> 6, lane = tid & 63;
    float* xs = (float*)(p.ws + OFF_XS); bf16_t* hb = (bf16_t*)(p.ws + OFF_HB); const bf16_t* ybuf = (const bf16_t*)(p.ws + OFF_YBUF);
    const float* modv = (const float*)(p.ws + OFF_MOD);
    f32x4 wv[4]; load_row4(layer == 0 ? p.norm1_w + D_ : p.final_norm_w, lane, wv);
    for (int r = get_bid() * 8 + wave; r < R_; r += get_nblk() * 8) {
        const int b = r / TPB, pp = r - b * TPB;
        if (layer == 1 && pp < CTX_) continue;
        const int mi = pp < CTX_ ? 4 : b;
        u32x2 yw[4][4]; f32x4 gv[4], xv[4], scv[4], shv[4], v[4], hv[4];
#pragma unroll
        for (int j = 0; j < 4; ++j)
#pragma unroll
            for (int s = 0; s < 4; ++s) yw[j][s] = *(const u32x2*)(ybuf + ((size_t)r * 4 + s) * D_ + 4 * lane + 256 * j);
        load_row4(modv + (size_t)(layer * 5 + mi) * 6144 + 5120, lane, gv);
        load_row4(xs + (size_t)r * D_, lane, xv);
        if (layer == 0) { const float* mv = modv + (size_t)(5 + mi) * 6144; load_row4(mv + 1024, lane, scv); load_row4(mv, lane, shv); }
        SCHED_FENCE();
#pragma unroll
        for (int j = 0; j < 4; ++j) {
            f32x4 f = (f32x4){0.f, 0.f, 0.f, 0.f};
#pragma unroll
            for (int s = 0; s < 4; ++s) { f.x += bflo(yw[j][s].x); f.y += bfhi(yw[j][s].x); f.z += bflo(yw[j][s].y); f.w += bfhi(yw[j][s].y); }
            v[j] = xv[j] + gv[j] * f;
        }
        const float rstd = row_rstd(v);
        if (layer == 0) {
#pragma unroll
            for (int j = 0; j < 4; ++j) *(f32x4*)(xs + (size_t)r * D_ + 4 * lane + 256 * j) = v[j];
            norm_apply_store(v, rstd, wv, scv, shv, hb + (size_t)r * D_, lane, hv);
        } else {
            float* dst = p.out + ((size_t)b * SEQ_ + (pp - CTX_)) * D_;
#pragma unroll
            for (int j = 0; j < 4; ++j) { f32x4 o; o.x = v[j].x * rstd * wv[j].x; o.y = v[j].y * rstd * wv[j].y; o.z = v[j].z * rstd * wv[j].z; o.w = v[j].w * rstd * wv[j].w; *(f32x4*)(dst + 4 * lane + 256 * j) = o; }
        }
    }
}

#define LAS __attribute__((address_space(3)))
#define XB_TMO      128
#define XB_XCNT(j)  (256  + 64 * (j))
#define XB_XSUB(j)  (1280 + 64 * (j))
#define XB_XGEN(j)  (2304 + 64 * (j))
#define XB_TOP      3328
#define XB_TOPGEN   3392
#define XCD_BAR_WORDS 3456
#define XB_SPIN_CAP (1u << 18)

__device__ __forceinline__ unsigned xb_ld(unsigned* p)              { return __hip_atomic_load(p, __ATOMIC_RELAXED, __HIP_MEMORY_SCOPE_AGENT); }
__device__ __forceinline__ unsigned xb_add(unsigned* p, unsigned v) { return __hip_atomic_fetch_add(p, v, __ATOMIC_RELAXED, __HIP_MEMORY_SCOPE_AGENT); }
__device__ __forceinline__ unsigned xb_xcc_id() { return (unsigned)__builtin_amdgcn_s_getreg((3 << 11) | 20) & 0xFu; }
#define XB_SPIN(cond, bar) do { unsigned _sp = 0; while (cond) { __builtin_amdgcn_s_sleep(1); \
    if ((++_sp & 255u) == 0u) { if (xb_ld(&(bar)[XB_TMO])) break; if (_sp > XB_SPIN_CAP) { atomicAdd(&(bar)[XB_TMO], 1u); break; } } } } while (0)

struct XcdBarrier {
    unsigned* bar; unsigned x;
    volatile LAS unsigned* st;
};

__device__ __forceinline__ XcdBarrier xcd_barrier_post(unsigned* bar, volatile LAS unsigned* st) {
    XcdBarrier b; b.bar = bar; b.x = xb_xcc_id(); b.st = st;
    if (threadIdx.x == 0) (void)xb_add(&bar[XB_XCNT(b.x)], 1u);
    return b;
}
__device__ __forceinline__ void xcd_barrier_complete(unsigned* bar, unsigned x, unsigned& nloc, unsigned& nx) {
    const unsigned G = gridDim.x * gridDim.y * gridDim.z;
    unsigned sum, cnt, mine, sp = 0u;
    for (;;) {
        sum = 0u; cnt = 0u; mine = 0u;
#pragma unroll
        for (unsigned j = 0; j < 16; ++j) { const unsigned c = xb_ld(&bar[XB_XCNT(j)]); sum += c; cnt += (c > 0u) ? 1u : 0u; mine = (j == x) ? c : mine; }
        if (sum == G) break;
        __builtin_amdgcn_s_sleep(1);
        if ((++sp & 255u) == 0u) { if (xb_ld(&bar[XB_TMO])) break; if (sp > XB_SPIN_CAP) { atomicAdd(&bar[XB_TMO], 1u); break; } }
    }
    nloc = mine > 0u ? mine : 1u; nx = cnt > 0u ? cnt : 1u;
}

__device__ __forceinline__ void xcd_barrier(const XcdBarrier& b) {
    asm volatile("s_waitcnt vmcnt(0)" ::: "memory");
    __syncthreads();
    if (threadIdx.x == 0) {
        unsigned* bar = b.bar;
        __builtin_amdgcn_s_waitcnt(0);
        unsigned nloc = b.st[0], nx = b.st[1];
        if (nloc == 0u) { xcd_barrier_complete(bar, b.x, nloc, nx); b.st[0] = nloc; b.st[1] = nx; }
        const unsigned old = xb_add(&bar[XB_XSUB(b.x)], 1u);
        const unsigned gen = old / nloc;
        if (old + 1u == (gen + 1u) * nloc) {
            __builtin_amdgcn_fence(__ATOMIC_RELEASE, "agent");
            asm volatile("s_waitcnt vmcnt(0)" ::: "memory");
            const unsigned og = xb_add(&bar[XB_TOP], 1u);
            const unsigned tg = og / nx;
            if (og + 1u == (tg + 1u) * nx) xb_add(&bar[XB_TOPGEN], 1u);
            else XB_SPIN(xb_ld(&bar[XB_TOPGEN]) == tg, bar);
            __builtin_amdgcn_fence(__ATOMIC_ACQUIRE, "agent");
            xb_add(&bar[XB_XGEN(b.x)], 1u);
            asm volatile("s_waitcnt vmcnt(0)" ::: "memory");
        } else {
            XB_SPIN(xb_ld(&bar[XB_XGEN(b.x)]) == gen, bar);
            __builtin_amdgcn_fence(__ATOMIC_ACQUIRE, "agent");
            asm volatile("s_waitcnt vmcnt(0)" ::: "memory");
        }
    }
    __syncthreads();
}


constexpr int NPHASE = 24;
typedef const __attribute__((address_space(4))) Params* KArgs;
__device__ __forceinline__ KArgs kargs() { KArgs q = (KArgs)__builtin_amdgcn_kernarg_segment_ptr(); asm volatile("" : "+s"(q)); return q; }
__device__ __forceinline__ void grid_bar(unsigned char* lds) {
    XcdBarrier b; b.bar = (unsigned*)(kargs()->ws + OFF_BAR); b.x = xb_xcc_id(); b.st = (volatile LAS unsigned*)((LAS unsigned char*)lds + LDS_BYTES - 16);
    xcd_barrier(b);
}
__global__ void __launch_bounds__(NT) fwd_kernel(Params p_unused) {
    extern __shared__ __attribute__((aligned(16))) unsigned char lds[];
    {
        volatile LAS unsigned* bst = (volatile LAS unsigned*)((LAS unsigned char*)lds + LDS_BYTES - 16);
        if (threadIdx.x == 0) { bst[0] = 0u; bst[1] = 0u; }
        __syncthreads();
        (void)xcd_barrier_post((unsigned*)(kargs()->ws + OFF_BAR), bst);
    }
#define PH(ty, last, call) do { const int nrep_ = ((PROBE_MASK1 >> (ty)) & 1) ? 2 : 1; for (int rep_ = 0; rep_ < nrep_; ++rep_) { { PRef p = *kargs(); call; } if (!(last) || rep_ + 1 < nrep_) grid_bar(lds); } } while (0)
    { PRef p = *kargs(); phase_prep(p, lds); }
    cg::this_grid().sync();
    if ((PROBE_MASK1 >> 0) & 1) { { PRef p = *kargs(); phase_prep(p, lds); } grid_bar(lds); }
    PH(1, false, phase_norm_in(p));
#pragma nounroll
    for (int L = 0; L < 2; ++L) {
        PH(2, false, phase_inproj(p, L, lds));
        PH(3, false, phase_mixers(p, L, lds));
        PH(4, false, phase_hgrn_c2(p));
        PH(5, false, phase_hgrn_inter(p, L, lds));
        PH(7, false, phase_outproj(p, L, lds));
        PH(8, false, phase_router(p, L, lds));
        PH(10, false, phase_moe1(p, L, lds));
        PH(11, false, phase_moe2(p, L, lds));
        PH(12, L == 1, phase_combine(p, L));
    }
#undef PH
}

extern "C" void kernel_launch(void* const* d_in, const int* in_sizes, int n_in, void* d_out, int out_size, void* d_ws, size_t ws_size, hipStream_t stream) {
    static int grid = 0;
    if (grid == 0) {
        if (ws_size < WS_END) { fprintf(stderr, "kernel_launch: workspace too small (%zu < %zu)\n", ws_size, (size_t)WS_END); grid = -1; return; }
        int dev = 0, cus = 0, per_cu = 0;
        (void)hipGetDevice(&dev);
        (void)hipDeviceGetAttribute(&cus, hipDeviceAttributeMultiprocessorCount, dev);
        (void)hipFuncSetAttribute((const void*)fwd_kernel, hipFuncAttributeMaxDynamicSharedMemorySize, LDS_BYTES);
        (void)hipOccupancyMaxActiveBlocksPerMultiprocessor(&per_cu, (const void*)fwd_kernel, NT, LDS_BYTES);
        if (per_cu < 1) { fprintf(stderr, "kernel_launch: occupancy query reports %d blocks per CU\n", per_cu); }
        grid = cus;
        (void)hipGetLastError();
    }
    if (grid < 0) return;
    Params p{};
    const float** pin = (const float**)&p;
    for (int i = 0; i < 22; ++i) pin[i] = (const float*)d_in[i];
    p.out = (float*)d_out; p.ws = (unsigned char*)d_ws;
    (void)hipMemsetAsync((char*)d_ws + OFF_BAR, 0, XCD_BAR_WORDS * 4, stream);
    void* args[] = {&p};
    hipError_t e = hipLaunchCooperativeKernel((const void*)fwd_kernel, dim3(grid), dim3(NT), args, LDS_BYTES, stream);
    if (e != hipSuccess) fprintf(stderr, "cooperative launch failed: %s (grid %d)\n", hipGetErrorString(e), grid);
}
```

```cpp
#include <hip/hip_runtime.h>
#include <hip/hip_cooperative_groups.h>
#include <stdint.h>
#include <stdio.h>
namespace cg = cooperative_groups;

#ifndef MEGA
#define MEGA 1
#endif
#ifndef PROBE
#define PROBE 0
#endif
#define PROBE_MASK1 0x0
#define PROBE_MASK2 0x0

typedef unsigned short bf16_t;
typedef short bf16x8 __attribute__((ext_vector_type(8)));
typedef float f32x4 __attribute__((ext_vector_type(4)));
typedef unsigned u32x4 __attribute__((ext_vector_type(4)));
typedef unsigned u32x2 __attribute__((ext_vector_type(2)));

#define NT 512
constexpr int D_ = 1024, NB_ = 4, SEQ_ = 4096, CTX_ = 256, TPB = 4352, R_ = NB_ * TPB, INW = 3584, NE = 32, DFF = 1024;
constexpr float EPS_ = 1e-6f;
constexpr int PMAX = 77824;
constexpr int LDS_BYTES = 147456;
constexpr int ROWE_CAP = R_;

constexpr size_t OFF_CTL = 0;
constexpr size_t OFF_ROPE = 65536;
constexpr size_t OFF_MOD = 131072;
constexpr size_t OFF_WIN = 1u << 20;
constexpr size_t OFF_WOUT = OFF_WIN + (size_t)2 * INW * D_ * 2;
constexpr size_t OFF_W1 = OFF_WOUT + (size_t)2 * D_ * D_ * 2;
constexpr size_t OFF_W2 = OFF_W1 + (size_t)2 * NE * 2048 * D_ * 2;
constexpr size_t OFF_XS = OFF_W2 + (size_t)2 * NE * D_ * DFF * 2;
constexpr size_t OFF_HB = OFF_XS + (size_t)R_ * D_ * 4;
constexpr size_t OFF_PROJ = OFF_HB + (size_t)R_ * D_ * 2;
constexpr size_t OFF_MIX = OFF_PROJ + (size_t)R_ * INW * 2;
constexpr size_t OFF_OF = OFF_MIX + (size_t)R_ * D_ * 2;
constexpr size_t OFF_OB = OFF_OF + (size_t)R_ * 512 * 4;
constexpr size_t OFF_EID = OFF_OB + (size_t)R_ * 512 * 4;
constexpr size_t OFF_GATE = OFF_EID + (size_t)R_ * 16;
constexpr size_t OFF_POS = OFF_GATE + (size_t)R_ * 16;
constexpr size_t OFF_ROWL = OFF_POS + (size_t)R_ * 16;
constexpr size_t OFF_ACT = OFF_ROWL + (size_t)PMAX * 4;
constexpr size_t OFF_YBUF = OFF_ACT + (size_t)PMAX * DFF * 2;
constexpr size_t OFF_LT = OFF_YBUF + (size_t)R_ * 4 * D_ * 2;
constexpr size_t OFF_SB = OFF_LT + (size_t)2176 * 16384 * 2;
constexpr size_t OFF_DEC = OFF_SB + (size_t)2176 * 16384 * 2;
constexpr size_t OFF_QH = OFF_DEC + (size_t)2176 * 128 * 4;
constexpr size_t OFF_ROWE = OFF_QH + (size_t)2176 * 8192 * 2;
constexpr size_t WS_END = OFF_ROWE + (size_t)NE * ROWE_CAP * 4;
constexpr size_t OFF_LB = 4096;
constexpr int LDS_ROPE = 135168;
constexpr size_t OFF_BAR = 16384;
constexpr size_t OFF_TS = 32768;
constexpr size_t OFF_HS = OFF_PROJ;
static_assert((size_t)PMAX * D_ * 2 <= (size_t)R_ * INW * 2 + (size_t)R_ * D_ * 2, "hs overlay");

struct Params {
    const float *x, *c, *ctx, *c_ctx, *w_mod, *b_mod, *norm1_w, *norm2_w, *w_in, *w_out, *attn_sink, *q_norm_w, *k_norm_w, *hgrn_lb,
        *gate_norm_w, *router_w, *router_b, *w1, *b1, *w2, *b2, *final_norm_w;
    float* out;
    unsigned char* ws;
};

typedef const __attribute__((address_space(4))) Params& PRef;
typedef __bf16 bf2_t __attribute__((ext_vector_type(2)));
__device__ __forceinline__ unsigned pack2(float lo, float hi) { bf2_t v; v.x = (__bf16)lo; v.y = (__bf16)hi; return __builtin_bit_cast(unsigned, v); }
__device__ __forceinline__ unsigned f2bf(float f) { return pack2(f, 0.f) & 0xffffu; }
__device__ __forceinline__ float bflo(unsigned w) { return __uint_as_float(w << 16); }
__device__ __forceinline__ float bfhi(unsigned w) { return __uint_as_float(w & 0xffff0000u); }
__device__ __forceinline__ float xadd16(float v) { auto r = __builtin_amdgcn_permlane16_swap(__float_as_uint(v), __float_as_uint(v), false, false); return __uint_as_float(r[0]) + __uint_as_float(r[1]); }
__device__ __forceinline__ float xadd32(float v) { auto r = __builtin_amdgcn_permlane32_swap(__float_as_uint(v), __float_as_uint(v), false, false); return __uint_as_float(r[0]) + __uint_as_float(r[1]); }
__device__ __forceinline__ float xmax16(float v) { auto r = __builtin_amdgcn_permlane16_swap(__float_as_uint(v), __float_as_uint(v), false, false); return fmaxf(__uint_as_float(r[0]), __uint_as_float(r[1])); }
__device__ __forceinline__ float xmax32(float v) { auto r = __builtin_amdgcn_permlane32_swap(__float_as_uint(v), __float_as_uint(v), false, false); return fmaxf(__uint_as_float(r[0]), __uint_as_float(r[1])); }
__device__ __forceinline__ float wave_sum(float v) {
    v += __int_as_float(__builtin_amdgcn_update_dpp(0, __float_as_int(v), 0x111, 0xf, 0xf, true));
    v += __int_as_float(__builtin_amdgcn_update_dpp(0, __float_as_int(v), 0x112, 0xf, 0xf, true));
    v += __int_as_float(__builtin_amdgcn_update_dpp(0, __float_as_int(v), 0x114, 0xf, 0xf, true));
    v += __int_as_float(__builtin_amdgcn_update_dpp(0, __float_as_int(v), 0x118, 0xf, 0xf, true));
    v += __int_as_float(__builtin_amdgcn_update_dpp(0, __float_as_int(v), 0x142, 0xa, 0xf, false));
    v += __int_as_float(__builtin_amdgcn_update_dpp(0, __float_as_int(v), 0x143, 0xc, 0xf, false));
    return __int_as_float(__builtin_amdgcn_readlane(__float_as_int(v), 63));
}
__device__ __forceinline__ int get_tid() { int t = threadIdx.x; asm volatile("" : "+v"(t)); return t; }
__device__ __forceinline__ int get_bid() { int t = blockIdx.x; asm volatile("" : "+s"(t)); return t; }
__device__ __forceinline__ int get_nblk() { int t = gridDim.x; asm volatile("" : "+s"(t)); return t; }
__device__ __forceinline__ float sigmoidf_(float z) { return __builtin_amdgcn_rcpf(1.f + __expf(-z)); }

__device__ __forceinline__ int perm_row(int c, int perm) {
    const int lc = c & 255;
    if (perm == 1) { const int wcc = lc >> 6, dim = lc & 63; return (c & ~255) + 128 * (dim >> 5) + 32 * wcc + (dim & 31); }
    if (perm == 2) { const int wcc = lc >> 6, fq = (lc >> 4) & 3, bj = (lc >> 3) & 1, n = (lc >> 2) & 1, i = lc & 3; return (c & ~255) + 128 * bj + 32 * wcc + 16 * n + 4 * fq + i; }
    return c;
}
__device__ __forceinline__ void prep_transpose_item(const float* __restrict__ src, int K, int N, bf16_t* __restrict__ dst, int item, int perm, unsigned char* lds) {
    constexpr int LDO = 72;
    const int nb = N >> 8, kb = item / nb, nbk = item - kb * nb, k0 = kb * 64, n0 = nbk * 256, tid = get_tid(), kc = tid >> 6, lane = tid & 63;
    const float* s = src + (size_t)(k0 + kc * 8) * N + n0 + 4 * lane;
    f32x4 v[8];
#pragma unroll
    for (int j = 0; j < 8; ++j) v[j] = __builtin_nontemporal_load((const f32x4*)(s + (size_t)j * N));
    bf16_t* img = (bf16_t*)lds;
#pragma unroll
    for (int ni = 0; ni < 4; ++ni) {
        u32x4 w;
        w.x = pack2(v[0][ni], v[1][ni]); w.y = pack2(v[2][ni], v[3][ni]); w.z = pack2(v[4][ni], v[5][ni]); w.w = pack2(v[6][ni], v[7][ni]);
        *(u32x4*)(img + (4 * lane + ni) * LDO + kc * 8) = w;
    }
    __syncthreads();
#pragma unroll
    for (int i = 0; i < 4; ++i) {
        const int n = (tid >> 3) + 64 * i, pc = tid & 7;
        const u32x4 w = *(const u32x4*)(img + n * LDO + pc * 8);
        __builtin_nontemporal_store(w, (u32x4*)(dst + (size_t)perm_row(n0 + n, perm) * K + k0 + pc * 8));
    }
    __syncthreads();
}

constexpr int N_MOECONV = 32 * 128 + 32 * 64;
constexpr int CV_TAILN = 6;
constexpr int CV_OUTTAIL = 0, CV_INTAIL = 72 * CV_TAILN;
__device__ __forceinline__ void moe_conv_item(PRef p, int layer, int idx, unsigned char* lds) {
    if (idx < 4096) { const int m = layer * 32 + (idx >> 7), ii = idx & 127; prep_transpose_item(p.w1 + (size_t)m * D_ * 2048, D_, 2048, (bf16_t*)(p.ws + OFF_W1) + (size_t)m * 2048 * D_, ii, 2, lds); }
    else { const int j = idx - 4096, m = layer * 32 + (j >> 6), ii = j & 63; prep_transpose_item(p.w2 + (size_t)m * DFF * D_, DFF, D_, (bf16_t*)(p.ws + OFF_W2) + (size_t)m * D_ * DFF, ii, 2, lds); }
}

__device__ __forceinline__ void prep_mod_item(PRef p, int item, float* lds) {
    const int l = item / 96, col0 = (item - l * 96) * 64, tid = get_tid();
    float* s = lds;
    float* red = lds + 5 * 1024;
    for (int i = tid; i < 5 * 1024; i += NT) { const int row = i >> 10, k = i & 1023; const float cv = row < 4 ? p.c[row * 1024 + k] : p.c_ctx[k]; s[i] = cv / (1.f + __expf(-cv)); }
    __syncthreads();
    const int col = tid & 63, kq = tid >> 6;
    const float* w = p.w_mod + (size_t)l * 1024 * 6144 + col0 + col;
    float a0 = 0.f, a1 = 0.f, a2 = 0.f, a3 = 0.f, a4 = 0.f;
#pragma unroll 8
    for (int k = kq * 128; k < kq * 128 + 128; ++k) {
        const float wv = __builtin_nontemporal_load(w + (size_t)k * 6144);
        a0 += s[k] * wv; a1 += s[1024 + k] * wv; a2 += s[2048 + k] * wv; a3 += s[3072 + k] * wv; a4 += s[4096 + k] * wv;
    }
    red[(kq * 5 + 0) * 64 + col] = a0; red[(kq * 5 + 1) * 64 + col] = a1; red[(kq * 5 + 2) * 64 + col] = a2; red[(kq * 5 + 3) * 64 + col] = a3; red[(kq * 5 + 4) * 64 + col] = a4;
    __syncthreads();
    if (tid < 320) {
        const int r = tid >> 6, c = tid & 63; float sum = 0.f;
#pragma unroll
        for (int q = 0; q < 8; ++q) sum += red[(q * 5 + r) * 64 + c];
        float* modv = (float*)(p.ws + OFF_MOD);
        modv[(size_t)(l * 5 + r) * 6144 + col0 + c] = sum + p.b_mod[l * 6144 + col0 + c];
    }
    __syncthreads();
}

__device__ __forceinline__ void phase_prep(PRef p, unsigned char* ldsraw) {
    float* lds = (float*)ldsraw;
    const int tid = get_tid();
    constexpr int N_MOD = 192, N_MISC = 1, N_WIN = 2 * 16 * 14, N_WOUT = 2 * 16 * 4;
    constexpr int NITEMS = N_MOD + N_MISC + N_WIN + N_WOUT;
    for (int it = get_bid(); it < NITEMS; it += get_nblk()) {
        int r = it;
        if (r < N_MOD) { prep_mod_item(p, r, lds); continue; } r -= N_MOD;
        if (r < N_MISC) {
            float* tab = (float*)(p.ws + OFF_ROPE);
            for (int i = tid; i < 1024; i += NT) { const int pos = i >> 4, fi = i & 15; const float inv = 1.0f / powf(10000.0f, (float)(2 * fi) / 32.0f); const float ang = (float)pos * inv; tab[2 * i] = cosf(ang); tab[2 * i + 1] = sinf(ang); }
            int* cnt = (int*)(p.ws + OFF_CTL);
            if (tid < 128) cnt[tid] = 0;
            float* lbt = (float*)(p.ws + OFF_LB);
            for (int i = tid; i < 1024; i += NT) lbt[i] = sigmoidf_(p.hgrn_lb[1024 + i] - p.hgrn_lb[i]);
            continue;
        } r -= N_MISC;
        if (r < N_WIN) { const int l = r / (16 * 14), ii = r - l * 16 * 14; prep_transpose_item(p.w_in + (size_t)l * D_ * INW, D_, INW, (bf16_t*)(p.ws + OFF_WIN) + (size_t)l * INW * D_, ii, 1, ldsraw); continue; } r -= N_WIN;
        { const int l = r / 64, ii = r - l * 64; prep_transpose_item(p.w_out + (size_t)l * D_ * D_, D_, D_, (bf16_t*)(p.ws + OFF_WOUT) + (size_t)l * D_ * D_, ii, 2, ldsraw); }
    }
}

__device__ __forceinline__ float row_rstd(const f32x4 (&v)[4]) {
    float ss = 0.f;
#pragma unroll
    for (int j = 0; j < 4; ++j) ss += (v[j].x * v[j].x + v[j].y * v[j].y) + (v[j].z * v[j].z + v[j].w * v[j].w);
    return rsqrtf(wave_sum(ss) * (1.0f / D_) + EPS_);
}
#define SCHED_FENCE() __builtin_amdgcn_sched_barrier(0)
__device__ __forceinline__ void load_row4_nt(const float* src, int lane, f32x4 (&v)[4]) {
#pragma unroll
    for (int j = 0; j < 4; ++j) v[j] = __builtin_nontemporal_load((const f32x4*)(src + 4 * lane + 256 * j));
}
__device__ __forceinline__ void load_row4(const float* src, int lane, f32x4 (&v)[4]) {
#pragma unroll
    for (int j = 0; j < 4; ++j) v[j] = *(const f32x4*)(src + 4 * lane + 256 * j);
}
__device__ __forceinline__ void load_xrow4(const bf16_t* src, int lane, f32x4 (&v)[4]) {
    u32x2 w[4];
#pragma unroll
    for (int j = 0; j < 4; ++j) w[j] = *(const u32x2*)(src + 4 * lane + 256 * j);
#pragma unroll
    for (int j = 0; j < 4; ++j) { v[j].x = bflo(w[j].x); v[j].y = bfhi(w[j].x); v[j].z = bflo(w[j].y); v[j].w = bfhi(w[j].y); }
}
__device__ __forceinline__ void store_xrow4(bf16_t* dst, int lane, const f32x4 (&v)[4]) {
#pragma unroll
    for (int j = 0; j < 4; ++j) { u32x2 o; o.x = pack2(v[j].x, v[j].y); o.y = pack2(v[j].z, v[j].w); __builtin_nontemporal_store(o, (u32x2*)(dst + 4 * lane + 256 * j)); }
}
__device__ __forceinline__ void norm_apply_store(const f32x4 (&v)[4], float rstd, const f32x4 (&wv)[4], const f32x4 (&scv)[4], const f32x4 (&shv)[4], bf16_t* dst, int lane, f32x4 (&hv)[4]) {
#pragma unroll
    for (int j = 0; j < 4; ++j) {
        f32x4 h;
        h.x = (v[j].x * rstd * wv[j].x) * (1.f + scv[j].x) + shv[j].x; h.y = (v[j].y * rstd * wv[j].y) * (1.f + scv[j].y) + shv[j].y;
        h.z = (v[j].z * rstd * wv[j].z) * (1.f + scv[j].z) + shv[j].z; h.w = (v[j].w * rstd * wv[j].w) * (1.f + scv[j].w) + shv[j].w;
        hv[j] = h;
        u32x2 o; o.x = pack2(h.x, h.y); o.y = pack2(h.z, h.w);
        *(u32x2*)(dst + 4 * lane + 256 * j) = o;
    }
}

__device__ __forceinline__ void phase_norm_in(PRef p) {
    const int tid = get_tid(), wave = tid >> 6, lane = tid & 63;
    bf16_t* xs = (bf16_t*)(p.ws + OFF_XS); bf16_t* hb = (bf16_t*)(p.ws + OFF_HB); const float* modv = (const float*)(p.ws + OFF_MOD);
    f32x4 wv[4]; load_row4(p.norm1_w, lane, wv);
    const int stride = get_nblk() * 8;
    int r = get_bid() * 8 + wave;
    f32x4 v[4], vn[4], scv[4], shv[4], hv[4];
#define NI_SRC(r_) (((r_) % TPB) < CTX_ ? p.ctx + ((size_t)((r_) / TPB) * CTX_ + ((r_) % TPB)) * D_ : p.x + ((size_t)((r_) / TPB) * SEQ_ + (((r_) % TPB) - CTX_)) * D_)
    if (r < R_) load_row4_nt(NI_SRC(r), lane, v);
    for (; r < R_; r += stride) {
        const int b = r / TPB, pp = r - b * TPB;
        const float* mv = modv + (size_t)(pp < CTX_ ? 4 : b) * 6144;
        const int rn = (r + stride < R_) ? r + stride : r;
        load_row4_nt(NI_SRC(rn), lane, vn); load_row4(mv + 1024, lane, scv); load_row4(mv, lane, shv);
        SCHED_FENCE();
        store_xrow4(xs + (size_t)r * D_, lane, v);
        const float rstd = row_rstd(v);
        norm_apply_store(v, rstd, wv, scv, shv, hb + (size_t)r * D_, lane, hv);
#pragma unroll
        for (int j = 0; j < 4; ++j) v[j] = vn[j];
    }
#undef NI_SRC
}

namespace pg8 {
#define PG8_LAS __attribute__((address_space(3)))
constexpr int BM = 256, BK = 64, HALF = 128, HTB = HALF * BK * 2, STAGE_BYTES = 8 * HTB, NXCD = 8, WGM = 8;
__host__ __device__ __forceinline__ int lds_byte(int r, int c) { const int st = (r >> 4) * 2 + (c >> 5), rr = r & 15, cc = c & 31, ob = rr * 64 + cc * 2; return st * 1024 + (ob ^ (((ob >> 9) & 1) << 5)); }
__host__ __device__ __forceinline__ void stage_rc(int b, int& R, int& C) { const int st = b / 1024, sb = b % 1024, swz = sb ^ (((sb >> 9) & 1) << 5); R = (st >> 1) * 16 + swz / 64; C = (st & 1) * 32 + (swz % 64) / 2; }
__host__ __device__ __forceinline__ int perm32(int rho) { const int n = rho >> 4, i = rho & 15; return 8 * (i >> 2) + 4 * n + (i & 3); }
struct Unit { int pm, pn, aux; };
struct Gemm { const bf16_t* A; const bf16_t* Bt; int K; };
struct TileOrder {
    int nM, nN, nwg, G, c;
    __device__ __forceinline__ void init(int nM_, int nN_, int G_, int c_) { nM = nM_; nN = nN_; nwg = nM * nN; G = G_; c = c_; }
    __device__ __forceinline__ bool map(int i, int& pm, int& pn) const {
        const long L = (long)i * G + c; if (L >= nwg) return false;
        int wgid = (int)L; { const int q = nwg / NXCD, r = nwg % NXCD, xcd = wgid % NXCD, off = wgid / NXCD; wgid = (xcd < r ? xcd * (q + 1) : r * (q + 1) + (xcd - r) * q) + off; }
        const int nig = WGM * nN, gid = wgid / nig, fm = gid * WGM, gsz = (nM - fm) < WGM ? (nM - fm) : WGM;
        pm = fm + ((wgid % nig) % gsz); pn = (wgid % nig) / gsz; return true;
    }
};
struct DenseSched : TileOrder {
    static constexpr bool GATHER = false;
    __device__ __forceinline__ bool next(int i, Unit& u) const { u.aux = 0; return map(i, u.pm, u.pn); }
    __device__ __forceinline__ void a_ready(const Unit&) const {}
    __device__ __forceinline__ void done(const Unit&) const {}
};
template <bool GATHER_>
struct MoeSched : TileOrder {
    static constexpr bool GATHER = GATHER_;
    const int* tab; const int* rowe; int K2;
    __device__ __forceinline__ bool next(int i, Unit& u) const {
        int pm, ln; if (!map(i, pm, ln)) return false;
        const int e = tab[96 + pm];
        u.pm = pm; u.pn = e * nN + ln; u.aux = (i << 16) | (e << 8) | ln; return true;
    }
    const int* ridx;
    __device__ __forceinline__ void fill_ridx(int* dst, int tid) const {
        for (int i = 0; ; i += 2) {
            Unit u0; if (!next(i, u0)) break;
            const int ii = i + (tid >> 8), r = tid & 255;
            Unit u;
            if (next(ii, u)) { const int e = (u.aux >> 8) & 255, pos = u.pm * 256 - tab[e] + r, c = tab[40 + e]; dst[ii * 256 + r] = pos < c ? rowe[(size_t)e * ROWE_CAP + pos] : -1; }
        }
        __syncthreads();
    }
    __device__ __forceinline__ void gather(const Unit& u, int tid, unsigned (&go)[2][2], int ui) const {
        int idx[2][2], C[2];
#pragma unroll
        for (int i = 0; i < 2; ++i) {
            int R; stage_rc(tid * 16 + i * 8192, R, C[i]);
#pragma unroll
            for (int h = 0; h < 2; ++h) idx[h][i] = ridx[ui * 256 + h * 128 + R];
        }
#pragma unroll
        for (int h = 0; h < 2; ++h)
#pragma unroll
            for (int i = 0; i < 2; ++i) go[h][i] = (unsigned)((idx[h][i] < 0 ? 0 : (idx[h][i] >> 2)) * K2 + C[i] * 2);
    }
    __device__ __forceinline__ void a_ready(const Unit&) const {}
    __device__ __forceinline__ void done(const Unit&) const {}
};
template <class Epi, class Sched, bool ALIGN_EPI = false, bool SP2 = false>
__device__ __forceinline__ void gemm_phase(PG8_LAS unsigned char* lds, const Gemm g, const Sched& S, const Epi& E) {
    const int tid = get_tid(), wid = __builtin_amdgcn_readfirstlane(tid >> 6), lane = tid & 63, wr = wid >> 2, wc = wid & 3, fr = lane & 15, fq = lane >> 4;
    const int K = g.K, nt = K / BK;
    unsigned voffA[2], voffB[2];
#pragma unroll
    for (int i = 0; i < 2; ++i) { int R, C; stage_rc(tid * 16 + i * 8192, R, C); const int Rb = Epi::PERM ? ((R & ~31) + perm32(R & 31)) : R;
        voffA[i] = (unsigned)(R * K + C) * 2u; voffB[i] = (unsigned)(Rb * K + C) * 2u; }
    const size_t kstep = (size_t)(BK * 2);
    const size_t hstep = (size_t)HALF * K * 2;
    const size_t tstep = 2 * hstep;
    const unsigned ldsw = (unsigned)wid * 1024u;
    const int aoff = lds_byte(wr * 64 + fr, fq * 8), boff = lds_byte(wc * 32 + fr, fq * 8);
#define PG8_SA(b, h) (((b) * 2 + (h)) * HTB)
#define PG8_SB(b, h) ((4 + (b) * 2 + (h)) * HTB)
#define PG8_STAGE(bufoff, gbase, voff) do { _Pragma("unroll") for (int _i = 0; _i < 2; ++_i) \
        __builtin_amdgcn_global_load_lds((const unsigned*)((const char*)(gbase) + (voff)[_i]), (PG8_LAS unsigned*)(lds + (bufoff) + ldsw + _i * 8192), 16, 0, 0); } while (0)
#define PG8_STAGE_A(bufoff, kbytes, h, usenext) do { if constexpr (Sched::GATHER) { _Pragma("unroll") for (int _i = 0; _i < 2; ++_i) { const unsigned o_ = (usenext) ? ngo[h][_i] : cgo[h][_i]; \
        __builtin_amdgcn_global_load_lds((const unsigned*)((const char*)g.A + (kbytes) + o_), (PG8_LAS unsigned*)(lds + (bufoff) + ldsw + _i * 8192), 16, 0, 0); } } \
    else { PG8_STAGE(bufoff, ((usenext) ? nA : cA) + (kbytes) + (h) * hstep, voffA); } } while (0)
#define PG8_LDA(dst, b, h) do { _Pragma("unroll") for (int m = 0; m < 4; ++m) _Pragma("unroll") for (int k = 0; k < 2; ++k) dst[m][k] = *(const PG8_LAS bf16x8*)(lds + PG8_SA(b, h) + aoff + m * 2048 + k * 1024); } while (0)
#define PG8_LDB(dst, b, h) do { _Pragma("unroll") for (int n = 0; n < 2; ++n) _Pragma("unroll") for (int k = 0; k < 2; ++k) dst[n][k] = *(const PG8_LAS bf16x8*)(lds + PG8_SB(b, h) + boff + n * 2048 + k * 1024); } while (0)
#define PG8_MMA(ai, bj, At, Bt) do { __builtin_amdgcn_s_setprio(1); _Pragma("unroll") for (int m = 0; m < 4; ++m) _Pragma("unroll") for (int n = 0; n < 2; ++n) _Pragma("unroll") for (int k = 0; k < 2; ++k) \
        acc[ai][bj][m][n] = __builtin_amdgcn_mfma_f32_16x16x32_bf16(Bt[n][k], At[m][k], acc[ai][bj][m][n], 0, 0, 0); __builtin_amdgcn_s_setprio(0); } while (0)
#define PG8_WAIT_V(n) asm volatile("s_waitcnt vmcnt(" #n ")" ::: "memory")
#define PG8_WAIT_V8X(rx) asm volatile("s_cmp_eq_u32 %0, 0\n\ts_cbranch_scc1 2\n\ts_waitcnt vmcnt(%1)\n\ts_branch 1\n\ts_waitcnt vmcnt(8)" :: "s"(rx), "n"(8 + Epi::NVM) : "memory", "scc")
#define PG8_WAIT_L(n) asm volatile("s_waitcnt lgkmcnt(" #n ")" ::: "memory")
#define PG8_BAR __builtin_amdgcn_s_barrier()
#define PG8_SCHED __builtin_amdgcn_sched_barrier(0)
    Unit cur, nxt; int ui = 0;
    if (!S.next(0, cur)) return;
    unsigned cgo[2][2] = {{0u, 0u}, {0u, 0u}}, ngo[2][2] = {{0u, 0u}, {0u, 0u}};
    if constexpr (Sched::GATHER) S.gather(cur, tid, cgo, 0);
    f32x4 acc[2][2][4][2];
#pragma unroll
    for (int a = 0; a < 2; ++a)
#pragma unroll
        for (int b = 0; b < 2; ++b)
#pragma unroll
            for (int m = 0; m < 4; ++m)
#pragma unroll
                for (int n = 0; n < 2; ++n) acc[a][b][m][n] = (f32x4){0.f, 0.f, 0.f, 0.f};
    bf16x8 At[4][2], B0[2][2], B1[2][2];
    const char* cA = (const char*)g.A + (size_t)cur.pm * tstep; const char* cB = (const char*)g.Bt + (size_t)cur.pn * tstep;
    const char* nA = cA;
    S.a_ready(cur);
    if constexpr (SP2) {
        PG8_STAGE(PG8_SB(0, 0), cB, voffB); PG8_STAGE(PG8_SB(0, 1), cB + hstep, voffB); PG8_STAGE_A(PG8_SA(0, 0), 0, 0, false); PG8_STAGE_A(PG8_SA(0, 1), 0, 1, false);
        if (wr == 1) PG8_BAR;
        PG8_WAIT_V(2); PG8_BAR;
        PG8_STAGE(PG8_SB(1, 0), cB + kstep, voffB); PG8_STAGE_A(PG8_SA(1, 0), kstep, 0, false); PG8_STAGE(PG8_SB(1, 1), cB + hstep + kstep, voffB);
        PG8_WAIT_V(6); PG8_BAR;
    } else {
        PG8_STAGE(PG8_SB(0, 0), cB, voffB); PG8_STAGE_A(PG8_SA(0, 0), 0, 0, false); PG8_STAGE(PG8_SB(0, 1), cB + hstep, voffB); PG8_STAGE_A(PG8_SA(0, 1), 0, 1, false);
        if (wr == 1) PG8_BAR;
        PG8_WAIT_V(4); PG8_BAR;
        PG8_STAGE(PG8_SB(1, 0), cB + kstep, voffB); PG8_STAGE_A(PG8_SA(1, 0), kstep, 0, false); PG8_STAGE(PG8_SB(1, 1), cB + hstep + kstep, voffB);
        PG8_WAIT_V(6); PG8_BAR;
    }
    for (;;) {
        const bool has_next = S.next(ui + 1, nxt);
        nA = has_next ? (const char*)g.A + (size_t)nxt.pm * tstep : cA; const char* nB = has_next ? (const char*)g.Bt + (size_t)nxt.pn * tstep : cB;
        if constexpr (Sched::GATHER) { if (has_next) S.gather(nxt, tid, ngo, ui + 1); else { ngo[0][0] = cgo[0][0]; ngo[0][1] = cgo[0][1]; ngo[1][0] = cgo[1][0]; ngo[1][1] = cgo[1][1]; } }
        for (int t = 0; t < nt; t += 2) {
            const bool last = (t == nt - 2);
            const size_t k1 = (size_t)(t + 1) * kstep, k2 = last ? 0 : (size_t)(t + 2) * kstep, k3 = k2 + kstep;
            const char* b2 = last ? nB : cB + (size_t)(t + 2) * kstep; const char* b3 = b2 + kstep;
            if (last && has_next) S.a_ready(nxt);
            if constexpr (SP2) {
            const int rx = __builtin_amdgcn_readfirstlane(((Epi::NVM > 0) && (t == 0) && (ui > 0)) ? 1 : 0);
            PG8_LDB(B0, 0, 0); PG8_LDB(B1, 0, 1); PG8_SCHED; PG8_LDA(At, 0, 0); PG8_STAGE_A(PG8_SA(1, 1), k1, 1, false);
            PG8_WAIT_V8X(rx); PG8_WAIT_L(0); PG8_BAR; PG8_MMA(0, 0, At, B0); PG8_MMA(0, 1, At, B1); PG8_BAR; PG8_SCHED;
            PG8_LDA(At, 0, 1); PG8_STAGE(PG8_SB(0, 0), b2, voffB); PG8_STAGE(PG8_SB(0, 1), b2 + hstep, voffB); PG8_STAGE_A(PG8_SA(0, 0), k2, 0, last);
            PG8_WAIT_V8X(rx); PG8_WAIT_L(0); PG8_BAR; PG8_MMA(1, 0, At, B0); PG8_MMA(1, 1, At, B1); PG8_BAR; PG8_SCHED;
            PG8_LDB(B0, 1, 0); PG8_LDB(B1, 1, 1); PG8_SCHED; PG8_LDA(At, 1, 0); PG8_STAGE_A(PG8_SA(0, 1), k2, 1, last);
            PG8_WAIT_V(8); PG8_WAIT_L(0); PG8_BAR; PG8_MMA(0, 0, At, B0); PG8_MMA(0, 1, At, B1); PG8_BAR; PG8_SCHED;
            PG8_LDA(At, 1, 1); PG8_STAGE(PG8_SB(1, 0), b3, voffB); PG8_STAGE(PG8_SB(1, 1), b3 + hstep, voffB); PG8_STAGE_A(PG8_SA(1, 0), k3, 0, last);
            PG8_WAIT_V(8); PG8_WAIT_L(0); PG8_BAR; PG8_MMA(1, 0, At, B0); PG8_MMA(1, 1, At, B1); PG8_BAR; PG8_SCHED;
            } else {
            PG8_LDB(B0, 0, 0); PG8_SCHED; PG8_LDA(At, 0, 0); PG8_STAGE_A(PG8_SA(1, 1), k1, 1, false);
            PG8_WAIT_L(8); PG8_BAR; PG8_WAIT_L(0); PG8_MMA(0, 0, At, B0); PG8_BAR; PG8_SCHED;
            PG8_LDB(B1, 0, 1); PG8_STAGE(PG8_SB(0, 0), b2, voffB);
            PG8_BAR; PG8_WAIT_L(0); PG8_MMA(0, 1, At, B1); PG8_BAR;
            PG8_LDA(At, 0, 1); PG8_STAGE_A(PG8_SA(0, 0), k2, 0, last);
            PG8_BAR; PG8_WAIT_L(0); PG8_MMA(1, 0, At, B0); PG8_BAR; PG8_SCHED;
            PG8_STAGE(PG8_SB(0, 1), b2 + hstep, voffB);
            PG8_WAIT_V(6); PG8_BAR; PG8_MMA(1, 1, At, B1); PG8_BAR;
            PG8_LDB(B0, 1, 0); PG8_SCHED; PG8_LDA(At, 1, 0); PG8_STAGE_A(PG8_SA(0, 1), k2, 1, last);
            PG8_WAIT_L(8); PG8_BAR; PG8_WAIT_L(0); PG8_MMA(0, 0, At, B0); PG8_BAR; PG8_SCHED;
            PG8_LDB(B1, 1, 1); PG8_STAGE(PG8_SB(1, 0), b3, voffB);
            PG8_BAR; PG8_WAIT_L(0); PG8_MMA(0, 1, At, B1); PG8_BAR;
            PG8_LDA(At, 1, 1); PG8_STAGE_A(PG8_SA(1, 0), k3, 0, last);
            PG8_BAR; PG8_WAIT_L(0); PG8_MMA(1, 0, At, B0); PG8_BAR; PG8_SCHED;
            PG8_STAGE(PG8_SB(1, 1), b3 + hstep, voffB);
            PG8_WAIT_V(6); PG8_BAR; PG8_MMA(1, 1, At, B1); PG8_BAR;
            }
        }
        if constexpr (ALIGN_EPI) { if (wr == 0) PG8_BAR; }
        if constexpr (!Epi::AFTER_DRAIN) { E(acc, cur, wr, wc, fr, fq); S.done(cur); }
        if (!has_next) break;
#pragma unroll
        for (int a = 0; a < 2; ++a)
#pragma unroll
            for (int b = 0; b < 2; ++b)
#pragma unroll
                for (int m = 0; m < 4; ++m)
#pragma unroll
                    for (int n = 0; n < 2; ++n) acc[a][b][m][n] = (f32x4){0.f, 0.f, 0.f, 0.f};
        cur = nxt; cA = nA; cB = nB; ++ui;
        if constexpr (Sched::GATHER) { cgo[0][0] = ngo[0][0]; cgo[0][1] = ngo[0][1]; cgo[1][0] = ngo[1][0]; cgo[1][1] = ngo[1][1]; }
        if constexpr (ALIGN_EPI) { if (wr == 1) PG8_BAR; }
    }
    PG8_WAIT_V(0);
    if constexpr (!ALIGN_EPI) { if (wr == 0) PG8_BAR; }
    PG8_BAR;
    if constexpr (Epi::AFTER_DRAIN) { E.fused(acc, cur, wr, wc, fr, fq, lds, wid, lane); S.done(cur); }
#undef PG8_SA
#undef PG8_SB
#undef PG8_STAGE
#undef PG8_STAGE_A
#undef PG8_LDA
#undef PG8_LDB
#undef PG8_MMA
#undef PG8_WAIT_V
#undef PG8_WAIT_L
#undef PG8_BAR
#undef PG8_SCHED
}
}

struct EpiInProj {
    static constexpr bool PERM = false, AFTER_DRAIN = false; static constexpr int NVM = 16;
    bf16_t* proj; const float* rope; const float* qn; const float* kn;
    __device__ __forceinline__ void operator()(const f32x4 (&acc)[2][2][4][2], const pg8::Unit& u, int wr, int wc, int fr, int fq) const {
        const int tile = u.pn;
        const bool attn_half = (tile == 0) || (tile == 2) || ((tile == 1 || tile == 3) && wc < 2);
        const bool is_rope = attn_half, is_norm = attn_half && tile >= 2, is_q = (tile == 0) || (tile == 2), is_silu = (tile == 4) || (tile == 5);
        const float* nw = (tile == 3) ? kn : qn;
        f32x4 nwv[2][2];
#pragma unroll
        for (int bj = 0; bj < 2; ++bj)
#pragma unroll
            for (int n = 0; n < 2; ++n) nwv[bj][n] = *(const f32x4*)(nw + 32 * bj + 16 * n + 4 * fq);
        SCHED_FENCE();
#pragma unroll
        for (int ai = 0; ai < 2; ++ai)
#pragma unroll
            for (int m = 0; m < 4; ++m) {
                const int r = u.pm * 256 + ai * 128 + wr * 64 + m * 16 + fr;
                const int b = r / TPB, pp = r - b * TPB;
                const bool latent = pp >= CTX_;
                const int nn = pp - CTX_, prow = nn >> 6, pcol = nn & 63;
                f32x4 v[2][2];
#pragma unroll
                for (int bj = 0; bj < 2; ++bj)
#pragma unroll
                    for (int n = 0; n < 2; ++n) v[bj][n] = acc[ai][bj][m][n];
                if (is_norm) {
                    float ss = 0.f;
#pragma unroll
                    for (int bj = 0; bj < 2; ++bj)
#pragma unroll
                        for (int n = 0; n < 2; ++n) ss += (v[bj][n].x * v[bj][n].x + v[bj][n].y * v[bj][n].y) + (v[bj][n].z * v[bj][n].z + v[bj][n].w * v[bj][n].w);
                    ss = xadd32(xadd16(ss));
                    const float rs = rsqrtf(ss * (1.0f / 64.0f) + EPS_);
#pragma unroll
                    for (int bj = 0; bj < 2; ++bj)
#pragma unroll
                        for (int n = 0; n < 2; ++n) { const f32x4 wv = nwv[bj][n]; v[bj][n].x *= rs * wv.x; v[bj][n].y *= rs * wv.y; v[bj][n].z *= rs * wv.z; v[bj][n].w *= rs * wv.w; }
                }
                if (is_rope && latent) {
#pragma unroll
                    for (int bj = 0; bj < 2; ++bj) {
                        const int pos = bj == 0 ? prow : pcol;
                        const f32x4 c0 = *(const f32x4*)(rope + (pos * 16 + 4 * fq) * 2), c1 = *(const f32x4*)(rope + (pos * 16 + 4 * fq) * 2 + 4);
                        const f32x4 a = v[bj][0], bq = v[bj][1]; f32x4 o0, o1;
                        o0.x = a.x * c0.x - bq.x * c0.y; o1.x = bq.x * c0.x + a.x * c0.y;
                        o0.y = a.y * c0.z - bq.y * c0.w; o1.y = bq.y * c0.z + a.y * c0.w;
                        o0.z = a.z * c1.x - bq.z * c1.y; o1.z = bq.z * c1.x + a.z * c1.y;
                        o0.w = a.w * c1.z - bq.w * c1.w; o1.w = bq.w * c1.z + a.w * c1.w;
                        v[bj][0] = o0; v[bj][1] = o1;
                    }
                }
                if (is_q) {
#pragma unroll
                    for (int bj = 0; bj < 2; ++bj)
#pragma unroll
                        for (int n = 0; n < 2; ++n) v[bj][n] = v[bj][n] * (0.125f * 1.4426950408889634f);
                }
                if (is_silu) {
#pragma unroll
                    for (int bj = 0; bj < 2; ++bj)
#pragma unroll
                        for (int n = 0; n < 2; ++n) { v[bj][n].x = v[bj][n].x * sigmoidf_(v[bj][n].x); v[bj][n].y = v[bj][n].y * sigmoidf_(v[bj][n].y); v[bj][n].z = v[bj][n].z * sigmoidf_(v[bj][n].z); v[bj][n].w = v[bj][n].w * sigmoidf_(v[bj][n].w); }
                }
                bf16_t* dst = proj + (size_t)r * INW + tile * 256 + wc * 64 + ((fq & 1) ? 16 + 4 * (fq - 1) : 4 * fq);
#pragma unroll
                for (int bj = 0; bj < 2; ++bj) {
                    const unsigned a0 = pack2(v[bj][0].x, v[bj][0].y), a1 = pack2(v[bj][0].z, v[bj][0].w), b0 = pack2(v[bj][1].x, v[bj][1].y), b1 = pack2(v[bj][1].z, v[bj][1].w);
                    const auto s0 = __builtin_amdgcn_permlane16_swap(a0, b0, false, false), s1 = __builtin_amdgcn_permlane16_swap(a1, b1, false, false);
                    u32x4 o; o.x = s0[0]; o.y = s1[0]; o.z = s0[1]; o.w = s1[1];
                    *(u32x4*)(dst + 32 * bj) = o;
                }
            }
    }
};
__device__ __forceinline__ void phase_inproj(PRef p, int layer, unsigned char* lds) {
    pg8::Gemm g{(const bf16_t*)(p.ws + OFF_HB), (const bf16_t*)(p.ws + OFF_WIN) + (size_t)layer * INW * D_, D_};
    pg8::DenseSched S; S.init(R_ / 256, INW / 256, get_nblk(), get_bid());
    {
        const int tid = get_tid();
        *(u32x4*)(lds + LDS_ROPE + tid * 16) = *(const u32x4*)(p.ws + OFF_ROPE + tid * 16);
        __syncthreads();
    }
    EpiInProj E{(bf16_t*)(p.ws + OFF_PROJ), (const float*)(lds + LDS_ROPE), p.q_norm_w + layer * 64, p.k_norm_w + layer * 64};
    pg8::gemm_phase<EpiInProj, pg8::DenseSched, true, true>((PG8_LAS unsigned char*)lds, g, S, E);
    if (get_nblk() == 256 && get_bid() >= 184) {
        const int base = (layer == 1 ? CV_OUTTAIL : 0) + (get_bid() - 184);
        for (int k = 0; k < CV_TAILN; ++k) moe_conv_item(p, layer, base + k * 72, lds);
    }
}

__device__ __forceinline__ void cvt8(const u32x4 w, float* d) {
    d[0] = bflo(w.x); d[1] = bfhi(w.x); d[2] = bflo(w.y); d[3] = bfhi(w.y); d[4] = bflo(w.z); d[5] = bfhi(w.z); d[6] = bflo(w.w); d[7] = bfhi(w.w);
}

__device__ __forceinline__ int chain_pos(int dir, int cc, int j) { return dir == 0 ? cc * 64 + j : (cc < 4 ? (3 - cc) * 64 + 63 - j : TPB - 1 - ((cc - 4) * 64 + j)); }

constexpr int HB_LD = 132, HQ_LD = 136, HV_LD = 72;
constexpr int H_OFF_B = 0, H_OFF_Q = 64 * HB_LD * 4, H_OFF_KK = H_OFF_Q + 64 * HQ_LD * 2, H_OFF_VT = H_OFF_KK + 64 * HQ_LD * 2, H_OFF_KHT = H_OFF_VT + 128 * HV_LD * 2,
              H_OFF_TOT = H_OFF_KHT + 128 * HV_LD * 2, H_LDS = H_OFF_TOT + 4 * 128 * 4;
static_assert(H_LDS <= LDS_BYTES, "hgrn lds");
__device__ __forceinline__ void cvt8f(const f32x4 a, const f32x4 b, float* d) { d[0] = a.x; d[1] = a.y; d[2] = a.z; d[3] = a.w; d[4] = b.x; d[5] = b.y; d[6] = b.z; d[7] = b.w; }
__device__ __forceinline__ bf16x8 pack8(const float* v) { u32x4 w; w.x = pack2(v[0], v[1]); w.y = pack2(v[2], v[3]); w.z = pack2(v[4], v[5]); w.w = pack2(v[6], v[7]); return __builtin_bit_cast(bf16x8, w); }

struct HgLoads { u32x4 z0, z1, q0, q1, v0, v1; f32x4 lb4[4]; };
__device__ __forceinline__ void hgrn_issue_loads(PRef p, int layer, int item, HgLoads& L) {
    const int cc = item % 68, chain = item / 68, dir = chain & 1, h = (chain >> 1) & 3, b = chain >> 3;
    const int tid = get_tid(), lane = tid & 63, wave = tid >> 6;
    const bf16_t* proj = (const bf16_t*)(p.ws + OFF_PROJ);
    const float* lbt = (const float*)(p.ws + OFF_LB) + dir * 512 + h * 128;
    const int j = tid >> 3, kb = (tid & 7) * 16;
    const bf16_t* row = proj + (size_t)(b * TPB + chain_pos(dir, cc, j)) * INW;
    const bf16_t* vrow = proj + (size_t)(b * TPB + chain_pos(dir, cc, lane)) * INW + 2560 + h * 128 + wave * 16;
    L.z0 = *(const u32x4*)(row + (dir == 0 ? 1536 : 2048) + h * 128 + kb); L.z1 = *(const u32x4*)(row + (dir == 0 ? 1536 : 2048) + h * 128 + kb + 8);
    L.q0 = *(const u32x4*)(row + 1024 + h * 128 + kb); L.q1 = *(const u32x4*)(row + 1024 + h * 128 + kb + 8);
    L.v0 = *(const u32x4*)vrow; L.v1 = *(const u32x4*)(vrow + 8);
#pragma unroll
    for (int e = 0; e < 4; ++e) L.lb4[e] = layer == 1 ? *(const f32x4*)(lbt + kb + 4 * e) : (f32x4){0.f, 0.f, 0.f, 0.f};
}
__device__ __forceinline__ void hgrn_load_scan(const HgLoads& L, unsigned char* lds) {
    const int tid = get_tid(), lane = tid & 63, wave = tid >> 6;
    float* Bc = (float*)(lds + H_OFF_B); bf16_t* Qs = (bf16_t*)(lds + H_OFF_Q); bf16_t* KKs = (bf16_t*)(lds + H_OFF_KK); bf16_t* VT = (bf16_t*)(lds + H_OFF_VT); float* Tot = (float*)(lds + H_OFF_TOT);
    {
        const int j = tid >> 3, kb = (tid & 7) * 16;
        const u32x4 z0 = L.z0, z1 = L.z1, q0 = L.q0, q1 = L.q1, v0 = L.v0, v1 = L.v1;
        float z[16], g[16], kk[16]; cvt8(z0, z); cvt8(z1, z + 8);
#pragma unroll
        for (int e = 0; e < 16; ++e) {
            const float lb = L.lb4[e >> 2][e & 3];
            const float sg = sigmoidf_(z[e]); const float f = lb + (1.f - lb) * sg;
            g[e] = __logf(fmaxf(f, 1e-30f)); kk[e] = (1.f - lb) * (1.f - sg);
        }
#pragma unroll
        for (int e = 0; e < 16; e += 4) *(f32x4*)(Bc + j * HB_LD + kb + e) = (f32x4){g[e], g[e + 1], g[e + 2], g[e + 3]};
        *(bf16x8*)(KKs + j * HQ_LD + kb) = pack8(kk); *(bf16x8*)(KKs + j * HQ_LD + kb + 8) = pack8(kk + 8);
        *(u32x4*)(Qs + j * HQ_LD + kb) = q0; *(u32x4*)(Qs + j * HQ_LD + kb + 8) = q1;
        bf16_t* d = VT + (wave * 16) * HV_LD + lane;
        d[0 * HV_LD] = (bf16_t)(v0.x & 0xffffu); d[1 * HV_LD] = (bf16_t)(v0.x >> 16); d[2 * HV_LD] = (bf16_t)(v0.y & 0xffffu); d[3 * HV_LD] = (bf16_t)(v0.y >> 16);
        d[4 * HV_LD] = (bf16_t)(v0.z & 0xffffu); d[5 * HV_LD] = (bf16_t)(v0.z >> 16); d[6 * HV_LD] = (bf16_t)(v0.w & 0xffffu); d[7 * HV_LD] = (bf16_t)(v0.w >> 16);
        d[8 * HV_LD] = (bf16_t)(v1.x & 0xffffu); d[9 * HV_LD] = (bf16_t)(v1.x >> 16); d[10 * HV_LD] = (bf16_t)(v1.y & 0xffffu); d[11 * HV_LD] = (bf16_t)(v1.y >> 16);
        d[12 * HV_LD] = (bf16_t)(v1.z & 0xffffu); d[13 * HV_LD] = (bf16_t)(v1.z >> 16); d[14 * HV_LD] = (bf16_t)(v1.w & 0xffffu); d[15 * HV_LD] = (bf16_t)(v1.w >> 16);
    }
    __syncthreads();
    const int k = tid & 127, seg = tid >> 7;
    float sc[16];
#pragma unroll
    for (int jj = 0; jj < 16; ++jj) sc[jj] = Bc[(seg * 16 + jj) * HB_LD + k];
    SCHED_FENCE();
#pragma unroll
    for (int jj = 1; jj < 16; ++jj) sc[jj] += sc[jj - 1];
    Tot[seg * 128 + k] = sc[15];
    __syncthreads();
    {
        const float t0 = Tot[k], t1 = Tot[128 + k], t2 = Tot[256 + k];
        const float off = seg == 0 ? 0.f : (seg == 1 ? t0 : (seg == 2 ? t0 + t1 : t0 + t1 + t2));
#pragma unroll
        for (int jj = 0; jj < 16; ++jj) Bc[(seg * 16 + jj) * HB_LD + k] = sc[jj] + off;
    }
    __syncthreads();
}

constexpr int H_OFF_PM = H_LDS, HP_LD = 72, H_LDS2 = H_OFF_PM + 64 * HP_LD * 2;
static_assert(H_LDS2 <= LDS_BYTES - 16, "hgrn lds");
__device__ __forceinline__ void hgrn_local_item(PRef p, int layer, int item, unsigned char* lds, const HgLoads& L) {
    const int cc = item % 68, chain = item / 68, dir = chain & 1, h = (chain >> 1) & 3, b = chain >> 3;
    hgrn_load_scan(L, lds);
    const int tid = get_tid(), lane = tid & 63, wave = tid >> 6, fr = lane & 15, fq = lane >> 4;
    const float* Bc = (const float*)(lds + H_OFF_B); const bf16_t* Qs = (const bf16_t*)(lds + H_OFF_Q); const bf16_t* KKs = (const bf16_t*)(lds + H_OFF_KK); const bf16_t* VT = (const bf16_t*)(lds + H_OFF_VT);
    bf16_t* KHT = (bf16_t*)(lds + H_OFF_KHT); bf16_t* Pm = (bf16_t*)(lds + H_OFF_PM);
    {
        const int j = lane, kc = wave * 16;
        float bj[16], be[16], kk[16];
        cvt8f(*(const f32x4*)(Bc + j * HB_LD + kc), *(const f32x4*)(Bc + j * HB_LD + kc + 4), bj); cvt8f(*(const f32x4*)(Bc + j * HB_LD + kc + 8), *(const f32x4*)(Bc + j * HB_LD + kc + 12), bj + 8);
        cvt8f(*(const f32x4*)(Bc + 63 * HB_LD + kc), *(const f32x4*)(Bc + 63 * HB_LD + kc + 4), be); cvt8f(*(const f32x4*)(Bc + 63 * HB_LD + kc + 8), *(const f32x4*)(Bc + 63 * HB_LD + kc + 12), be + 8);
        cvt8(*(const u32x4*)(KKs + j * HQ_LD + kc), kk); cvt8(*(const u32x4*)(KKs + j * HQ_LD + kc + 8), kk + 8);
#pragma unroll
        for (int e = 0; e < 16; ++e) KHT[(kc + e) * HV_LD + j] = (bf16_t)f2bf(kk[e] * __expf(be[e] - bj[e]));
    }
    if (tid < 128) ((float*)(p.ws + OFF_DEC))[(size_t)item * 128 + tid] = __expf(Bc[63 * HB_LD + tid]);
    {
        const int j = tid >> 3, kb = (tid & 7) * 16;
        float bt[16], q8[16], x[16];
        cvt8f(*(const f32x4*)(Bc + j * HB_LD + kb), *(const f32x4*)(Bc + j * HB_LD + kb + 4), bt); cvt8f(*(const f32x4*)(Bc + j * HB_LD + kb + 8), *(const f32x4*)(Bc + j * HB_LD + kb + 12), bt + 8);
        cvt8(*(const u32x4*)(Qs + j * HQ_LD + kb), q8); cvt8(*(const u32x4*)(Qs + j * HQ_LD + kb + 8), q8 + 8);
#pragma unroll
        for (int e = 0; e < 16; ++e) x[e] = q8[e] * __expf(bt[e]);
        bf16_t* qh = (bf16_t*)(p.ws + OFF_QH) + ((size_t)item * 64 + j) * 128 + kb;
        *(bf16x8*)qh = pack8(x); *(bf16x8*)(qh + 8) = pack8(x + 8);
        for (int i = tid; i < 64 * HP_LD * 2 / 16; i += NT) *(u32x4*)((unsigned char*)Pm + i * 16) = (u32x4){0u, 0u, 0u, 0u};
    }
    __syncthreads();
    {
        bf16x8 bfr[2];
#pragma unroll
        for (int ks = 0; ks < 2; ++ks) bfr[ks] = *(const bf16x8*)(VT + (16 * wave + fr) * HV_LD + ks * 32 + fq * 8);
        bf16_t* lt = (bf16_t*)(p.ws + OFF_LT) + ((size_t)item * 128 + 16 * wave + fr) * 128 + ((fq & 1) ? 16 + 4 * (fq - 1) : 4 * fq);
        bf16x8 afr[8][2];
#pragma unroll
        for (int a = 0; a < 8; ++a)
#pragma unroll
            for (int ks = 0; ks < 2; ++ks) afr[a][ks] = *(const bf16x8*)(KHT + (16 * a + fr) * HV_LD + ks * 32 + fq * 8);
        SCHED_FENCE();
#pragma unroll
        for (int a = 0; a < 8; a += 2) {
            f32x4 acc = __builtin_amdgcn_mfma_f32_16x16x32_bf16(afr[a][0], bfr[0], (f32x4){0.f, 0.f, 0.f, 0.f}, 0, 0, 0);
            acc = __builtin_amdgcn_mfma_f32_16x16x32_bf16(afr[a][1], bfr[1], acc, 0, 0, 0);
            f32x4 acd = __builtin_amdgcn_mfma_f32_16x16x32_bf16(afr[a + 1][0], bfr[0], (f32x4){0.f, 0.f, 0.f, 0.f}, 0, 0, 0);
            acd = __builtin_amdgcn_mfma_f32_16x16x32_bf16(afr[a + 1][1], bfr[1], acd, 0, 0, 0);
            const auto s0 = __builtin_amdgcn_permlane16_swap(pack2(acc.x, acc.y), pack2(acd.x, acd.y), false, false), s1 = __builtin_amdgcn_permlane16_swap(pack2(acc.z, acc.w), pack2(acd.z, acd.w), false, false);
            u32x4 o; o.x = s0[0]; o.y = s1[0]; o.z = s0[1]; o.w = s1[1];
            *(u32x4*)(lt + 16 * a) = o;
        }
    }
    for (int pi = wave; pi < 10; pi += 8) {
        const int I = pi >= 6 ? 3 : (pi >= 3 ? 2 : (pi >= 1 ? 1 : 0)), J = pi - (I * (I + 1)) / 2;
        const int rrow = (J < I) ? 16 * J + 15 : 16 * I + 7;
        const int s = 16 * J + fr, t = 16 * I + fr;
        f32x4 pacc = (f32x4){0.f, 0.f, 0.f, 0.f};
#pragma unroll
        for (int k2 = 0; k2 < 4; k2 += 2) {
            f32x4 rr[2][2], sb[2][2], tb[2][2]; u32x4 kw[2], qw[2];
#pragma unroll
            for (int d = 0; d < 2; ++d) {
                const int ko = (k2 + d) * 32 + 8 * fq;
                rr[d][0] = *(const f32x4*)(Bc + rrow * HB_LD + ko); rr[d][1] = *(const f32x4*)(Bc + rrow * HB_LD + ko + 4);
                sb[d][0] = *(const f32x4*)(Bc + s * HB_LD + ko); sb[d][1] = *(const f32x4*)(Bc + s * HB_LD + ko + 4);
                tb[d][0] = *(const f32x4*)(Bc + t * HB_LD + ko); tb[d][1] = *(const f32x4*)(Bc + t * HB_LD + ko + 4);
                kw[d] = *(const u32x4*)(KKs + s * HQ_LD + ko); qw[d] = *(const u32x4*)(Qs + t * HQ_LD + ko);
            }
            SCHED_FENCE();
#pragma unroll
            for (int d = 0; d < 2; ++d) {
                float r8[8], bs[8], bt[8], kk[8], q8[8], xk[8], xq[8];
                cvt8f(rr[d][0], rr[d][1], r8); cvt8f(sb[d][0], sb[d][1], bs); cvt8f(tb[d][0], tb[d][1], bt); cvt8(kw[d], kk); cvt8(qw[d], q8);
#pragma unroll
                for (int e = 0; e < 8; ++e) { xk[e] = kk[e] * __expf(fminf(r8[e] - bs[e], 80.f)); xq[e] = q8[e] * __expf(fminf(bt[e] - r8[e], 80.f)); }
                pacc = __builtin_amdgcn_mfma_f32_16x16x32_bf16(pack8(xk), pack8(xq), pacc, 0, 0, 0);
            }
        }
        if (J == I) {
            if (4 * fq + 0 > fr) pacc.x = 0.f;
            if (4 * fq + 1 > fr) pacc.y = 0.f;
            if (4 * fq + 2 > fr) pacc.z = 0.f;
            if (4 * fq + 3 > fr) pacc.w = 0.f;
        }
        u32x2 o; o.x = pack2(pacc.x, pacc.y); o.y = pack2(pacc.z, pacc.w);
        *(u32x2*)(Pm + t * HP_LD + 16 * J + 4 * fq) = o;
    }
    __syncthreads();
    {
        bf16_t* obuf = (bf16_t*)(p.ws + (dir == 0 ? OFF_OF : OFF_OB));
        bf16x8 vf[2], pfr[4][2];
#pragma unroll
        for (int ks = 0; ks < 2; ++ks) vf[ks] = *(const bf16x8*)(VT + (16 * wave + fr) * HV_LD + ks * 32 + fq * 8);
#pragma unroll
        for (int I = 0; I < 4; ++I)
#pragma unroll
            for (int ks = 0; ks < 2; ++ks) pfr[I][ks] = *(const bf16x8*)(Pm + (16 * I + fr) * HP_LD + ks * 32 + fq * 8);
        SCHED_FENCE();
#pragma unroll
        for (int I = 0; I < 4; ++I) {
            f32x4 acc = __builtin_amdgcn_mfma_f32_16x16x32_bf16(vf[0], pfr[I][0], (f32x4){0.f, 0.f, 0.f, 0.f}, 0, 0, 0);
            if (I >= 2) acc = __builtin_amdgcn_mfma_f32_16x16x32_bf16(vf[1], pfr[I][1], acc, 0, 0, 0);
            u32x2 o; o.x = pack2(acc.x, acc.y); o.y = pack2(acc.z, acc.w);
            *(u32x2*)(obuf + (size_t)(b * TPB + chain_pos(dir, cc, 16 * I + fr)) * 512 + h * 128 + 16 * wave + 4 * fq) = o;
        }
    }
    __syncthreads();
}

__device__ __forceinline__ void phase_hgrn_c2(PRef p) {
    const int tid = get_tid();
    const bf16_t* LT = (const bf16_t*)(p.ws + OFF_LT); bf16_t* SB = (bf16_t*)(p.ws + OFF_SB); const float* DEC = (const float*)(p.ws + OFF_DEC);
    for (int e = get_bid() * NT + tid; e < 32 * 128 * 32; e += get_nblk() * NT) {
        const int chain = e >> 12, rem = e & 4095, v = rem >> 5, k4 = (rem & 31) * 4;
        float s0 = 0.f, s1 = 0.f, s2 = 0.f, s3 = 0.f;
        const size_t base = (size_t)chain * 68 * 16384 + v * 128 + k4;
        const float* dbase = DEC + (size_t)chain * 68 * 128 + k4;
#define C2_GROUP(C0_, N_) do { u32x2 l[N_]; f32x4 d[N_]; \
            _Pragma("unroll") for (int q = 0; q < (N_); ++q) { l[q] = *(const u32x2*)(LT + base + (size_t)((C0_) + q) * 16384); d[q] = *(const f32x4*)(dbase + (size_t)((C0_) + q) * 128); } \
            SCHED_FENCE(); \
            _Pragma("unroll") for (int q = 0; q < (N_); ++q) { u32x2 o; o.x = pack2(s0, s1); o.y = pack2(s2, s3); *(u32x2*)(SB + base + (size_t)((C0_) + q) * 16384) = o; \
                s0 = d[q].x * s0 + bflo(l[q].x); s1 = d[q].y * s1 + bfhi(l[q].x); s2 = d[q].z * s2 + bflo(l[q].y); s3 = d[q].w * s3 + bfhi(l[q].y); } } while (0)
#pragma unroll 1
        for (int c0 = 0; c0 < 64; c0 += 8) C2_GROUP(c0, 8);
        C2_GROUP(64, 4);
#undef C2_GROUP
    }
}

constexpr int IN_LD = 144;
constexpr int IN_S_BYTES = 128 * IN_LD * 2, IN_Q_BYTES = 64 * IN_LD * 2;
constexpr int IN_OFF_S = 0, IN_OFF_Q = 2 * IN_S_BYTES, IN_OFF_SS = IN_OFF_Q + 2 * IN_Q_BYTES, IN_LDS = IN_OFF_SS + 8 * 64 * 4;
static_assert(IN_LDS <= LDS_BYTES - 16, "inter lds");
struct InRegs { u32x4 s[2][4]; u32x4 q[2][2]; };
__device__ __forceinline__ void inter_ids(int layer, int idx, int& b, int& h, int& tc) { const int ntc = layer == 1 ? 64 : 68; const int bh = idx / ntc; tc = (layer == 1 ? 4 : 0) + (idx - bh * ntc); h = bh & 3; b = bh >> 2; }
__device__ __forceinline__ void inter_load(PRef p, int layer, int idx, int tid, InRegs& R) {
    int b, h, tc; inter_ids(layer, idx, b, h, tc);
#pragma unroll
    for (int dir = 0; dir < 2; ++dir) {
        const int chain = (b * 4 + h) * 2 + dir, cc = dir == 0 ? tc : (tc < 4 ? 3 - tc : 71 - tc);
        const size_t it = (size_t)chain * 68 + cc;
        const bf16_t* sb = (const bf16_t*)(p.ws + OFF_SB) + it * 16384;
        const bf16_t* qh = (const bf16_t*)(p.ws + OFF_QH) + it * 8192;
#pragma unroll
        for (int i = 0; i < 4; ++i) R.s[dir][i] = *(const u32x4*)(sb + (size_t)(tid + NT * i) * 8);
#pragma unroll
        for (int i = 0; i < 2; ++i) R.q[dir][i] = *(const u32x4*)(qh + (size_t)(tid + NT * i) * 8);
    }
}
__device__ __forceinline__ void phase_hgrn_inter(PRef p, int layer, unsigned char* lds) {
    const int tid = get_tid(), lane = tid & 63, wave = tid >> 6, fr = lane & 15, fq = lane >> 4;
    const bf16_t* of = (const bf16_t*)(p.ws + OFF_OF); const bf16_t* ob = (const bf16_t*)(p.ws + OFF_OB);
    const bf16_t* proj = (const bf16_t*)(p.ws + OFF_PROJ); bf16_t* mix = (bf16_t*)(p.ws + OFF_MIX);
    float* ssum = (float*)(lds + IN_OFF_SS);
    const int nitems = 16 * (layer == 1 ? 64 : 68), nblk = get_nblk();
    int idx = get_bid();
    if (idx >= nitems) return;
    const f32x4 gw = *(const f32x4*)(p.gate_norm_w + layer * 128 + 16 * wave + 4 * fq);
    InRegs R; inter_load(p, layer, idx, tid, R);
    for (; idx < nitems; idx += nblk) {
        int b, h, tc; inter_ids(layer, idx, b, h, tc);
#pragma unroll
        for (int dir = 0; dir < 2; ++dir) {
#pragma unroll
            for (int i = 0; i < 4; ++i) { const int pc = tid + NT * i; *(u32x4*)(lds + IN_OFF_S + dir * IN_S_BYTES + ((pc >> 4) * IN_LD + (pc & 15) * 8) * 2) = R.s[dir][i]; }
#pragma unroll
            for (int i = 0; i < 2; ++i) { const int pc = tid + NT * i, j = pc >> 4, row = dir == 0 ? j : 63 - j; *(u32x4*)(lds + IN_OFF_Q + dir * IN_Q_BYTES + (row * IN_LD + (pc & 15) * 8) * 2) = R.q[dir][i]; }
        }
        __syncthreads();
        { const int nx = idx + nblk < nitems ? idx + nblk : idx; inter_load(p, layer, nx, tid, R); }
        const int vcol = h * 128 + 16 * wave + 4 * fq;
        u32x2 a0[4], a1[4]; u32x2 gwd[4];
#pragma unroll
        for (int tt = 0; tt < 4; ++tt) { const size_t r = (size_t)b * TPB + tc * 64 + tt * 16 + fr;
            a0[tt] = *(const u32x2*)(of + r * 512 + vcol); a1[tt] = *(const u32x2*)(ob + r * 512 + vcol); gwd[tt] = *(const u32x2*)(proj + r * INW + 3072 + vcol); }
        SCHED_FENCE();
        f32x4 acc[4];
#pragma unroll
        for (int tt = 0; tt < 4; ++tt) acc[tt] = (f32x4){0.f, 0.f, 0.f, 0.f};
#pragma unroll
        for (int dir = 0; dir < 2; ++dir) {
            bf16x8 af[4], bf[4][4];
            const unsigned char* sp = lds + IN_OFF_S + dir * IN_S_BYTES + ((16 * wave + fr) * IN_LD + 8 * fq) * 2;
            const unsigned char* qp = lds + IN_OFF_Q + dir * IN_Q_BYTES + (fr * IN_LD + 8 * fq) * 2;
#pragma unroll
            for (int ks = 0; ks < 4; ++ks) { af[ks] = *(const bf16x8*)(sp + ks * 64);
#pragma unroll
                for (int tt = 0; tt < 4; ++tt) bf[tt][ks] = *(const bf16x8*)(qp + (tt * 16 * IN_LD + ks * 32) * 2); }
            SCHED_FENCE();
#pragma unroll
            for (int ks = 0; ks < 4; ++ks)
#pragma unroll
                for (int tt = 0; tt < 4; ++tt) acc[tt] = __builtin_amdgcn_mfma_f32_16x16x32_bf16(af[ks], bf[tt][ks], acc[tt], 0, 0, 0);
        }
        float ss[4];
#pragma unroll
        for (int tt = 0; tt < 4; ++tt) {
            acc[tt] = acc[tt] + (f32x4){bflo(a0[tt].x), bfhi(a0[tt].x), bflo(a0[tt].y), bfhi(a0[tt].y)} + (f32x4){bflo(a1[tt].x), bfhi(a1[tt].x), bflo(a1[tt].y), bfhi(a1[tt].y)};
            float s = (acc[tt].x * acc[tt].x + acc[tt].y * acc[tt].y) + (acc[tt].z * acc[tt].z + acc[tt].w * acc[tt].w);
            ss[tt] = xadd32(xadd16(s));
        }
        if (fq == 0) {
#pragma unroll
            for (int tt = 0; tt < 4; ++tt) ssum[wave * 64 + tt * 16 + fr] = ss[tt];
        }
        __syncthreads();
#pragma unroll
        for (int tt = 0; tt < 4; ++tt) {
            const int tau = tt * 16 + fr; const size_t r = (size_t)b * TPB + tc * 64 + tau;
            float tot = 0.f;
#pragma unroll
            for (int w = 0; w < 8; ++w) tot += ssum[w * 64 + tau];
            const float rs = rsqrtf(tot * (1.0f / 128.0f) + EPS_);
            const float g0 = bflo(gwd[tt].x), g1 = bfhi(gwd[tt].x), g2 = bflo(gwd[tt].y), g3 = bfhi(gwd[tt].y);
            u32x2 o;
            o.x = pack2(acc[tt].x * rs * gw.x * (g0 * sigmoidf_(g0)), acc[tt].y * rs * gw.y * (g1 * sigmoidf_(g1)));
            o.y = pack2(acc[tt].z * rs * gw.z * (g2 * sigmoidf_(g2)), acc[tt].w * rs * gw.w * (g3 * sigmoidf_(g3)));
            *(u32x2*)(mix + r * D_ + 512 + vcol) = o;
        }
        __syncthreads();
    }
}

constexpr int AT_LDK = 80, AT_LDV = 136;
constexpr int AT_KBYTES = 128 * AT_LDK * 2, AT_VBYTES = 64 * AT_LDV * 2, AT_STAGE = AT_KBYTES + AT_VBYTES;
static_assert(2 * AT_STAGE <= LDS_BYTES - 16, "attention lds");
constexpr float LOG2E_ = 1.4426950408889634f;
struct AtRegs { u32x4 k0, k1, v0, v1; };
__device__ __forceinline__ float max3f(float a, float b, float c) { float r; asm("v_max3_f32 %0, %1, %2, %3" : "=v"(r) : "v"(a), "v"(b), "v"(c)); return r; }
__device__ __forceinline__ void at_tile(const unsigned char* Ks, const unsigned char* VT, const bf16x8 (&qf)[2][2], f32x4 (&oacc)[2][4], float (&m)[2], float (&l)[2],
                                        int fr, int fq, bool masked, int nq0, int nk0, bool first) {
    f32x4 sacc[2][2][4];
    {
        bf16x8 kf[2][4][2];
        const unsigned char* kp = Ks + (fr * AT_LDK + fq * 8) * 2;
#pragma unroll
        for (int h = 0; h < 2; ++h)
#pragma unroll
            for (int n = 0; n < 4; ++n)
#pragma unroll
                for (int ks = 0; ks < 2; ++ks) kf[h][n][ks] = *(const bf16x8*)(kp + ((h * 64 + n * 16) * AT_LDK + ks * 32) * 2);
        SCHED_FENCE();
#pragma unroll
        for (int h = 0; h < 2; ++h)
#pragma unroll
            for (int qt = 0; qt < 2; ++qt)
#pragma unroll
                for (int n = 0; n < 4; ++n) {
                    sacc[h][qt][n] = __builtin_amdgcn_mfma_f32_16x16x32_bf16(kf[h][n][0], qf[qt][0], (f32x4){-m[qt], -m[qt], -m[qt], -m[qt]}, 0, 0, 0);
                    sacc[h][qt][n] = __builtin_amdgcn_mfma_f32_16x16x32_bf16(kf[h][n][1], qf[qt][1], sacc[h][qt][n], 0, 0, 0);
                }
    }
    if (masked) {
#pragma unroll
        for (int h = 0; h < 2; ++h)
#pragma unroll
            for (int qt = 0; qt < 2; ++qt) {
                const int nq = nq0 + qt * 16;
#pragma unroll
                for (int n = 0; n < 4; ++n)
#pragma unroll
                    for (int i = 0; i < 4; ++i) { const int df = nq - (nk0 + h * 64 + n * 16 + i); if (df > 128 || df < -128) sacc[h][qt][n][i] = -1e30f; }
            }
    }
    float mx[2];
#pragma unroll
    for (int qt = 0; qt < 2; ++qt) {
        float t = max3f(sacc[0][qt][0].x, sacc[0][qt][0].y, sacc[0][qt][0].z);
#pragma unroll
        for (int h = 0; h < 2; ++h)
#pragma unroll
            for (int n = 0; n < 4; ++n) { if (h | n) t = max3f(t, sacc[h][qt][n].x, sacc[h][qt][n].y); t = max3f(t, sacc[h][qt][n].z, sacc[h][qt][n].w); }
        mx[qt] = t;
    }
    mx[0] = xmax32(xmax16(mx[0])); mx[1] = xmax32(xmax16(mx[1]));
    if (first || __any(fmaxf(mx[0], mx[1]) > 8.f)) {
#pragma unroll
        for (int qt = 0; qt < 2; ++qt) {
            const float dl = first ? fmaxf(mx[qt], -1e30f) : fmaxf(mx[qt], 0.f);
            const float corr = __builtin_amdgcn_exp2f(-dl);
            m[qt] += dl; l[qt] *= corr;
#pragma unroll
            for (int dt = 0; dt < 4; ++dt) oacc[qt][dt] = oacc[qt][dt] * corr;
#pragma unroll
            for (int h = 0; h < 2; ++h)
#pragma unroll
                for (int n = 0; n < 4; ++n) sacc[h][qt][n] = sacc[h][qt][n] - dl;
        }
    }
#pragma unroll
    for (int h = 0; h < 2; ++h) {
        u32x2 vlo[4][2], vhi[4][2];
        const unsigned char* vp = VT + (fr * AT_LDV + h * 64 + 4 * fq) * 2;
#pragma unroll
        for (int dt = 0; dt < 4; ++dt)
#pragma unroll
            for (int s = 0; s < 2; ++s) {
                vlo[dt][s] = *(const u32x2*)(vp + (dt * 16 * AT_LDV + s * 32) * 2);
                vhi[dt][s] = *(const u32x2*)(vp + (dt * 16 * AT_LDV + s * 32 + 16) * 2);
            }
        bf16x8 pf[2][2];
#pragma unroll
        for (int qt = 0; qt < 2; ++qt) {
            float ls = l[qt];
            float pe[4][4];
#pragma unroll
            for (int n = 0; n < 4; ++n) { pe[n][0] = __builtin_amdgcn_exp2f(sacc[h][qt][n].x); pe[n][1] = __builtin_amdgcn_exp2f(sacc[h][qt][n].y); pe[n][2] = __builtin_amdgcn_exp2f(sacc[h][qt][n].z); pe[n][3] = __builtin_amdgcn_exp2f(sacc[h][qt][n].w);
                                          ls += (pe[n][0] + pe[n][1]) + (pe[n][2] + pe[n][3]); }
            l[qt] = ls;
#pragma unroll
            for (int s = 0; s < 2; ++s) {
                u32x4 w; w.x = pack2(pe[2 * s][0], pe[2 * s][1]); w.y = pack2(pe[2 * s][2], pe[2 * s][3]); w.z = pack2(pe[2 * s + 1][0], pe[2 * s + 1][1]); w.w = pack2(pe[2 * s + 1][2], pe[2 * s + 1][3]);
                pf[qt][s] = __builtin_bit_cast(bf16x8, w);
            }
        }
#pragma unroll
        for (int dt = 0; dt < 4; ++dt)
#pragma unroll
            for (int s = 0; s < 2; ++s) {
                u32x4 w; w.x = vlo[dt][s].x; w.y = vlo[dt][s].y; w.z = vhi[dt][s].x; w.w = vhi[dt][s].y;
                const bf16x8 vf = __builtin_bit_cast(bf16x8, w);
#pragma unroll
                for (int qt = 0; qt < 2; ++qt) oacc[qt][dt] = __builtin_amdgcn_mfma_f32_16x16x32_bf16(vf, pf[qt][s], oacc[qt][dt], 0, 0, 0);
            }
    }
}
__device__ __forceinline__ void attn_mfma_item(PRef p, int layer, int item, unsigned char* lds) {
    const int tid = get_tid(), lane = tid & 63, wave = tid >> 6, fr = lane & 15, fq = lane >> 4;
    const int mixer = item / 272; int rem = item - mixer * 272; const int b = rem / 68; rem -= b * 68; const int kvh = rem / 34, qb = rem - kvh * 34;
    const int p0 = qb * 128; const bool ctxblk = p0 < CTX_;
    const int head = kvh * 2 + (wave >> 2);
    const int qrow0 = p0 + (wave & 3) * 32;
    const bf16_t* proj = (const bf16_t*)(p.ws + OFF_PROJ);
    bf16_t* mix = (bf16_t*)(p.ws + OFF_MIX);
    const int qcol = (mixer == 0 ? 0 : 512) + head * 64, kcol = (mixer == 0 ? 256 : 768) + kvh * 64, vcol = (mixer == 0 ? 384 : 896) + kvh * 64;
    bf16x8 qf[2][2];
#pragma unroll
    for (int qt = 0; qt < 2; ++qt)
#pragma unroll
        for (int ks = 0; ks < 2; ++ks) qf[qt][ks] = *(const bf16x8*)(proj + (size_t)(b * TPB + qrow0 + qt * 16 + fr) * INW + qcol + ks * 32 + fq * 8);
    f32x4 oacc[2][4];
#pragma unroll
    for (int qt = 0; qt < 2; ++qt)
#pragma unroll
        for (int dt = 0; dt < 4; ++dt) oacc[qt][dt] = (f32x4){0.f, 0.f, 0.f, 0.f};
    float m[2], l[2];
    if (mixer == 0) { const float sk = p.attn_sink[layer * 4 + head] * LOG2E_; m[0] = sk; m[1] = sk; l[0] = fq == 0 ? 1.f : 0.f; l[1] = l[0]; }
    else { m[0] = 0.f; m[1] = 0.f; l[0] = 0.f; l[1] = 0.f; }
    int tlo, thi;
    if (ctxblk) { tlo = 2; thi = 1; } else if (mixer == 1) { tlo = 2; thi = 33; } else { tlo = qb - 1 < 2 ? 2 : qb - 1; thi = qb + 1 > 33 ? 33 : qb + 1; }
    const int ntile = 2 + (thi - tlo + 1);
    const int srow = tid >> 3, sc8 = tid & 7;
    const bf16_t* kbase = proj + (size_t)(b * TPB + srow) * INW + kcol + sc8 * 8;
    const bf16_t* vbase = proj + (size_t)(b * TPB + lane) * INW + vcol + wave * 8;
    const int nq0 = qrow0 + fr - CTX_;
    const bool mixA = (mixer == 0);
#define AT_TID(ti_) ((ti_) < 2 ? (ti_) : tlo + (ti_) - 2)
#define AT_CL(ti_) ((ti_) < ntile ? (ti_) : ntile - 1)
#define AT_LOAD(R_, ti_) do { const size_t ro_ = (size_t)AT_TID(AT_CL(ti_)) * 128 * INW; R_.k0 = *(const u32x4*)(kbase + ro_); R_.k1 = *(const u32x4*)(kbase + ro_ + (size_t)64 * INW); \
                              R_.v0 = *(const u32x4*)(vbase + ro_); R_.v1 = *(const u32x4*)(vbase + ro_ + (size_t)64 * INW); } while (0)
#define AT_ST8(VT_, key_, w_) do { VT_[(wave * 8 + 0) * AT_LDV + (key_)] = (bf16_t)((w_).x & 0xffffu); VT_[(wave * 8 + 1) * AT_LDV + (key_)] = (bf16_t)((w_).x >> 16); \
        VT_[(wave * 8 + 2) * AT_LDV + (key_)] = (bf16_t)((w_).y & 0xffffu); VT_[(wave * 8 + 3) * AT_LDV + (key_)] = (bf16_t)((w_).y >> 16); \
        VT_[(wave * 8 + 4) * AT_LDV + (key_)] = (bf16_t)((w_).z & 0xffffu); VT_[(wave * 8 + 5) * AT_LDV + (key_)] = (bf16_t)((w_).z >> 16); \
        VT_[(wave * 8 + 6) * AT_LDV + (key_)] = (bf16_t)((w_).w & 0xffffu); VT_[(wave * 8 + 7) * AT_LDV + (key_)] = (bf16_t)((w_).w >> 16); } while (0)
#define AT_STORE(buf_, R_) do { unsigned char* Ks_ = lds + (buf_) * AT_STAGE; bf16_t* VT_ = (bf16_t*)(Ks_ + AT_KBYTES); \
        *(u32x4*)(Ks_ + (srow * AT_LDK + sc8 * 8) * 2) = R_.k0; *(u32x4*)(Ks_ + ((srow + 64) * AT_LDK + sc8 * 8) * 2) = R_.k1; \
        AT_ST8(VT_, lane, R_.v0); AT_ST8(VT_, lane + 64, R_.v1); } while (0)
    AtRegs RA, RB;
    AT_LOAD(RB, 0); AT_LOAD(RA, 1); SCHED_FENCE();
    asm volatile("" :: "v"(qf[0][0]), "v"(qf[0][1]), "v"(qf[1][0]), "v"(qf[1][1]));
    AT_STORE(0, RB);
    __syncthreads();
#pragma unroll 1
    for (int ti = 0; ti < ntile; ++ti) {
        const int t_ = AT_TID(ti); const bool mk_ = mixA && (t_ >= 2); const int nk_ = t_ * 128 + 4 * fq - CTX_;
        const int buf = ti & 1;
        AT_STORE(buf ^ 1, RA);
        AT_LOAD(RA, ti + 2); SCHED_FENCE();
        const unsigned char* Ks = lds + buf * AT_STAGE;
        at_tile(Ks, Ks + AT_KBYTES, qf, oacc, m, l, fr, fq, mk_, nq0, nk_, ti == 0);
        __syncthreads();
    }
#undef AT_TID
#undef AT_CL
#undef AT_LOAD
#undef AT_ST8
#undef AT_STORE
#pragma unroll
    for (int qt = 0; qt < 2; ++qt) {
        const float lt = xadd32(xadd16(l[qt]));
        const float inv = __builtin_amdgcn_rcpf(lt);
        bf16_t* dst = mix + (size_t)(b * TPB + qrow0 + qt * 16 + fr) * D_ + (mixer == 0 ? 0 : 256) + head * 64 + ((fq & 1) ? 16 + 4 * (fq - 1) : 4 * fq);
#pragma unroll
        for (int dt = 0; dt < 4; dt += 2) {
            const auto s0 = __builtin_amdgcn_permlane16_swap(pack2(oacc[qt][dt].x * inv, oacc[qt][dt].y * inv), pack2(oacc[qt][dt + 1].x * inv, oacc[qt][dt + 1].y * inv), false, false);
            const auto s1 = __builtin_amdgcn_permlane16_swap(pack2(oacc[qt][dt].z * inv, oacc[qt][dt].w * inv), pack2(oacc[qt][dt + 1].z * inv, oacc[qt][dt + 1].w * inv), false, false);
            u32x4 o; o.x = s0[0]; o.y = s1[0]; o.z = s0[1]; o.w = s1[1];
            *(u32x4*)(dst + dt * 16) = o;
        }
    }
}

__device__ __forceinline__ void phase_mixers(PRef p, int layer, unsigned char* lds) {
    constexpr int N_A = 544, N_C1 = 2176;
    const int nblk = get_nblk();
    int it = get_bid();
    int cidx = (nblk == 256 ? (layer == 1 ? CV_OUTTAIL + CV_INTAIL : CV_INTAIL) : 0) + get_bid();
    if (get_bid() & 1) { for (; cidx < N_MOECONV; cidx += nblk) moe_conv_item(p, layer, cidx, lds); }
    for (; it < N_A; it += nblk) {
        int a;
        if (it < 256) { const int g = it >> 5, qb = 2 + (it & 31); a = 272 + g * 34 + qb; }
        else if (it < 512) { const int j = it - 256, g = j >> 5, qb = 2 + (j & 31); a = g * 34 + qb; }
        else if (it < 528) { const int j = it - 512; a = 272 + (j >> 1) * 34 + (j & 1); }
        else { const int j = it - 528; a = (j >> 1) * 34 + (j & 1); }
        for (int rep = 0; rep < (((PROBE_MASK1 >> (it < 256 ? 13 : 15)) & 1) ? 2 : 1); ++rep) { attn_mfma_item(p, layer, a, lds); __syncthreads(); }
    }
    if (it < N_A + N_C1) {
        HgLoads cur; hgrn_issue_loads(p, layer, it - N_A, cur);
        for (; it < N_A + N_C1; it += nblk) {
            HgLoads nxt; const bool hn = it + nblk < N_A + N_C1;
            hgrn_issue_loads(p, layer, (hn ? it + nblk : it) - N_A, nxt);
            SCHED_FENCE();
            for (int rep = 0; rep < (((PROBE_MASK1 >> 14) & 1) ? 2 : 1); ++rep) hgrn_local_item(p, layer, it - N_A, lds, cur);
            cur = nxt;
            __syncthreads();
        }
    }
    for (; cidx < N_MOECONV; cidx += nblk) moe_conv_item(p, layer, cidx, lds);
}

struct EpiOutProj {
    static constexpr bool PERM = false, AFTER_DRAIN = false; static constexpr int NVM = 32;
    bf16_t* xs; const float* modl;
    __device__ __forceinline__ void operator()(const f32x4 (&acc)[2][2][4][2], const pg8::Unit& u, int wr, int wc, int fr, int fq) const {
        const int col0 = u.pn * 256 + wc * 64 + 16 * fq;
        const int r00 = u.pm * 256, b0 = r00 / TPB, pp0 = r00 - b0 * TPB;
        const float* g1 = modl + (size_t)(pp0 < CTX_ ? 4 : b0) * 6144 + 2048 + col0;
        f32x4 gv[4];
#pragma unroll
        for (int q = 0; q < 4; ++q) gv[q] = *(const f32x4*)(g1 + 4 * q);
#pragma unroll
        for (int ai = 0; ai < 2; ++ai) {
            u32x4 xw[4][2];
#pragma unroll
            for (int m = 0; m < 4; ++m) {
                const bf16_t* xp = xs + (size_t)(u.pm * 256 + ai * 128 + wr * 64 + m * 16 + fr) * D_ + col0;
                xw[m][0] = *(const u32x4*)xp; xw[m][1] = *(const u32x4*)(xp + 8);
            }
            SCHED_FENCE();
#pragma unroll
            for (int m = 0; m < 4; ++m) {
                bf16_t* xp = xs + (size_t)(u.pm * 256 + ai * 128 + wr * 64 + m * 16 + fr) * D_ + col0;
#pragma unroll
                for (int bj = 0; bj < 2; ++bj) {
                    const u32x4 w = xw[m][bj];
                    const f32x4 a0 = acc[ai][bj][m][0], a1 = acc[ai][bj][m][1], g0 = gv[2 * bj], g1v = gv[2 * bj + 1];
                    u32x4 o;
                    o.x = pack2(bflo(w.x) + g0.x * a0.x, bfhi(w.x) + g0.y * a0.y); o.y = pack2(bflo(w.y) + g0.z * a0.z, bfhi(w.y) + g0.w * a0.w);
                    o.z = pack2(bflo(w.z) + g1v.x * a1.x, bfhi(w.z) + g1v.y * a1.y); o.w = pack2(bflo(w.w) + g1v.z * a1.z, bfhi(w.w) + g1v.w * a1.w);
                    *(u32x4*)(xp + 8 * bj) = o;
                }
            }
            SCHED_FENCE();
        }
    }
};
struct OutProjSched : pg8::TileOrder {
    static constexpr bool GATHER = false;
    bool skipctx;
    __device__ __forceinline__ bool next(int i, pg8::Unit& u) const { int pm, pn; if (!map(i, pm, pn)) return false; u.pm = skipctx ? pm + (pm >> 4) + 1 : pm; u.pn = pn; u.aux = 0; return true; }
    __device__ __forceinline__ void a_ready(const pg8::Unit&) const {}
    __device__ __forceinline__ void done(const pg8::Unit&) const {}
};
__device__ __forceinline__ void phase_outproj(PRef p, int layer, unsigned char* lds) {
    pg8::Gemm g{(const bf16_t*)(p.ws + OFF_MIX), (const bf16_t*)(p.ws + OFF_WOUT) + (size_t)layer * D_ * D_, D_};
    OutProjSched S; S.skipctx = (layer == 1); S.init(layer == 1 ? 64 : R_ / 256, D_ / 256, get_nblk(), get_bid());
    EpiOutProj E{(bf16_t*)(p.ws + OFF_XS), (const float*)(p.ws + OFF_MOD) + (size_t)layer * 5 * 6144};
    pg8::gemm_phase<EpiOutProj, OutProjSched, true, true>((PG8_LAS unsigned char*)lds, g, S, E);
}

constexpr int RW_LD = 1028;
template <int CTRL> __device__ __forceinline__ float dpp_mov(float v) { return __int_as_float(__builtin_amdgcn_update_dpp(0, __float_as_int(v), CTRL, 0xf, 0xf, true)); }
__device__ __forceinline__ float router_reduce(float (&part)[32], int lane) {
#pragma unroll
    for (int i = 0; i < 16; ++i) { auto r = __builtin_amdgcn_permlane32_swap(__float_as_uint(part[i]), __float_as_uint(part[i + 16]), false, false); part[i] = __uint_as_float(r[0]) + __uint_as_float(r[1]); }
#pragma unroll
    for (int i = 0; i < 8; ++i) { auto r = __builtin_amdgcn_permlane16_swap(__float_as_uint(part[i]), __float_as_uint(part[i + 8]), false, false); part[i] = __uint_as_float(r[0]) + __uint_as_float(r[1]); }
#pragma unroll
    for (int i = 0; i < 4; ++i) { const bool hi = (lane & 8) != 0; const float send = hi ? part[i] : part[i + 4], keep = hi ? part[i + 4] : part[i]; part[i] = keep + dpp_mov<0x128>(send); }
#pragma unroll
    for (int i = 0; i < 2; ++i) { const bool hi = (lane & 4) != 0; const float send = hi ? part[i] : part[i + 2], keep = hi ? part[i + 2] : part[i]; part[i] = keep + dpp_mov<0x1B>(dpp_mov<0x141>(send)); }
    { const bool hi = (lane & 2) != 0; const float send = hi ? part[0] : part[1], keep = hi ? part[1] : part[0]; part[0] = keep + dpp_mov<0x4E>(send); }
    return part[0] + dpp_mov<0xB1>(part[0]);
}
__device__ __forceinline__ void router_commit(float myv, int lane, bool routed, int lr, int* lcnt, int* lsel, int* lpos, float* lgate) {
    const int e_me = lane >> 1;
    int rank = 0;
#pragma unroll
    for (int e = 0; e < 32; ++e) {
        const float le = __int_as_float(__builtin_amdgcn_readlane(__float_as_int(myv), 2 * e));
        rank += ((le > myv) || (le == myv && e < e_me)) ? 1 : 0;
    }
    if (lane & 1) rank = 99;
    int sel[4]; float sv[4];
#pragma unroll
    for (int t = 0; t < 4; ++t) {
        const unsigned long long mk = __builtin_amdgcn_ballot_w64(rank == t);
        const int src = __builtin_amdgcn_readfirstlane((int)__builtin_ctzll(mk));
        sel[t] = src >> 1; sv[t] = __int_as_float(__builtin_amdgcn_readlane(__float_as_int(myv), src));
    }
    const float e0 = 1.f, e1 = __expf(sv[1] - sv[0]), e2 = __expf(sv[2] - sv[0]), e3 = __expf(sv[3] - sv[0]);
    const float isum = 1.f / (e0 + e1 + e2 + e3);
    if (lane == 0) {
        const float gs[4] = {e0 * isum, e1 * isum, e2 * isum, e3 * isum};
#pragma unroll
        for (int t = 0; t < 4; ++t) {
            if (routed) { const int lp = atomicAdd(lcnt + sel[t], 1); lsel[lr * 4 + t] = sel[t]; lpos[lr * 4 + t] = lp; lgate[lr * 4 + t] = gs[t]; }
            else { lsel[lr * 4 + t] = -1; lpos[lr * 4 + t] = 0; lgate[lr * 4 + t] = 0.f; }
        }
    }
}
__device__ __forceinline__ void router_commit2(const float* lgl, int rbase, int nrows, int lane, int* lcnt, int* lsel, int* lpos, float* lgate, float* wsel) {
    const int hh = lane >> 5, e = lane & 31, rr = rbase + hh; const bool valid = rr < nrows; const int rc = valid ? rr : nrows - 1;
    const float* row = lgl + rc * 32;
    const float myv = row[e];
    f32x4 v[8];
#pragma unroll
    for (int q = 0; q < 8; ++q) v[q] = *(const f32x4*)(row + 4 * q);
    int rank = 0;
#pragma unroll
    for (int q = 0; q < 8; ++q)
#pragma unroll
        for (int i = 0; i < 4; ++i) { const float le = v[q][i]; rank += ((le > myv) || (le == myv && (4 * q + i) < e)) ? 1 : 0; }
    const bool win = valid && rank < 4;
    if (win) wsel[rc * 4 + rank] = myv;
    const f32x4 w4 = *(const f32x4*)(wsel + rc * 4);
    if (win) {
        const float den = 1.f + __expf(w4.y - w4.x) + __expf(w4.z - w4.x) + __expf(w4.w - w4.x);
        const float g = __expf(myv - w4.x) / den;
        const int lp = atomicAdd(lcnt + e, 1);
        lsel[rr * 4 + rank] = e; lpos[rr * 4 + rank] = lp; lgate[rr * 4 + rank] = g;
    }
}
constexpr int RS_LD = 1028, RR_LD = 36, RT_MAXROWS = 80;
constexpr int RT_OFF_STAGE = 0, RT_OFF_RED = RT_OFF_STAGE + 16 * RS_LD * 4, RT_OFF_SQ = RT_OFF_RED + 8 * 16 * RR_LD * 4, RT_OFF_BT = RT_OFF_SQ + 16 * 8 * 4, RT_OFF_LG = RT_OFF_BT + 8 * 32 * 4,
              RT_OFF_TAB = RT_OFF_LG + RT_MAXROWS * 32 * 4, RT_OFF_WSEL = RT_OFF_TAB + (64 + 3 * 4 * RT_MAXROWS) * 4, RT_LDS = RT_OFF_WSEL + 4 * RT_MAXROWS * 4;
static_assert(RT_LDS <= LDS_BYTES - 16, "router lds");
constexpr int RT_LAT = 69;
__device__ __forceinline__ void phase_router(PRef p, int layer, unsigned char* ldsraw, int cslot) {
    float* stage = (float*)(ldsraw + RT_OFF_STAGE);
    float* red = (float*)(ldsraw + RT_OFF_RED);
    float* sq = (float*)(ldsraw + RT_OFF_SQ);
    float* btw = (float*)(ldsraw + RT_OFF_BT);
    float* lgl = (float*)(ldsraw + RT_OFF_LG);
    int* lcnt = (int*)(ldsraw + RT_OFF_TAB);
    int* lbase = lcnt + 32;
    int* lsel = lbase + 32; int* lpos = lsel + 4 * RT_MAXROWS; float* lgate = (float*)(lpos + 4 * RT_MAXROWS);
    const int tid = get_tid(), wave = tid >> 6, lane = tid & 63, li = lane & 15, k4 = lane >> 4;
    const bf16_t* xs = (const bf16_t*)(p.ws + OFF_XS); bf16_t* hb = (bf16_t*)(p.ws + OFF_HB);
    const float* modv = (const float*)(p.ws + OFF_MOD) + (size_t)layer * 5 * 6144;
    for (int vb = get_bid(); vb < 256; vb += get_nblk()) {
        const int b = vb >> 6, j = vb & 63;
        int r0, nrows, mi;
        if (layer == 1) { r0 = b * TPB + CTX_ + 64 * j; nrows = 64; mi = b; }
        else if (j < 4) { r0 = b * TPB + 64 * j; nrows = 64; mi = 4; }
        else { r0 = b * TPB + CTX_ + (j - 4) * RT_LAT; nrows = (SEQ_ - (j - 4) * RT_LAT) < RT_LAT ? (SEQ_ - (j - 4) * RT_LAT) : RT_LAT; mi = b; }
        const int ntile = (nrows + 15) >> 4;
        if (tid < 32) lcnt[tid] = 0;
        const int kb = 128 * wave + 32 * k4;
        float rwp0[32], rwp1[32];
        {
            float bp0 = 0.f, bp1 = 0.f;
            const float* rwg = p.router_w + (size_t)layer * 32768 + (size_t)kb * 32 + li;
            const float* wg = p.norm2_w + layer * D_ + kb; const float* scg = modv + (size_t)mi * 6144 + 4096 + kb; const float* shg = modv + (size_t)mi * 6144 + 3072 + kb;
#pragma unroll
            for (int c = 0; c < 4; ++c) {
                float rv0[8], rv1[8]; f32x4 wv[2], sv[2], hv[2];
                const float* rc = rwg + 256 * c; asm volatile("" : "+v"(rc));
#pragma unroll
                for (int s = 0; s < 8; ++s) { rv0[s] = rc[s * 32]; rv1[s] = rc[s * 32 + 16]; }
#pragma unroll
                for (int q = 0; q < 2; ++q) { wv[q] = *(const f32x4*)(wg + 8 * c + 4 * q); sv[q] = *(const f32x4*)(scg + 8 * c + 4 * q); hv[q] = *(const f32x4*)(shg + 8 * c + 4 * q); }
                SCHED_FENCE();
#pragma unroll
                for (int s = 0; s < 8; ++s) {
                    const float f = wv[s >> 2][s & 3] * (1.f + sv[s >> 2][s & 3]), h = hv[s >> 2][s & 3];
                    rwp0[8 * c + s] = rv0[s] * f; rwp1[8 * c + s] = rv1[s] * f; bp0 = fmaf(h, rv0[s], bp0); bp1 = fmaf(h, rv1[s], bp1);
                }
            }
            bp0 = xadd32(xadd16(bp0)); bp1 = xadd32(xadd16(bp1));
            if (lane < 16) { btw[wave * 32 + li] = bp0; btw[wave * 32 + 16 + li] = bp1; }
        }
        const int srow = tid >> 8, scol = (tid & 255) * 4;
        const f32x4 w4 = *(const f32x4*)(p.norm2_w + layer * D_ + scol), sc4 = *(const f32x4*)(modv + (size_t)mi * 6144 + 4096 + scol), sh4 = *(const f32x4*)(modv + (size_t)mi * 6144 + 3072 + scol);
        u32x2 cur[8], nxt[8];
#pragma unroll
        for (int it = 0; it < 8; ++it) { int rr = 2 * it + srow; if (rr >= nrows) rr = nrows - 1; cur[it] = *(const u32x2*)(xs + (size_t)(r0 + rr) * D_ + scol); }
#pragma unroll 1
        for (int t = 0; t < ntile; ++t) {
#pragma unroll
            for (int it = 0; it < 8; ++it) *(f32x4*)(stage + (2 * it + srow) * RS_LD + scol) = (f32x4){bflo(cur[it].x), bfhi(cur[it].x), bflo(cur[it].y), bfhi(cur[it].y)};
#pragma unroll
            for (int it = 0; it < 8; ++it) { int rr = 16 * (t + 1) + 2 * it + srow; if (rr >= nrows) rr = nrows - 1; nxt[it] = *(const u32x2*)(xs + (size_t)(r0 + rr) * D_ + scol); }
            __syncthreads();
            {
                f32x4 xa[8];
#pragma unroll
                for (int q = 0; q < 8; ++q) xa[q] = *(const f32x4*)(stage + li * RS_LD + kb + 4 * q);
                SCHED_FENCE();
                float ss = 0.f; f32x4 acc0 = {0.f, 0.f, 0.f, 0.f}, acc1 = {0.f, 0.f, 0.f, 0.f};
#pragma unroll
                for (int s = 0; s < 32; ++s) {
                    const float x = xa[s >> 2][s & 3]; ss = fmaf(x, x, ss);
                    acc0 = __builtin_amdgcn_mfma_f32_16x16x4f32(x, rwp0[s], acc0, 0, 0, 0);
                    acc1 = __builtin_amdgcn_mfma_f32_16x16x4f32(x, rwp1[s], acc1, 0, 0, 0);
                }
                ss = xadd32(xadd16(ss));
                if (lane < 16) sq[li * 8 + wave] = ss;
#pragma unroll
                for (int r = 0; r < 4; ++r) { red[(wave * 16 + 4 * k4 + r) * RR_LD + li] = acc0[r]; red[(wave * 16 + 4 * k4 + r) * RR_LD + 16 + li] = acc1[r]; }
            }
            __syncthreads();
            {
                const int rr = tid >> 5, e = tid & 31;
                float s = 0.f, bt = 0.f;
#pragma unroll
                for (int w = 0; w < 8; ++w) { s += red[(w * 16 + rr) * RR_LD + e]; bt += btw[w * 32 + e]; }
                const f32x4 qa = *(const f32x4*)(sq + rr * 8), qb = *(const f32x4*)(sq + rr * 8 + 4);
                const float rstd = rsqrtf((((qa.x + qa.y) + (qa.z + qa.w)) + ((qb.x + qb.y) + (qb.z + qb.w))) * (1.0f / D_) + EPS_);
                lgl[(16 * t + rr) * 32 + e] = fmaf(rstd, s, bt + p.router_b[layer * 32 + e]);
            }
#pragma unroll
            for (int it = 0; it < 8; ++it) {
                const int row = 2 * it + srow, grow = 16 * t + row;
                const f32x4 qa = *(const f32x4*)(sq + row * 8), qb = *(const f32x4*)(sq + row * 8 + 4);
                const float rs = rsqrtf((((qa.x + qa.y) + (qa.z + qa.w)) + ((qb.x + qb.y) + (qb.z + qb.w))) * (1.0f / D_) + EPS_);
                if (grow < nrows) {
                    const f32x4 x = (f32x4){bflo(cur[it].x), bfhi(cur[it].x), bflo(cur[it].y), bfhi(cur[it].y)};
                    const float h0 = (x.x * rs * w4.x) * (1.f + sc4.x) + sh4.x, h1 = (x.y * rs * w4.y) * (1.f + sc4.y) + sh4.y;
                    const float h2 = (x.z * rs * w4.z) * (1.f + sc4.z) + sh4.z, h3 = (x.w * rs * w4.w) * (1.f + sc4.w) + sh4.w;
                    u32x2 o; o.x = pack2(h0, h1); o.y = pack2(h2, h3);
                    *(u32x2*)(hb + (size_t)(r0 + grow) * D_ + scol) = o;
                }
            }
#pragma unroll
            for (int it = 0; it < 8; ++it) cur[it] = nxt[it];
        }
        __syncthreads();
        { const int tc = get_tid(), wc = tc >> 6, lc = tc & 63;
          float* wsel = (float*)(ldsraw + RT_OFF_WSEL);
          for (int rb = 2 * wc; rb < nrows; rb += 16) router_commit2(lgl, rb, nrows, lc, lcnt, lsel, lpos, lgate, wsel); }
        __syncthreads();
        if (get_tid() < 32) lbase[get_tid()] = atomicAdd((int*)(p.ws + OFF_CTL) + cslot * 32 + get_tid(), lcnt[get_tid()]);
        __syncthreads();
        float* gate = (float*)(p.ws + OFF_GATE); int* rowe = (int*)(p.ws + OFF_ROWE);
        for (int i = get_tid(); i < nrows * 4; i += NT) { const int e = lsel[i]; rowe[(size_t)e * ROWE_CAP + lbase[e] + lpos[i]] = r0 * 4 + i; gate[r0 * 4 + i] = lgate[i]; }
        __syncthreads();
    }
}

__device__ __forceinline__ void moe_offsets(PRef p, int layer, int* off) {
    const int tid = get_tid();
    if (tid == 0) { const int* cnt = (const int*)(p.ws + OFF_CTL) + layer * 32; int a = 0; for (int e = 0; e < 32; ++e) { const int c = cnt[e]; off[e] = a; off[40 + e] = c; a += (c + 255) & ~255; } off[32] = a; }
    __syncthreads();
    if (tid < PMAX / 256) { int e = 0; for (int q = 1; q < 32; ++q) e += (off[q] <= tid * 256) ? 1 : 0; off[96 + tid] = e; }
    __syncthreads();
}

struct EpiMoe1 {
    static constexpr bool PERM = false, AFTER_DRAIN = false; static constexpr int NVM = 8;
    bf16_t* act; const float* b1l;
    __device__ __forceinline__ void operator()(const f32x4 (&acc)[2][2][4][2], const pg8::Unit& u, int wr, int wc, int fr, int fq) const {
        const int e = (u.aux >> 8) & 255, ln = u.aux & 255;
        const int ucol0 = ln * 256 + wc * 64 + 16 * fq;
        const float* b1 = b1l + (size_t)e * 2048 + ucol0;
        f32x4 bv[2][2];
#pragma unroll
        for (int bj = 0; bj < 2; ++bj)
#pragma unroll
            for (int n = 0; n < 2; ++n) bv[bj][n] = *(const f32x4*)(b1 + 8 * bj + 4 * n);
#pragma unroll
        for (int ai = 0; ai < 2; ++ai)
#pragma unroll
            for (int m = 0; m < 4; ++m) {
                const int prow = u.pm * 256 + ai * 128 + wr * 64 + m * 16 + fr;
                u32x4 o; unsigned ow[4];
#pragma unroll
                for (int bj = 0; bj < 2; ++bj)
#pragma unroll
                    for (int n = 0; n < 2; ++n) {
                        const f32x4 uu = acc[ai][bj][m][n] + bv[bj][n];
                        const float g0 = fminf(uu.x, 7.f), l0 = fminf(fmaxf(uu.y, -7.f), 7.f), g1 = fminf(uu.z, 7.f), l1 = fminf(fmaxf(uu.w, -7.f), 7.f);
                        const float y0 = g0 * sigmoidf_(1.702f * g0) * (l0 + 1.f), y1 = g1 * sigmoidf_(1.702f * g1) * (l1 + 1.f);
                        ow[2 * bj + n] = pack2(y0, y1);
                    }
                o.x = ow[0]; o.y = ow[1]; o.z = ow[2]; o.w = ow[3];
                *(u32x4*)(act + (size_t)prow * DFF + (ucol0 >> 1)) = o;
            }
    }
};
__device__ __forceinline__ void phase_moe1(PRef p, int layer, unsigned char* lds) {
    int* off = (int*)(lds + pg8::STAGE_BYTES);
    moe_offsets(p, layer, off);
    pg8::Gemm g{(const bf16_t*)(p.ws + OFF_HB), (const bf16_t*)(p.ws + OFF_W1) + (size_t)layer * NE * 2048 * D_, D_};
    pg8::MoeSched<true> S; S.init(off[32] >> 8, 8, get_nblk(), get_bid()); S.tab = off; S.rowe = (const int*)(p.ws + OFF_ROWE); S.K2 = D_ * 2;
    { int* ridx = (int*)(lds + pg8::STAGE_BYTES + 2048); S.ridx = ridx; S.fill_ridx(ridx, get_tid()); }
    EpiMoe1 E{(bf16_t*)(p.ws + OFF_ACT), p.b1 + (size_t)layer * NE * 2048};
    pg8::gemm_phase<EpiMoe1, pg8::MoeSched<true>, true, true>((PG8_LAS unsigned char*)lds, g, S, E);
}

struct EpiMoe2 {
    static constexpr bool PERM = false, AFTER_DRAIN = false; static constexpr int NVM = 16;
    bf16_t* ybuf; const float* b2l; const u32x2* rtab; bf16_t* dummy;
    __device__ __forceinline__ void operator()(const f32x4 (&acc)[2][2][4][2], const pg8::Unit& u, int wr, int wc, int fr, int fq) const {
        const int e = (u.aux >> 8) & 255, ln = u.aux & 255, ui = u.aux >> 16;
        const int col0 = ln * 256 + wc * 64 + 16 * fq;
        const float* b2 = b2l + (size_t)e * D_ + col0;
        f32x4 bv[2][2];
#pragma unroll
        for (int bj = 0; bj < 2; ++bj)
#pragma unroll
            for (int n = 0; n < 2; ++n) bv[bj][n] = *(const f32x4*)(b2 + 8 * bj + 4 * n);
        u32x2 rt[2][4];
#pragma unroll
        for (int ai = 0; ai < 2; ++ai)
#pragma unroll
            for (int m = 0; m < 4; ++m) rt[ai][m] = rtab[ui * 256 + ai * 128 + wr * 64 + m * 16 + fr];
        SCHED_FENCE();
#pragma unroll
        for (int ai = 0; ai < 2; ++ai)
#pragma unroll
            for (int m = 0; m < 4; ++m) {
                const int idx = (int)rt[ai][m].x; const float g = __uint_as_float(rt[ai][m].y);
                unsigned ow[8];
#pragma unroll
                for (int bj = 0; bj < 2; ++bj)
#pragma unroll
                    for (int n = 0; n < 2; ++n) { const f32x4 y = (acc[ai][bj][m][n] + bv[bj][n]) * g; ow[4 * bj + 2 * n] = pack2(y.x, y.y); ow[4 * bj + 2 * n + 1] = pack2(y.z, y.w); }
                u32x4 o0, o1; o0.x = ow[0]; o0.y = ow[1]; o0.z = ow[2]; o0.w = ow[3]; o1.x = ow[4]; o1.y = ow[5]; o1.z = ow[6]; o1.w = ow[7];
                bf16_t* d = (idx >= 0 ? ybuf + (size_t)idx * D_ : dummy) + col0;
                *(u32x4*)d = o0; *(u32x4*)(d + 8) = o1;
            }
    }
};
__device__ __forceinline__ void phase_moe2(PRef p, int layer, unsigned char* lds) {
    int* off = (int*)(lds + pg8::STAGE_BYTES);
    pg8::Gemm g{(const bf16_t*)(p.ws + OFF_ACT), (const bf16_t*)(p.ws + OFF_W2) + (size_t)layer * NE * D_ * DFF, DFF};
    pg8::MoeSched<false> S; S.init(off[32] >> 8, 4, get_nblk(), get_bid()); S.tab = off; S.rowe = nullptr; S.K2 = 0; S.ridx = nullptr;
    u32x2* rtab = (u32x2*)(lds + pg8::STAGE_BYTES + 2048);
    {
        const int tid = get_tid(); const int* rowe = (const int*)(p.ws + OFF_ROWE); const float* gate = (const float*)(p.ws + OFF_GATE);
        for (int i = 0; ; i += 2) {
            pg8::Unit u0; if (!S.next(i, u0)) break;
            const int ii = i + (tid >> 8), r = tid & 255;
            pg8::Unit u;
            if (S.next(ii, u)) {
                const int e = (u.aux >> 8) & 255, pos = u.pm * 256 - off[e] + r, c = off[40 + e];
                const int idx = pos < c ? rowe[(size_t)e * ROWE_CAP + pos] : -1;
                u32x2 w; w.x = (unsigned)idx; w.y = __float_as_uint(idx >= 0 ? gate[idx] : 0.f);
                rtab[ii * 256 + r] = w;
            }
        }
        __syncthreads();
    }
    EpiMoe2 E{(bf16_t*)(p.ws + OFF_YBUF), p.b2 + (size_t)layer * NE * D_, rtab, (bf16_t*)(p.ws + OFF_EID)};
    pg8::gemm_phase<EpiMoe2, pg8::MoeSched<false>, true, true>((PG8_LAS unsigned char*)lds, g, S, E);
}

__device__ __forceinline__ void phase_combine(PRef p, int layer) {
    const int tid = get_tid(), wave = tid >> 6, lane = tid & 63;
    bf16_t* xs = (bf16_t*)(p.ws + OFF_XS); bf16_t* hb = (bf16_t*)(p.ws + OFF_HB); const bf16_t* ybuf = (const bf16_t*)(p.ws + OFF_YBUF);
    const float* modv = (const float*)(p.ws + OFF_MOD);
    f32x4 wv[4]; load_row4(layer == 0 ? p.norm1_w + D_ : p.final_norm_w, lane, wv);
    for (int r = get_bid() * 8 + wave; r < R_; r += get_nblk() * 8) {
        const int b = r / TPB, pp = r - b * TPB;
        if (layer == 1 && pp < CTX_) continue;
        const int mi = pp < CTX_ ? 4 : b;
        u32x2 yw[4][4]; f32x4 gv[4], xv[4], scv[4], shv[4], v[4], hv[4];
#pragma unroll
        for (int j = 0; j < 4; ++j)
#pragma unroll
            for (int s = 0; s < 4; ++s) yw[j][s] = *(const u32x2*)(ybuf + ((size_t)r * 4 + s) * D_ + 4 * lane + 256 * j);
        load_row4(modv + (size_t)(layer * 5 + mi) * 6144 + 5120, lane, gv);
        load_xrow4(xs + (size_t)r * D_, lane, xv);
        if (layer == 0) { const float* mv = modv + (size_t)(5 + mi) * 6144; load_row4(mv + 1024, lane, scv); load_row4(mv, lane, shv); }
        SCHED_FENCE();
#pragma unroll
        for (int j = 0; j < 4; ++j) {
            f32x4 f = (f32x4){0.f, 0.f, 0.f, 0.f};
#pragma unroll
            for (int s = 0; s < 4; ++s) { f.x += bflo(yw[j][s].x); f.y += bfhi(yw[j][s].x); f.z += bflo(yw[j][s].y); f.w += bfhi(yw[j][s].y); }
            v[j] = xv[j] + gv[j] * f;
        }
        const float rstd = row_rstd(v);
        if (layer == 0) {
            store_xrow4(xs + (size_t)r * D_, lane, v);
            norm_apply_store(v, rstd, wv, scv, shv, hb + (size_t)r * D_, lane, hv);
        } else {
            float* dst = p.out + ((size_t)b * SEQ_ + (pp - CTX_)) * D_;
#pragma unroll
            for (int j = 0; j < 4; ++j) { f32x4 o; o.x = v[j].x * rstd * wv[j].x; o.y = v[j].y * rstd * wv[j].y; o.z = v[j].z * rstd * wv[j].z; o.w = v[j].w * rstd * wv[j].w; __builtin_nontemporal_store(o, (f32x4*)(dst + 4 * lane + 256 * j)); }
        }
    }
}

#define LAS __attribute__((address_space(3)))
#define XB_TMO      128
#define XB_XCNT(j)  (256  + 64 * (j))
#define XB_XSUB(j)  (1280 + 64 * (j))
#define XB_XGEN(j)  (2304 + 64 * (j))
#define XB_TOP      3328
#define XB_TOPGEN   3392
#define XCD_BAR_WORDS 3456
#define XB_SPIN_CAP (1u << 18)

__device__ __forceinline__ unsigned xb_ld(unsigned* p)              { return __hip_atomic_load(p, __ATOMIC_RELAXED, __HIP_MEMORY_SCOPE_AGENT); }
__device__ __forceinline__ unsigned xb_add(unsigned* p, unsigned v) { return __hip_atomic_fetch_add(p, v, __ATOMIC_RELAXED, __HIP_MEMORY_SCOPE_AGENT); }
__device__ __forceinline__ unsigned xb_xcc_id() { return (unsigned)__builtin_amdgcn_s_getreg((3 << 11) | 20) & 0xFu; }
#define XB_SPIN(cond, bar) do { unsigned _sp = 0; while (cond) { __builtin_amdgcn_s_sleep(1); \
    if ((++_sp & 255u) == 0u) { if (xb_ld(&(bar)[XB_TMO])) break; if (_sp > XB_SPIN_CAP) { atomicAdd(&(bar)[XB_TMO], 1u); break; } } } } while (0)

struct XcdBarrier {
    unsigned* bar; unsigned x;
    volatile LAS unsigned* st;
};

__device__ __forceinline__ XcdBarrier xcd_barrier_post(unsigned* bar, volatile LAS unsigned* st) {
    XcdBarrier b; b.bar = bar; b.x = xb_xcc_id(); b.st = st;
    if (threadIdx.x == 0) (void)xb_add(&bar[XB_XCNT(b.x)], 1u);
    return b;
}
__device__ __forceinline__ void xcd_barrier_complete(unsigned* bar, unsigned x, unsigned& nloc, unsigned& nx) {
    const unsigned G = gridDim.x * gridDim.y * gridDim.z;
    unsigned sum, cnt, mine, sp = 0u;
    for (;;) {
        sum = 0u; cnt = 0u; mine = 0u;
#pragma unroll
        for (unsigned j = 0; j < 16; ++j) { const unsigned c = xb_ld(&bar[XB_XCNT(j)]); sum += c; cnt += (c > 0u) ? 1u : 0u; mine = (j == x) ? c : mine; }
        if (sum == G) break;
        __builtin_amdgcn_s_sleep(1);
        if ((++sp & 255u) == 0u) { if (xb_ld(&bar[XB_TMO])) break; if (sp > XB_SPIN_CAP) { atomicAdd(&bar[XB_TMO], 1u); break; } }
    }
    nloc = mine > 0u ? mine : 1u; nx = cnt > 0u ? cnt : 1u;
}

__device__ __forceinline__ void xcd_barrier(const XcdBarrier& b) {
    asm volatile("s_waitcnt vmcnt(0)" ::: "memory");
    __syncthreads();
    if (threadIdx.x == 0) {
        unsigned* bar = b.bar;
        __builtin_amdgcn_s_waitcnt(0);
        unsigned nloc = b.st[0], nx = b.st[1];
        if (nloc == 0u) { xcd_barrier_complete(bar, b.x, nloc, nx); b.st[0] = nloc; b.st[1] = nx; }
        const unsigned old = xb_add(&bar[XB_XSUB(b.x)], 1u);
        const unsigned gen = old / nloc;
        if (old + 1u == (gen + 1u) * nloc) {
            __builtin_amdgcn_fence(__ATOMIC_RELEASE, "agent");
            asm volatile("s_waitcnt vmcnt(0)" ::: "memory");
            const unsigned og = xb_add(&bar[XB_TOP], 1u);
            const unsigned tg = og / nx;
            if (og + 1u == (tg + 1u) * nx) xb_add(&bar[XB_TOPGEN], 1u);
            else XB_SPIN(xb_ld(&bar[XB_TOPGEN]) == tg, bar);
            __builtin_amdgcn_fence(__ATOMIC_ACQUIRE, "agent");
            xb_add(&bar[XB_XGEN(b.x)], 1u);
            asm volatile("s_waitcnt vmcnt(0)" ::: "memory");
        } else {
            XB_SPIN(xb_ld(&bar[XB_XGEN(b.x)]) == gen, bar);
            __builtin_amdgcn_fence(__ATOMIC_ACQUIRE, "agent");
            asm volatile("s_waitcnt vmcnt(0)" ::: "memory");
        }
    }
    __syncthreads();
}


constexpr int NPHASE = 24;
typedef const __attribute__((address_space(4))) Params* KArgs;
__device__ __forceinline__ KArgs kargs() { KArgs q = (KArgs)__builtin_amdgcn_kernarg_segment_ptr(); asm volatile("" : "+s"(q)); return q; }
__device__ __forceinline__ void grid_bar(unsigned char* lds) {
    XcdBarrier b; b.bar = (unsigned*)(kargs()->ws + OFF_BAR); b.x = xb_xcc_id(); b.st = (volatile LAS unsigned*)((LAS unsigned char*)lds + LDS_BYTES - 16);
    xcd_barrier(b);
}
__global__ void __launch_bounds__(NT) fwd_kernel(Params p_unused) {
    extern __shared__ __attribute__((aligned(16))) unsigned char lds[];
    {
        volatile LAS unsigned* bst = (volatile LAS unsigned*)((LAS unsigned char*)lds + LDS_BYTES - 16);
        if (threadIdx.x == 0) { bst[0] = 0u; bst[1] = 0u; }
        __syncthreads();
        (void)xcd_barrier_post((unsigned*)(kargs()->ws + OFF_BAR), bst);
    }
#define PH(ty, last, call) do { const int nrep_ = ((PROBE_MASK1 >> (ty)) & 1) ? 2 : 1; for (int rep_ = 0; rep_ < nrep_; ++rep_) { { PRef p = *kargs(); call; } if (!(last) || rep_ + 1 < nrep_) grid_bar(lds); } } while (0)
    { PRef p = *kargs(); phase_prep(p, lds); }
    grid_bar(lds);
    if ((PROBE_MASK1 >> 0) & 1) { { PRef p = *kargs(); phase_prep(p, lds); } grid_bar(lds); }
    PH(1, false, phase_norm_in(p));
#pragma nounroll
    for (int L = 0; L < 2; ++L) {
        PH(2, false, phase_inproj(p, L, lds));
        PH(3, false, phase_mixers(p, L, lds));
        PH(4, false, phase_hgrn_c2(p));
        PH(5, false, phase_hgrn_inter(p, L, lds));
        PH(7, false, phase_outproj(p, L, lds));
        PH(8, false, phase_router(p, L, lds, L + 2 * rep_));
        PH(10, false, phase_moe1(p, L, lds));
        PH(11, false, phase_moe2(p, L, lds));
        PH(12, L == 1, phase_combine(p, L));
    }
#undef PH
}

extern "C" void kernel_launch(void* const* d_in, const int* in_sizes, int n_in, void* d_out, int out_size, void* d_ws, size_t ws_size, hipStream_t stream) {
    static int grid = 0;
    if (grid == 0) {
        if (ws_size < WS_END) { fprintf(stderr, "kernel_launch: workspace too small (%zu < %zu)\n", ws_size, (size_t)WS_END); grid = -1; return; }
        int dev = 0, cus = 0, per_cu = 0;
        (void)hipGetDevice(&dev);
        (void)hipDeviceGetAttribute(&cus, hipDeviceAttributeMultiprocessorCount, dev);
        (void)hipFuncSetAttribute((const void*)fwd_kernel, hipFuncAttributeMaxDynamicSharedMemorySize, LDS_BYTES);
        (void)hipOccupancyMaxActiveBlocksPerMultiprocessor(&per_cu, (const void*)fwd_kernel, NT, LDS_BYTES);
        if (per_cu < 1) { fprintf(stderr, "kernel_launch: occupancy query reports %d blocks per CU\n", per_cu); }
        grid = cus;
        (void)hipGetLastError();
    }
    if (grid < 0) return;
    Params p{};
    const float** pin = (const float**)&p;
    for (int i = 0; i < 22; ++i) pin[i] = (const float*)d_in[i];
    p.out = (float*)d_out; p.ws = (unsigned char*)d_ws;
    (void)hipMemsetAsync((char*)d_ws + OFF_BAR, 0, XCD_BAR_WORDS * 4, stream);
    void* args[] = {&p};
    hipError_t e = hipLaunchCooperativeKernel((const void*)fwd_kernel, dim3(grid), dim3(NT), args, LDS_BYTES, stream);
    if (e != hipSuccess) fprintf(stderr, "cooperative launch failed: %s (grid %d)\n", hipGetErrorString(e), grid);
}
```
